# Optimizing an MI355X kernel written in HIP

```python
import jax
import jax.numpy as jnp
from jax import lax
import numpy as np

D_MODEL = 1024
BATCH = 8
SEQ = 4096
DEPTH = 1

CHUNK = 64
Q_BLOCK = 128
N_MEM = 256
EPS = 1e-6
SB_HD = 128
SB_HEADS = D_MODEL // SB_HD
SB_W = SB_HEADS * SB_HD
ML_HEADS = 4
ML_HD = D_MODEL // ML_HEADS
ML_W = ML_HEADS * ML_HD
X_HEADS = 4
X_HD = D_MODEL // X_HEADS
X_W = X_HEADS * X_HD
CONV_W = 4
D_FF = 4 * D_MODEL
N_BRANCH = 3
IN_SIZES = (SB_W, SB_W, SB_W, ML_W, ML_W, ML_W, ML_W, ML_HEADS, ML_HEADS, X_W, N_BRANCH * D_MODEL)
IN_SPLITS = tuple(int(v) for v in np.cumsum(IN_SIZES)[:-1])
N_IN = int(sum(IN_SIZES))

kernel_name = "hybrid_sb_mlstm_xattn_block"


def _rmsnorm(x, g):
    xf = x.astype(jnp.float32)
    y = xf * lax.rsqrt(jnp.mean(xf * xf, axis=-1, keepdims=True) + EPS)
    return (y * g.astype(jnp.float32)).astype(x.dtype)


def _split_heads(t, n):
    b, s, _ = t.shape
    return t.reshape(b, s, n, -1).transpose(0, 2, 1, 3)


def _merge_heads(t):
    b, h, s, d = t.shape
    return t.transpose(0, 2, 1, 3).reshape(b, s, h * d)


def _causal_conv(u, w, b):
    s = u.shape[1]
    up = jnp.pad(u, ((0, 0), (CONV_W - 1, 0), (0, 0)))
    return sum((up[:, j:j + s, :] * w[j] for j in range(CONV_W)), b)


def _stick_breaking(q, k, v):
    _, _, s_len, dh = q.shape
    scale = dh ** -0.5
    kf = k.astype(jnp.float32)
    vf = v.astype(jnp.float32)
    outs = []
    for blk in range(s_len // Q_BLOCK):
        start, end = blk * Q_BLOCK, (blk + 1) * Q_BLOCK
        qb = q[:, :, start:end].astype(jnp.float32)
        z = jnp.einsum('bhqd,bhkd->bhqk', qb, kf[:, :, :end]) * scale
        q_pos = start + jnp.arange(Q_BLOCK)
        k_pos = jnp.arange(end)
        causal = k_pos[None, :] < q_pos[:, None]
        log_1m = jnp.where(causal, jax.nn.log_sigmoid(-z), 0.0)
        later = lax.cumsum(log_1m, axis=3, reverse=True) - log_1m
        log_a = jnp.where(causal, jax.nn.log_sigmoid(z) + later, -jnp.inf)
        outs.append(jnp.einsum('bhqk,bhkd->bhqd', jnp.exp(log_a), vf[:, :, :end]))
    return jnp.concatenate(outs, axis=2)


def _mlstm(q, k, v, i_pre, f_pre):
    f32 = jnp.float32
    b, h, s_len, dh = q.shape
    nc = s_len // CHUNK
    q = q.astype(f32)
    k = k.astype(f32) * (dh ** -0.5)
    v = v.astype(f32)
    i_pre = i_pre.astype(f32)
    log_f = jax.nn.log_sigmoid(f_pre.astype(f32))

    def chunks(t):
        return jnp.moveaxis(t.reshape(b, h, nc, CHUNK, *t.shape[3:]), 2, 0)

    tri = jnp.tril(jnp.ones((CHUNK, CHUNK), dtype=bool))

    def step(carry, xs):
        c_prev, n_prev, m_prev = carry
        qc, kc, vc, ic, lfc = xs
        bcum = jnp.cumsum(lfc, axis=-1)
        d = jnp.where(tri, bcum[..., :, None] - bcum[..., None, :] + ic[..., None, :], -jnp.inf)
        m_inter = bcum + m_prev[..., None]
        m_t = jnp.maximum(m_inter, jnp.max(d, axis=-1))
        w = jnp.exp(d - m_t[..., None])
        s_inter = jnp.exp(m_inter - m_t)
        sc = jnp.einsum('bhtd,bhsd->bhts', qc, kc) * w
        num = jnp.einsum('bhts,bhsd->bhtd', sc, vc) + s_inter[..., None] * jnp.einsum('bhvk,bhtk->bhtv', c_prev, qc)
        den = jnp.sum(sc, axis=-1) + s_inter * jnp.einsum('bhtk,bhk->bht', qc, n_prev)
        h_c = num / jnp.maximum(jnp.abs(den), jnp.exp(-m_t))[..., None]
        b_end = bcum[..., -1]
        g = b_end[..., None] - bcum + ic
        m_new = jnp.maximum(b_end + m_prev, jnp.max(g, axis=-1))
        decay = jnp.exp(b_end + m_prev - m_new)
        wk = jnp.exp(g - m_new[..., None])
        c_new = decay[..., None, None] * c_prev + jnp.einsum('bhsv,bhsk->bhvk', vc * wk[..., None], kc)
        n_new = decay[..., None] * n_prev + jnp.einsum('bhs,bhsk->bhk', wk, kc)
        return (c_new, n_new, m_new), h_c

    init = (jnp.zeros((b, h, dh, dh), f32), jnp.zeros((b, h, dh), f32), jnp.zeros((b, h), f32))
    _, hs = lax.scan(step, init, (chunks(q), chunks(k), chunks(v), chunks(i_pre), chunks(log_f)))
    return jnp.moveaxis(hs, 0, 2).reshape(b, h, s_len, dh)


def _cross_attention(q, mk, mv, gq, gk):
    dh = q.shape[-1]
    qn = _rmsnorm(q, gq)
    kn = _rmsnorm(mk, gk)
    logits = jnp.einsum('bhsd,bhmd->bhsm', qn, kn).astype(jnp.float32) * (dh ** -0.5)
    p = jax.nn.softmax(logits, axis=-1)
    return jnp.einsum('bhsm,bhmd->bhsd', p.astype(mv.dtype), mv)


def setup_inputs(seed: int = 0) -> dict:
    key = jax.random.key(seed)
    ks = jax.random.split(key, 24)
    f32 = jnp.float32
    L = DEPTH

    def nrm(k, shape, scale):
        return jax.random.normal(k, shape, f32) * scale

    def gain(k, shape):
        return 1.0 + 0.02 * jax.random.normal(k, shape, f32)

    b_i = nrm(ks[4], (L, ML_HEADS), 0.1)
    b_f = jnp.linspace(3.0, 6.0, ML_HEADS, dtype=f32)[None, :] + nrm(ks[5], (L, ML_HEADS), 0.1)
    return {
        "x": nrm(ks[0], (BATCH, SEQ, D_MODEL), 1.0),
        "mem": nrm(ks[1], (BATCH, N_MEM, D_MODEL), 1.0),
        "g_mix": gain(ks[2], (L, D_MODEL)),
        "w_in": nrm(ks[3], (L, D_MODEL, N_IN), D_MODEL ** -0.5),
        "b_if": jnp.concatenate([b_i, b_f], axis=-1),
        "b_gate": nrm(ks[6], (L, N_BRANCH * D_MODEL), 0.02),
        "conv_w": nrm(ks[7], (L, CONV_W, 2 * ML_W), CONV_W ** -0.5),
        "conv_b": nrm(ks[8], (L, 2 * ML_W), 0.02),
        "ml_norm_g": gain(ks[9], (L, ML_W)),
        "g_mem": gain(ks[10], (L, D_MODEL)),
        "w_mem_kv": nrm(ks[11], (L, D_MODEL, 2 * X_W), D_MODEL ** -0.5),
        "q_norm_g": gain(ks[12], (L, X_HD)),
        "k_norm_g": gain(ks[13], (L, X_HD)),
        "w_sb_proj": nrm(ks[14], (L, SB_W, D_MODEL), SB_W ** -0.5),
        "w_ml_proj": nrm(ks[15], (L, ML_W, D_MODEL), ML_W ** -0.5),
        "w_x_proj": nrm(ks[16], (L, X_W, D_MODEL), X_W ** -0.5),
        "w_out": nrm(ks[17], (L, D_MODEL, D_MODEL), D_MODEL ** -0.5),
        "g_mlp": gain(ks[18], (L, D_MODEL)),
        "w_ff1": nrm(ks[19], (L, D_MODEL, D_FF), D_MODEL ** -0.5),
        "w_ff2": nrm(ks[20], (L, D_FF, D_MODEL), D_FF ** -0.5),
    }


def reference(x, mem, g_mix, w_in, b_if, b_gate, conv_w, conv_b, ml_norm_g, g_mem, w_mem_kv,
              q_norm_g, k_norm_g, w_sb_proj, w_ml_proj, w_x_proj, w_out, g_mlp, w_ff1, w_ff2):
    dt = x.dtype
    bsz, seq, _ = x.shape
    for l in range(DEPTH):
        h = _rmsnorm(x, g_mix[l])
        z = h @ w_in[l]
        (sb_q, sb_k, sb_v, ml_q, ml_k, ml_v, ml_o, ml_i, ml_f, x_q, gate_pre) = jnp.split(z, IN_SPLITS, axis=-1)

        y_sb = _merge_heads(_stick_breaking(_split_heads(sb_q, SB_HEADS), _split_heads(sb_k, SB_HEADS),
                                            _split_heads(sb_v, SB_HEADS))).astype(dt)

        qk = jax.nn.silu(_causal_conv(jnp.concatenate([ml_q, ml_k], axis=-1), conv_w[l], conv_b[l]))
        mq, mk = jnp.split(qk, 2, axis=-1)
        i_pre = (ml_i + b_if[l, :ML_HEADS]).transpose(0, 2, 1)
        f_pre = (ml_f + b_if[l, ML_HEADS:]).transpose(0, 2, 1)
        hm = _mlstm(_split_heads(mq, ML_HEADS), _split_heads(mk, ML_HEADS), _split_heads(ml_v, ML_HEADS), i_pre, f_pre)
        hm = _rmsnorm(hm, ml_norm_g[l].reshape(ML_HEADS, 1, ML_HD))
        y_ml = (_merge_heads(hm) * jax.nn.sigmoid(ml_o.astype(jnp.float32))).astype(dt)

        kv = _rmsnorm(mem, g_mem[l]) @ w_mem_kv[l]
        mem_k, mem_v = jnp.split(kv, 2, axis=-1)
        y_x = _merge_heads(_cross_attention(_split_heads(x_q, X_HEADS), _split_heads(mem_k, X_HEADS),
                                            _split_heads(mem_v, X_HEADS), q_norm_g[l], k_norm_g[l])).astype(dt)

        gates = jax.nn.sigmoid(gate_pre + b_gate[l]).reshape(bsz, seq, N_BRANCH, D_MODEL)
        mixed = (gates[:, :, 0] * (y_sb @ w_sb_proj[l])
                 + gates[:, :, 1] * (y_ml @ w_ml_proj[l])
                 + gates[:, :, 2] * (y_x @ w_x_proj[l]))
        x = x + mixed @ w_out[l]

        u = _rmsnorm(x, g_mlp[l]) @ w_ff1[l]
        x = x + jnp.square(jax.nn.relu(u)) @ w_ff2[l]
    return x
```

```cpp
#include <hip/hip_runtime.h>
#include <hip/hip_cooperative_groups.h>
#include <cstdint>
#include <cstdio>
namespace cg = cooperative_groups;

typedef unsigned short bf16_t;
typedef short bf16x8 __attribute__((ext_vector_type(8)));
typedef float f32x4 __attribute__((ext_vector_type(4)));
typedef unsigned u32x2 __attribute__((ext_vector_type(2)));
typedef unsigned u32x4 __attribute__((ext_vector_type(4)));

constexpr int D = 1024, BATCH = 8, SEQ = 4096, T = BATCH * SEQ, NMEM = 256, TMEM = BATCH * NMEM, FF = 4096;
constexpr int NIN = 11272;
constexpr int IF_COL = 7168;
constexpr float EPS = 1e-6f;
constexpr int NTHREADS = 512, NWAVES = 8;
constexpr int LDS_BYTES = 96 * 1024;

constexpr size_t MiB = (size_t)1 << 20;
constexpr size_t WS_WIN = 0;
constexpr size_t WS_WMKV = 22 * MiB;
constexpr size_t WS_WSB = 26 * MiB, WS_WML = 28 * MiB, WS_WX = 30 * MiB, WS_WOUT = 32 * MiB;
constexpr size_t WS_WFF1 = 34 * MiB;
constexpr size_t WS_WFF2 = 42 * MiB;
constexpr size_t WS_IF = 50 * MiB;
constexpr size_t WS_SLOT0 = 64 * MiB, SLOT_BYTES = 64 * MiB;
constexpr size_t WS_NEED = WS_SLOT0 + 7 * SLOT_BYTES;
constexpr size_t DO_MEMN = 0;
constexpr size_t DO_MEMKV = 4 * MiB;
constexpr size_t DO_HUN = 64 * MiB;

struct Params { const float* in[20]; float* out; unsigned char* ws; };

__device__ __forceinline__ unsigned f2bf(float f) { unsigned u = __builtin_bit_cast(unsigned, f); return (u + 0x7fffu + ((u >> 16) & 1u)) >> 16; }
__device__ __forceinline__ unsigned pk2(float lo, float hi) { return f2bf(lo) | (f2bf(hi) << 16); }
__device__ __forceinline__ float bf2f(bf16_t v) { return __builtin_bit_cast(float, (unsigned)v << 16); }
__device__ __forceinline__ float bflo(unsigned w) { return __builtin_bit_cast(float, w << 16); }
__device__ __forceinline__ float bfhi(unsigned w) { return __builtin_bit_cast(float, w & 0xffff0000u); }
__device__ __forceinline__ float wave_sum(float v) {
#pragma unroll
    for (int o = 1; o < 64; o <<= 1) v += __shfl_xor(v, o);
    return v;
}
__device__ __forceinline__ float wave_max(float v) {
#pragma unroll
    for (int o = 1; o < 64; o <<= 1) v = fmaxf(v, __shfl_xor(v, o));
    return v;
}
__device__ __forceinline__ float sigmoidf_(float x) { return 1.f / (1.f + __expf(-x)); }
#define LDS_WAIT() asm volatile("s_waitcnt lgkmcnt(0)" ::: "memory")

__device__ __forceinline__ void transpose_item(const float* W, int ldw, int K, bf16_t* WT, int k0, int n0, float* scr, int lane) {
#pragma unroll 8
    for (int i = 0; i < 32; ++i) { const int kk = 2 * i + (lane >> 5); scr[kk * 33 + (lane & 31)] = W[(size_t)(k0 + kk) * ldw + n0 + (lane & 31)]; }
    LDS_WAIT();
    const int c = lane & 7;
#pragma unroll
    for (int j = 0; j < 4; ++j) { const int n = (lane >> 3) + 8 * j; const float* s = scr + (8 * c) * 33 + n;
        u32x4 o; o.x = pk2(s[0 * 33], s[1 * 33]); o.y = pk2(s[2 * 33], s[3 * 33]); o.z = pk2(s[4 * 33], s[5 * 33]); o.w = pk2(s[6 * 33], s[7 * 33]);
        *(u32x4*)(WT + (size_t)(n0 + n) * K + k0 + 8 * c) = o; }
    LDS_WAIT();
}
__device__ __forceinline__ void transpose_matrix(const float* W, int ldw, int K, int N, bf16_t* WT, float* scr, int gw, int NGW, int lane) {
    const int nblk = N / 32, items = (K / 64) * nblk;
    for (int it = gw; it < items; it += NGW) { const int kb = it / nblk, nb = it % nblk; transpose_item(W, ldw, K, WT, 64 * kb, 32 * nb, scr, lane); }
}

template <bool WITH_IF>
__device__ __forceinline__ void rms_row(const float* xrow, const float* g, bf16_t* orow, const float* w_in, const float* b_if, float* ifout, int lane) {
    const f32x4* xr = (const f32x4*)xrow + lane; const f32x4* gr = (const f32x4*)g + lane;
    f32x4 v[4]; float s = 0.f;
#pragma unroll
    for (int j = 0; j < 4; ++j) { v[j] = xr[64 * j]; s += (v[j].x * v[j].x + v[j].y * v[j].y) + (v[j].z * v[j].z + v[j].w * v[j].w); }
    const float r = rsqrtf(wave_sum(s) * (1.f / D) + EPS);
#pragma unroll
    for (int j = 0; j < 4; ++j) v[j] = v[j] * r * gr[64 * j];
    u32x2* o8 = (u32x2*)orow + lane;
#pragma unroll
    for (int j = 0; j < 4; ++j) { u32x2 w; w.x = pk2(v[j].x, v[j].y); w.y = pk2(v[j].z, v[j].w); o8[64 * j] = w; }
    if (WITH_IF) {
        float a[8];
#pragma unroll
        for (int e = 0; e < 8; ++e) a[e] = 0.f;
#pragma unroll
        for (int j = 0; j < 4; ++j)
#pragma unroll
            for (int i = 0; i < 4; ++i) { const int k = 256 * j + 4 * lane + i; const f32x4* wp = (const f32x4*)(w_in + (size_t)k * NIN + IF_COL); const f32x4 w0 = wp[0], w1 = wp[1]; const float hv = v[j][i];
                a[0] += hv * w0.x; a[1] += hv * w0.y; a[2] += hv * w0.z; a[3] += hv * w0.w; a[4] += hv * w1.x; a[5] += hv * w1.y; a[6] += hv * w1.z; a[7] += hv * w1.w; }
#pragma unroll
        for (int e = 0; e < 8; ++e) a[e] = wave_sum(a[e]);
        if (lane == 0) {
#pragma unroll
            for (int e = 0; e < 8; ++e) ifout[e] = a[e] + b_if[e]; }
    }
}

template <class Epi>
__device__ __forceinline__ void gemm_simple(const bf16_t* A, const bf16_t* Bt, int M, int N, int K, const Epi& E) {
    const int tid = threadIdx.x, wid = tid >> 6, lane = tid & 63, wr = wid >> 2, wc = wid & 3, fr = lane & 15, fq = lane >> 4;
    const int nM = M / 128, nN = N / 128, nU = nM * nN;
    for (int u = blockIdx.x; u < nU; u += gridDim.x) {
        const int pm = u / nN, pn = u % nN;
        const int row0 = pm * 128 + wr * 64, col0 = pn * 128 + wc * 32;
        f32x4 acc[4][2];
#pragma unroll
        for (int m = 0; m < 4; ++m)
#pragma unroll
            for (int n = 0; n < 2; ++n) acc[m][n] = (f32x4){0.f, 0.f, 0.f, 0.f};
        const bf16_t* ap = A + (size_t)(row0 + fr) * K + fq * 8;
        const bf16_t* bp = Bt + (size_t)(col0 + fr) * K + fq * 8;
        for (int k0 = 0; k0 < K; k0 += 32) {
            bf16x8 a[4], b[2];
#pragma unroll
            for (int m = 0; m < 4; ++m) a[m] = *(const bf16x8*)(ap + (size_t)m * 16 * K + k0);
#pragma unroll
            for (int n = 0; n < 2; ++n) b[n] = *(const bf16x8*)(bp + (size_t)n * 16 * K + k0);
#pragma unroll
            for (int m = 0; m < 4; ++m)
#pragma unroll
                for (int n = 0; n < 2; ++n) acc[m][n] = __builtin_amdgcn_mfma_f32_16x16x32_bf16(b[n], a[m], acc[m][n], 0, 0, 0);
        }
#pragma unroll
        for (int m = 0; m < 4; ++m)
#pragma unroll
            for (int n = 0; n < 2; ++n) E(row0 + m * 16 + fr, col0 + n * 16 + 4 * fq, acc[m][n]);
    }
}

struct EpiBf16 { bf16_t* O; int ldc;
    __device__ __forceinline__ void operator()(int r, int c, f32x4 v) const { u32x2 w; w.x = pk2(v.x, v.y); w.y = pk2(v.z, v.w); *(u32x2*)(O + (size_t)r * ldc + c) = w; } };
struct EpiGate { bf16_t* S0; const float* bias;
    __device__ __forceinline__ void operator()(int r, int c, f32x4 v) const { const f32x4 b = *(const f32x4*)(bias + c); const int s = c >> 10, cc = c & 1023; bf16_t* O = S0 + (size_t)(3 + s + (s > 0 ? 1 : 0)) * (SLOT_BYTES / 2);
        u32x2 w; w.x = pk2(sigmoidf_(v.x + b.x), sigmoidf_(v.y + b.y)); w.y = pk2(sigmoidf_(v.z + b.z), sigmoidf_(v.w + b.w)); *(u32x2*)(O + (size_t)r * D + cc) = w; } };
template <int MODE>
struct EpiMix { const bf16_t* G; float* Mx; bf16_t* O;
    __device__ __forceinline__ void operator()(int r, int c, f32x4 v) const { const size_t off = (size_t)r * D + c; const u32x2 gw = *(const u32x2*)(G + off);
        f32x4 m = (f32x4){bflo(gw.x) * v.x, bfhi(gw.x) * v.y, bflo(gw.y) * v.z, bfhi(gw.y) * v.w};
        if (MODE >= 1) m = m + *(const f32x4*)(Mx + off);
        if (MODE <= 1) *(f32x4*)(Mx + off) = m; else { u32x2 w; w.x = pk2(m.x, m.y); w.y = pk2(m.z, m.w); *(u32x2*)(O + off) = w; } } };
struct EpiResid { const float* base; float* out;
    __device__ __forceinline__ void operator()(int r, int c, f32x4 v) const { const size_t off = (size_t)r * D + c; *(f32x4*)(out + off) = *(const f32x4*)(base + off) + v; } };
struct EpiRelu2 { bf16_t* O; int ldc;
    __device__ __forceinline__ void operator()(int r, int c, f32x4 v) const { f32x4 t = (f32x4){fmaxf(v.x, 0.f), fmaxf(v.y, 0.f), fmaxf(v.z, 0.f), fmaxf(v.w, 0.f)}; t = t * t;
        u32x2 w; w.x = pk2(t.x, t.y); w.y = pk2(t.z, t.w); *(u32x2*)(O + (size_t)r * ldc + c) = w; } };

__device__ __forceinline__ void sb_naive(bf16_t* Q, const bf16_t* Kk, const bf16_t* VT, float* qs, int gw, int NGW, int lane) {
    const float scale = 0.08838834764831845f;
    for (int w = gw; w < 2048; w += NGW) {
        for (int i = 0; i < 128; ++i) {
            const int bh = i >> 1, t = (i & 1) ? (SEQ - 1 - w) : w, b = bh >> 3, h = bh & 7;
            const size_t row = (size_t)b * SEQ + t;
            bf16_t* qrow = Q + row * D + h * 128;
            { const unsigned qw = *(const unsigned*)(qrow + 2 * lane); qs[2 * lane] = bflo(qw) * scale; qs[2 * lane + 1] = bfhi(qw) * scale; }
            LDS_WAIT();
            float acc[128];
#pragma unroll
            for (int d = 0; d < 128; ++d) acc[d] = 0.f;
            float R = 0.f;
            const int nb = (t + 63) >> 6;
            for (int blk = nb - 1; blk >= 0; --blk) {
                const int s = blk * 64 + lane; const bool valid = s < t;
                const bf16_t* krow = Kk + ((size_t)b * SEQ + s) * D + h * 128;
                float z = 0.f;
#pragma unroll
                for (int c = 0; c < 16; ++c) { const u32x4 kw = *(const u32x4*)(krow + 8 * c); const f32x4 q0 = *(const f32x4*)(qs + 8 * c), q1 = *(const f32x4*)(qs + 8 * c + 4);
                    z += bflo(kw.x) * q0.x + bfhi(kw.x) * q0.y + bflo(kw.y) * q0.z + bfhi(kw.y) * q0.w + bflo(kw.z) * q1.x + bfhi(kw.z) * q1.y + bflo(kw.w) * q1.z + bfhi(kw.w) * q1.w; }
                const float e = __expf(-fabsf(z)); const float sp = fmaxf(z, 0.f) + __logf(1.f + e);
                const float lm = valid ? -sp : 0.f, ls = z - sp;
                float incl = lm;
#pragma unroll
                for (int off = 1; off < 64; off <<= 1) { const float tmp = __shfl_down(incl, off); if (lane + off < 64) incl += tmp; }
                const float later = R + incl - lm;
                const float p = valid ? __expf(ls + later) : 0.f;
                R += __shfl(incl, 0);
                const bf16_t* vcol = VT + (size_t)(h * 128) * T + (size_t)b * SEQ + s;
#pragma unroll
                for (int d0 = 0; d0 < 128; d0 += 16) {
#pragma unroll
                    for (int d = d0; d < d0 + 16; ++d) acc[d] += p * bf2f(vcol[(size_t)d * T]);
                    asm volatile("" ::: "memory"); }
            }
            float o0 = 0.f, o1 = 0.f;
#pragma unroll
            for (int d = 0; d < 128; ++d) { const float tot = wave_sum(acc[d]); if ((d & 63) == lane) { if (d < 64) o0 = tot; else o1 = tot; } }
            qrow[lane] = (bf16_t)f2bf(o0); qrow[64 + lane] = (bf16_t)f2bf(o1);
            LDS_WAIT();
        }
    }
}

__device__ __forceinline__ void mlstm_naive(const bf16_t* MQ, const bf16_t* MK, const bf16_t* MVT, const float* ifp, const float* conv_w, const float* conv_b, bf16_t* HUN, float* lq) {
    const int tid = threadIdx.x, lane = tid & 63;
    for (int item = blockIdx.x; item < 256; item += gridDim.x) {
        const int bh = item >> 3, vs = item & 7, b = bh >> 2, h = bh & 3;
        const bool isk = tid >= 256; const int cc = h * 256 + (tid & 255), ch2 = (isk ? 1024 : 0) + cc;
        const bf16_t* src = (isk ? MK : MQ) + (size_t)b * SEQ * D + cc;
        const float w0 = conv_w[ch2], w1 = conv_w[2048 + ch2], w2 = conv_w[4096 + ch2], w3 = conv_w[6144 + ch2], cb = conv_b[ch2];
        const float osc = isk ? 0.0625f : 1.f;
        float r0 = 0.f, r1 = 0.f, r2 = 0.f;
        float C[16], n[16];
#pragma unroll
        for (int i = 0; i < 16; ++i) { C[i] = 0.f; n[i] = 0.f; }
        const int v = tid >> 4, kq = tid & 15;
        for (int t0 = 0; t0 < SEQ; t0 += 16) {
            float raw[16];
#pragma unroll
            for (int j = 0; j < 16; ++j) raw[j] = bf2f(src[(size_t)(t0 + j) * D]);
#pragma unroll
            for (int j = 0; j < 16; ++j) { const float u = w0 * r0 + w1 * r1 + w2 * r2 + w3 * raw[j] + cb; r0 = r1; r1 = r2; r2 = raw[j]; lq[j * 512 + tid] = u * sigmoidf_(u) * osc; }
            const size_t trow = (size_t)b * SEQ + t0 + kq;
            const float vv = bf2f(MVT[(size_t)(h * 256 + vs * 32 + v) * T + trow]);
            const float ei = __expf(ifp[trow * 8 + h]), fg = sigmoidf_(ifp[trow * 8 + 4 + h]);
            __syncthreads();
            float hkeep = 0.f;
#pragma unroll 1
            for (int j = 0; j < 16; ++j) {
                const int srcl = (lane & 48) | j;
                const float vj = __shfl(vv, srcl), eij = __shfl(ei, srcl), fj = __shfl(fg, srcl);
                const float ev = eij * vj;
                const f32x4* qp = (const f32x4*)(lq + j * 512 + 16 * kq); const f32x4* kp = (const f32x4*)(lq + j * 512 + 256 + 16 * kq);
                float pn = 0.f, pd = 0.f;
#pragma unroll
                for (int i4 = 0; i4 < 4; ++i4) { const f32x4 q4 = qp[i4], k4 = kp[i4];
#pragma unroll
                    for (int e = 0; e < 4; ++e) { const int i = 4 * i4 + e; C[i] = fj * C[i] + ev * k4[e]; n[i] = fj * n[i] + eij * k4[e]; pn += C[i] * q4[e]; pd += n[i] * q4[e]; } }
#pragma unroll
                for (int o = 1; o < 16; o <<= 1) { pn += __shfl_xor(pn, o); pd += __shfl_xor(pd, o); }
                const float hv = pn / fmaxf(fabsf(pd), 1.f);
                if (kq == j) hkeep = hv;
            }
            HUN[trow * D + h * 256 + vs * 32 + v] = (bf16_t)f2bf(hkeep);
            __syncthreads();
        }
    }
}

__device__ __forceinline__ void memk_norm(bf16_t* KV, const float* gk, int gw, int NGW, int lane) {
    for (int r = gw; r < TMEM * 4; r += NGW) { const int bm = r >> 2, h = r & 3; bf16_t* p = KV + (size_t)bm * 2048 + h * 256 + 4 * lane;
        const u32x2 w = *(const u32x2*)p; f32x4 v = (f32x4){bflo(w.x), bfhi(w.x), bflo(w.y), bfhi(w.y)};
        const float rs = rsqrtf(wave_sum(v.x * v.x + v.y * v.y + v.z * v.z + v.w * v.w) * (1.f / 256.f) + EPS);
        const f32x4 g = *(const f32x4*)(gk + 4 * lane); v = v * rs * g;
        u32x2 o; o.x = pk2(v.x, v.y); o.y = pk2(v.z, v.w); *(u32x2*)p = o; }
}
__device__ __forceinline__ void cross_naive(bf16_t* XQ, const bf16_t* KV, const float* gq, float* pw, int gw, int NGW, int lane) {
    for (int r = gw; r < T * 4; r += NGW) {
        const int t = r >> 2, h = r & 3, b = t >> 12;
        bf16_t* qp = XQ + (size_t)t * D + h * 256 + 4 * lane;
        const u32x2 w = *(const u32x2*)qp; f32x4 q = (f32x4){bflo(w.x), bfhi(w.x), bflo(w.y), bfhi(w.y)};
        const float rs = rsqrtf(wave_sum(q.x * q.x + q.y * q.y + q.z * q.z + q.w * q.w) * (1.f / 256.f) + EPS);
        q = q * rs * *(const f32x4*)(gq + 4 * lane);
        const bf16_t* kb = KV + (size_t)b * NMEM * 2048 + h * 256 + 4 * lane;
        float lg[4];
#pragma unroll
        for (int mi = 0; mi < 4; ++mi) { lg[mi] = 0.f;
            for (int mj = 0; mj < 64; ++mj) { const u32x2 kw = *(const u32x2*)(kb + (size_t)(mi * 64 + mj) * 2048);
                const float dsum = wave_sum(bflo(kw.x) * q.x + bfhi(kw.x) * q.y + bflo(kw.y) * q.z + bfhi(kw.y) * q.w); if (lane == mj) lg[mi] = dsum * 0.0625f; } }
        const float mx = wave_max(fmaxf(fmaxf(lg[0], lg[1]), fmaxf(lg[2], lg[3])));
        float ps = 0.f;
#pragma unroll
        for (int mi = 0; mi < 4; ++mi) { lg[mi] = __expf(lg[mi] - mx); ps += lg[mi]; }
        const float inv = 1.f / wave_sum(ps);
#pragma unroll
        for (int mi = 0; mi < 4; ++mi) pw[mi * 64 + lane] = lg[mi] * inv;
        LDS_WAIT();
        f32x4 o = (f32x4){0.f, 0.f, 0.f, 0.f};
        const bf16_t* vb = kb + 1024;
        for (int m = 0; m < 256; ++m) { const float pm = pw[m]; const u32x2 vw = *(const u32x2*)(vb + (size_t)m * 2048);
            o.x += pm * bflo(vw.x); o.y += pm * bfhi(vw.x); o.z += pm * bflo(vw.y); o.w += pm * bfhi(vw.y); }
        u32x2 ow; ow.x = pk2(o.x, o.y); ow.y = pk2(o.z, o.w); *(u32x2*)qp = ow;
        LDS_WAIT();
    }
}
__device__ __forceinline__ void ml_finalize(const bf16_t* HUN, const bf16_t* MO, const float* g, bf16_t* Y, int gw, int NGW, int lane) {
    for (int r = gw; r < T * 4; r += NGW) { const size_t off = (size_t)(r >> 2) * D + (r & 3) * 256 + 4 * lane;
        const u32x2 w = *(const u32x2*)(HUN + off); f32x4 v = (f32x4){bflo(w.x), bfhi(w.x), bflo(w.y), bfhi(w.y)};
        const float rs = rsqrtf(wave_sum(v.x * v.x + v.y * v.y + v.z * v.z + v.w * v.w) * (1.f / 256.f) + EPS);
        const f32x4 gg = *(const f32x4*)(g + (r & 3) * 256 + 4 * lane); const u32x2 ow = *(const u32x2*)(MO + off);
        v = v * rs * gg; v.x *= sigmoidf_(bflo(ow.x)); v.y *= sigmoidf_(bfhi(ow.x)); v.z *= sigmoidf_(bflo(ow.y)); v.w *= sigmoidf_(bfhi(ow.y));
        u32x2 o; o.x = pk2(v.x, v.y); o.y = pk2(v.z, v.w); *(u32x2*)(Y + off) = o; }
}

__global__ void __launch_bounds__(NTHREADS) fwd_megakernel(Params p) {
    extern __shared__ __attribute__((aligned(16))) unsigned char lds[];
    cg::grid_group grid = cg::this_grid();
    const int tid = threadIdx.x, lane = tid & 63, wave = tid >> 6;
    const int gw = blockIdx.x * NWAVES + wave, NGW = gridDim.x * NWAVES;
    unsigned char* ws = p.ws; unsigned char* dob = (unsigned char*)p.out;
    const float* x = p.in[0]; const float* mem = p.in[1]; const float* g_mix = p.in[2]; const float* w_in = p.in[3]; const float* b_if = p.in[4]; const float* b_gate = p.in[5];
    const float* conv_w = p.in[6]; const float* conv_b = p.in[7]; const float* ml_norm_g = p.in[8]; const float* g_mem = p.in[9]; const float* w_mem_kv = p.in[10];
    const float* q_norm_g = p.in[11]; const float* k_norm_g = p.in[12]; const float* w_sb = p.in[13]; const float* w_ml = p.in[14]; const float* w_x = p.in[15]; const float* w_out = p.in[16];
    const float* g_mlp = p.in[17]; const float* w_ff1 = p.in[18]; const float* w_ff2 = p.in[19];
    bf16_t* Wt_in = (bf16_t*)(ws + WS_WIN); bf16_t* Wt_mkv = (bf16_t*)(ws + WS_WMKV); bf16_t* Wt_sb = (bf16_t*)(ws + WS_WSB); bf16_t* Wt_ml = (bf16_t*)(ws + WS_WML);
    bf16_t* Wt_x = (bf16_t*)(ws + WS_WX); bf16_t* Wt_out = (bf16_t*)(ws + WS_WOUT); bf16_t* Wt_ff1 = (bf16_t*)(ws + WS_WFF1); bf16_t* Wt_ff2 = (bf16_t*)(ws + WS_WFF2);
    float* ifp = (float*)(ws + WS_IF);
#define SLOT(i) ((bf16_t*)(ws + WS_SLOT0 + (size_t)(i) * SLOT_BYTES))
    bf16_t* memn = (bf16_t*)(dob + DO_MEMN); bf16_t* memkv = (bf16_t*)(dob + DO_MEMKV); bf16_t* hun = (bf16_t*)(dob + DO_HUN);
    float* wscr = (float*)(lds + wave * 8448);

    transpose_matrix(w_in, NIN, D, 7168, Wt_in, wscr, gw, NGW, lane);
    transpose_matrix(w_in + 7176, NIN, D, 4096, Wt_in + (size_t)7168 * D, wscr, gw, NGW, lane);
    transpose_matrix(w_mem_kv, 2048, D, 2048, Wt_mkv, wscr, gw, NGW, lane);
    transpose_matrix(w_sb, D, D, D, Wt_sb, wscr, gw, NGW, lane);
    transpose_matrix(w_ml, D, D, D, Wt_ml, wscr, gw, NGW, lane);
    transpose_matrix(w_x, D, D, D, Wt_x, wscr, gw, NGW, lane);
    transpose_matrix(w_out, D, D, D, Wt_out, wscr, gw, NGW, lane);
    transpose_matrix(w_ff1, FF, D, FF, Wt_ff1, wscr, gw, NGW, lane);
    transpose_matrix(w_ff2, D, FF, D, Wt_ff2, wscr, gw, NGW, lane);
    for (int m = gw; m < T; m += NGW) rms_row<true>(x + (size_t)m * D, g_mix, SLOT(0) + (size_t)m * D, w_in, b_if, ifp + (size_t)m * 8, lane);
    for (int m = gw; m < TMEM; m += NGW) rms_row<false>(mem + (size_t)m * D, g_mem, memn + (size_t)m * D, nullptr, nullptr, nullptr, lane);
    grid.sync();

    { const bf16_t* hN = SLOT(0);
      gemm_simple(hN, Wt_in + (size_t)0 * D, T, 1024, D, EpiBf16{SLOT(1), D});
      gemm_simple(hN, Wt_in + (size_t)1024 * D, T, 1024, D, EpiBf16{SLOT(2), D});
      gemm_simple(Wt_in + (size_t)2048 * D, hN, 1024, T, D, EpiBf16{SLOT(3), T});
      gemm_simple(hN, Wt_in + (size_t)3072 * D, T, 1024, D, EpiBf16{SLOT(4), D});
      gemm_simple(hN, Wt_in + (size_t)4096 * D, T, 1024, D, EpiBf16{SLOT(5), D});
      gemm_simple(Wt_in + (size_t)5120 * D, hN, 1024, T, D, EpiBf16{SLOT(6), T});
      gemm_simple(memn, Wt_mkv, TMEM, 2048, D, EpiBf16{memkv, 2048}); }
    grid.sync();

    memk_norm(memkv, k_norm_g, gw, NGW, lane);
    mlstm_naive(SLOT(4), SLOT(5), SLOT(6), ifp, conv_w, conv_b, hun, (float*)lds);
    __syncthreads();
    sb_naive(SLOT(1), SLOT(2), SLOT(3), wscr, gw, NGW, lane);
    grid.sync();

    gemm_simple(SLOT(0), Wt_in + (size_t)7168 * D, T, 1024, D, EpiBf16{SLOT(2), D});
    gemm_simple(SLOT(0), Wt_in + (size_t)6144 * D, T, 1024, D, EpiBf16{SLOT(3), D});
    grid.sync();

    cross_naive(SLOT(2), memkv, q_norm_g, wscr, gw, NGW, lane);
    ml_finalize(hun, SLOT(3), ml_norm_g, SLOT(4), gw, NGW, lane);
    grid.sync();

    gemm_simple(SLOT(0), Wt_in + (size_t)8192 * D, T, 3072, D, EpiGate{SLOT(0), b_gate});
    grid.sync();

    gemm_simple(SLOT(1), Wt_sb, T, D, D, EpiMix<0>{SLOT(3), p.out, nullptr});
    grid.sync();
    gemm_simple(SLOT(4), Wt_ml, T, D, D, EpiMix<1>{SLOT(5), p.out, nullptr});
    grid.sync();
    gemm_simple(SLOT(2), Wt_x, T, D, D, EpiMix<2>{SLOT(6), p.out, SLOT(0)});
    grid.sync();

    gemm_simple(SLOT(0), Wt_out, T, D, D, EpiResid{x, p.out});
    grid.sync();

    for (int m = gw; m < T; m += NGW) rms_row<false>(p.out + (size_t)m * D, g_mlp, SLOT(1) + (size_t)m * D, nullptr, nullptr, nullptr, lane);
    grid.sync();

    gemm_simple(SLOT(1), Wt_ff1, T, FF, D, EpiRelu2{SLOT(2), FF});
    grid.sync();

    gemm_simple(SLOT(2), Wt_ff2, T, D, FF, EpiResid{p.out, p.out});
}

extern "C" void kernel_launch(void* const* d_in, const int* in_sizes, int n_in, void* d_out, int out_size, void* d_ws, size_t ws_size, hipStream_t stream) {
    static int grid_blocks = 0;
    if (grid_blocks == 0) {
        if (n_in != 20 || out_size != T * D || ws_size < WS_NEED) { fprintf(stderr, "kernel_launch: unexpected shapes (n_in %d out %d ws %zu)\n", n_in, out_size, ws_size); grid_blocks = -1; return; }
        int dev = 0, cus = 0, per_cu = 0;
        hipGetDevice(&dev);
        hipDeviceGetAttribute(&cus, hipDeviceAttributeMultiprocessorCount, dev);
        hipFuncSetAttribute((const void*)fwd_megakernel, hipFuncAttributeMaxDynamicSharedMemorySize, LDS_BYTES);
        hipOccupancyMaxActiveBlocksPerMultiprocessor(&per_cu, (const void*)fwd_megakernel, NTHREADS, LDS_BYTES);
        if (per_cu < 1) per_cu = 1;
        grid_blocks = cus * per_cu;
    }
    if (grid_blocks < 0) return;
    Params p{};
    for (int i = 0; i < 20; ++i) p.in[i] = (const float*)d_in[i];
    p.out = (float*)d_out; p.ws = (unsigned char*)d_ws;
    void* args[] = {&p};
    hipError_t e = hipLaunchCooperativeKernel((const void*)fwd_megakernel, dim3(grid_blocks), dim3(NTHREADS), args, LDS_BYTES, stream);
    if (e != hipSuccess) fprintf(stderr, "cooperative launch failed: %s (grid %d)\n", hipGetErrorString(e), grid_blocks);
}
```

```cpp
#include <hip/hip_runtime.h>
#include <hip/hip_cooperative_groups.h>
#include <cstdint>
#include <cstdio>
namespace cg = cooperative_groups;

typedef unsigned short bf16_t;
typedef short bf16x8 __attribute__((ext_vector_type(8)));
typedef float f32x4 __attribute__((ext_vector_type(4)));
typedef unsigned u32x2 __attribute__((ext_vector_type(2)));
typedef unsigned u32x4 __attribute__((ext_vector_type(4)));

constexpr int D = 1024, BATCH = 8, SEQ = 4096, T = BATCH * SEQ, NMEM = 256, TMEM = BATCH * NMEM, FF = 4096;
constexpr int NIN = 11272;
constexpr int IF_COL = 7168;
constexpr float EPS = 1e-6f;
constexpr int NTHREADS = 512, NWAVES = 8;
constexpr int LDS_BYTES = 144 * 1024;

constexpr size_t MiB = (size_t)1 << 20;
constexpr size_t WS_WIN = 0;
constexpr size_t WS_WMKV = 22 * MiB;
constexpr size_t WS_WSB = 26 * MiB, WS_WML = 28 * MiB, WS_WX = 30 * MiB, WS_WOUT = 32 * MiB;
constexpr size_t WS_WFF1 = 34 * MiB;
constexpr size_t WS_WFF2 = 42 * MiB;
constexpr size_t WS_IF = 50 * MiB;
constexpr size_t WS_SLOT0 = 64 * MiB, SLOT_BYTES = 64 * MiB;
constexpr size_t WS_NEED = WS_SLOT0 + 7 * SLOT_BYTES;
constexpr size_t DO_MEMN = 0;
constexpr size_t DO_MEMKV = 4 * MiB;
constexpr size_t DO_HUN = 64 * MiB;

struct Params { const float* in[20]; float* out; unsigned char* ws; };

__device__ __forceinline__ unsigned f2bf(float f) { unsigned u = __builtin_bit_cast(unsigned, f); return (u + 0x7fffu + ((u >> 16) & 1u)) >> 16; }
__device__ __forceinline__ unsigned pk2(float lo, float hi) { return f2bf(lo) | (f2bf(hi) << 16); }
__device__ __forceinline__ float bf2f(bf16_t v) { return __builtin_bit_cast(float, (unsigned)v << 16); }
__device__ __forceinline__ float bflo(unsigned w) { return __builtin_bit_cast(float, w << 16); }
__device__ __forceinline__ float bfhi(unsigned w) { return __builtin_bit_cast(float, w & 0xffff0000u); }
__device__ __forceinline__ float wave_sum(float v) {
#pragma unroll
    for (int o = 1; o < 64; o <<= 1) v += __shfl_xor(v, o);
    return v;
}
__device__ __forceinline__ float wave_max(float v) {
#pragma unroll
    for (int o = 1; o < 64; o <<= 1) v = fmaxf(v, __shfl_xor(v, o));
    return v;
}
__device__ __forceinline__ float sigmoidf_(float x) { return 1.f / (1.f + __expf(-x)); }
#define LDS_WAIT() asm volatile("s_waitcnt lgkmcnt(0)" ::: "memory")

__device__ __forceinline__ void transpose_item(const float* W, int ldw, int K, bf16_t* WT, int k0, int n0, float* scr, int lane) {
#pragma unroll 8
    for (int i = 0; i < 32; ++i) { const int kk = 2 * i + (lane >> 5); scr[kk * 33 + (lane & 31)] = W[(size_t)(k0 + kk) * ldw + n0 + (lane & 31)]; }
    LDS_WAIT();
    const int c = lane & 7;
#pragma unroll
    for (int j = 0; j < 4; ++j) { const int n = (lane >> 3) + 8 * j; const float* s = scr + (8 * c) * 33 + n;
        u32x4 o; o.x = pk2(s[0 * 33], s[1 * 33]); o.y = pk2(s[2 * 33], s[3 * 33]); o.z = pk2(s[4 * 33], s[5 * 33]); o.w = pk2(s[6 * 33], s[7 * 33]);
        *(u32x4*)(WT + (size_t)(n0 + n) * K + k0 + 8 * c) = o; }
    LDS_WAIT();
}
__device__ __forceinline__ void transpose_matrix(const float* W, int ldw, int K, int N, bf16_t* WT, float* scr, int gw, int NGW, int lane) {
    const int nblk = N / 32, items = (K / 64) * nblk;
    for (int it = gw; it < items; it += NGW) { const int kb = it / nblk, nb = it % nblk; transpose_item(W, ldw, K, WT, 64 * kb, 32 * nb, scr, lane); }
}

template <bool WITH_IF>
__device__ __forceinline__ void rms_row(const float* xrow, const float* g, bf16_t* orow, const float* w_in, const float* b_if, float* ifout, int lane) {
    const f32x4* xr = (const f32x4*)xrow + lane; const f32x4* gr = (const f32x4*)g + lane;
    f32x4 v[4]; float s = 0.f;
#pragma unroll
    for (int j = 0; j < 4; ++j) { v[j] = xr[64 * j]; s += (v[j].x * v[j].x + v[j].y * v[j].y) + (v[j].z * v[j].z + v[j].w * v[j].w); }
    const float r = rsqrtf(wave_sum(s) * (1.f / D) + EPS);
#pragma unroll
    for (int j = 0; j < 4; ++j) v[j] = v[j] * r * gr[64 * j];
    u32x2* o8 = (u32x2*)orow + lane;
#pragma unroll
    for (int j = 0; j < 4; ++j) { u32x2 w; w.x = pk2(v[j].x, v[j].y); w.y = pk2(v[j].z, v[j].w); o8[64 * j] = w; }
    if (WITH_IF) {
        float a[8];
#pragma unroll
        for (int e = 0; e < 8; ++e) a[e] = 0.f;
#pragma unroll
        for (int j = 0; j < 4; ++j)
#pragma unroll
            for (int i = 0; i < 4; ++i) { const int k = 256 * j + 4 * lane + i; const f32x4* wp = (const f32x4*)(w_in + (size_t)k * NIN + IF_COL); const f32x4 w0 = wp[0], w1 = wp[1]; const float hv = v[j][i];
                a[0] += hv * w0.x; a[1] += hv * w0.y; a[2] += hv * w0.z; a[3] += hv * w0.w; a[4] += hv * w1.x; a[5] += hv * w1.y; a[6] += hv * w1.z; a[7] += hv * w1.w; }
#pragma unroll
        for (int e = 0; e < 8; ++e) a[e] = wave_sum(a[e]);
        if (lane == 0) {
#pragma unroll
            for (int e = 0; e < 8; ++e) ifout[e] = a[e] + b_if[e]; }
    }
}

namespace pg8 {
#define PG8_LAS __attribute__((address_space(3)))
typedef unsigned short bf16_t;
typedef short bf16x8 __attribute__((ext_vector_type(8)));
typedef float f32x4 __attribute__((ext_vector_type(4)));
typedef unsigned u32x4 __attribute__((ext_vector_type(4)));
constexpr int BM = 256, BK = 64, HALF = 128, HTB = HALF * BK * 2  , STAGE_BYTES = 8 * HTB, NXCD = 8, WGM = 8;

__host__ __device__ __forceinline__ int lds_byte(int r, int c) { const int st = (r >> 4) * 2 + (c >> 5), rr = r & 15, cc = c & 31, ob = rr * 64 + cc * 2; return st * 1024 + (ob ^ (((ob >> 9) & 1) << 5)); }
__host__ __device__ __forceinline__ void stage_rc(int b, int& R, int& C) { const int st = b / 1024, sb = b % 1024, swz = sb ^ (((sb >> 9) & 1) << 5); R = (st >> 1) * 16 + swz / 64; C = (st & 1) * 32 + (swz % 64) / 2; }
__host__ __device__ __forceinline__ int perm32(int rho) { const int n = rho >> 4, i = rho & 15; return 8 * (i >> 2) + 4 * n + (i & 3); }

struct Unit { int pm, pn; };
struct Gemm { const bf16_t* A; const bf16_t* Bt; int M, N, K; };

struct StaticOrder {
    int nM, nN, nwg, G, c;
    __host__ __device__ void init(int M, int N, int G_, int c_) { nM = M / BM; nN = N / BM; nwg = nM * nN; G = G_; c = c_; }
    __host__ __device__ bool next(int i, Unit& u) const {
        const long L = (long)i * G + c; if (L >= nwg) return false;
        int wgid = (int)L; { const int q = nwg / NXCD, r = nwg % NXCD, xcd = wgid % NXCD, off = wgid / NXCD; wgid = (xcd < r ? xcd * (q + 1) : r * (q + 1) + (xcd - r) * q) + off; }
        const int nig = WGM * nN, gid = wgid / nig, fm = gid * WGM, gsz = (nM - fm) < WGM ? (nM - fm) : WGM;
        u.pm = fm + ((wgid % nig) % gsz); u.pn = (wgid % nig) / gsz; return true;
    }
    __device__ __forceinline__ void a_ready(const Unit&) const {}
    __device__ __forceinline__ void done(const Unit&) const {}
};
template <class Epi, class Sched, bool ALIGN_EPI = false, bool SP2 = false>
__device__ __forceinline__ void gemm_phase(PG8_LAS unsigned char* lds, const Gemm g, const Sched& S, const Epi& E) {
    int tid_ = threadIdx.x; asm volatile("" : "+v"(tid_));
    const int tid = tid_, wid = __builtin_amdgcn_readfirstlane(tid >> 6), lane = tid & 63, wr = wid >> 2, wc = wid & 3, fr = lane & 15, fq = lane >> 4;
    const int K = g.K, nt = K / BK;
    unsigned voffA[2], voffB[2];
#pragma unroll
    for (int i = 0; i < 2; ++i) { int R, C; stage_rc(tid * 16 + i * 8192, R, C); const int Rb = Epi::PERM ? ((R & ~31) + perm32(R & 31)) : R;
        voffA[i] = (unsigned)(R * K + C) * 2u; voffB[i] = (unsigned)(Rb * K + C) * 2u; }
    const size_t kstep = (size_t)(BK * 2);
    const size_t hstep = (size_t)HALF * K * 2;
    const size_t tstep = 2 * hstep;
    const unsigned ldsw = (unsigned)wid * 1024u;
    const int aoff = lds_byte(wr * 64 + fr, fq * 8), boff = lds_byte(wc * 32 + fr, fq * 8);
#define PG8_SA(b, h) (((b) * 2 + (h)) * HTB)
#define PG8_SB(b, h) ((4 + (b) * 2 + (h)) * HTB)
#define PG8_STAGE(bufoff, gbase, voff) do { _Pragma("unroll") for (int _i = 0; _i < 2; ++_i) \
        __builtin_amdgcn_global_load_lds((const unsigned*)((const char*)(gbase) + (voff)[_i]), (PG8_LAS unsigned*)(lds + (bufoff) + ldsw + _i * 8192), 16, 0, 0); } while (0)
#define PG8_LDA(dst, b, h) do { _Pragma("unroll") for (int m = 0; m < 4; ++m) _Pragma("unroll") for (int k = 0; k < 2; ++k) dst[m][k] = *(const PG8_LAS bf16x8*)(lds + PG8_SA(b, h) + aoff + m * 2048 + k * 1024); } while (0)
#define PG8_LDB(dst, b, h) do { _Pragma("unroll") for (int n = 0; n < 2; ++n) _Pragma("unroll") for (int k = 0; k < 2; ++k) dst[n][k] = *(const PG8_LAS bf16x8*)(lds + PG8_SB(b, h) + boff + n * 2048 + k * 1024); } while (0)
#define PG8_MMA(ai, bj, At, Bt) do { __builtin_amdgcn_s_setprio(1); _Pragma("unroll") for (int m = 0; m < 4; ++m) _Pragma("unroll") for (int n = 0; n < 2; ++n) _Pragma("unroll") for (int k = 0; k < 2; ++k) \
        acc[ai][bj][m][n] = __builtin_amdgcn_mfma_f32_16x16x32_bf16(Bt[n][k], At[m][k], acc[ai][bj][m][n], 0, 0, 0); __builtin_amdgcn_s_setprio(0); } while (0)
#define PG8_WAIT_V(n) asm volatile("s_waitcnt vmcnt(" #n ")" ::: "memory")
#define PG8_WAIT_L(n) asm volatile("s_waitcnt lgkmcnt(" #n ")" ::: "memory")
#define PG8_BAR __builtin_amdgcn_s_barrier()
#define PG8_SCHED __builtin_amdgcn_sched_barrier(0)
    Unit cur, nxt; int ui = 0;
    if (!S.next(0, cur)) return;
    f32x4 acc[2][2][4][2];
#pragma unroll
    for (int a = 0; a < 2; ++a)
#pragma unroll
        for (int b = 0; b < 2; ++b)
#pragma unroll
            for (int m = 0; m < 4; ++m)
#pragma unroll
                for (int n = 0; n < 2; ++n) acc[a][b][m][n] = (f32x4){0.f, 0.f, 0.f, 0.f};
    bf16x8 At[4][2], B0[2][2], B1[2][2];
    const char* cA = (const char*)g.A + (size_t)cur.pm * tstep; const char* cB = (const char*)g.Bt + (size_t)cur.pn * tstep;
    S.a_ready(cur);
    if constexpr (SP2) {
        PG8_STAGE(PG8_SB(0, 0), cB, voffB); PG8_STAGE(PG8_SB(0, 1), cB + hstep, voffB); PG8_STAGE(PG8_SA(0, 0), cA, voffA); PG8_STAGE(PG8_SA(0, 1), cA + hstep, voffA);
        if (wr == 1) PG8_BAR;
        PG8_WAIT_V(2); PG8_BAR;
        PG8_STAGE(PG8_SB(1, 0), cB + kstep, voffB); PG8_STAGE(PG8_SA(1, 0), cA + kstep, voffA); PG8_STAGE(PG8_SB(1, 1), cB + hstep + kstep, voffB);
        PG8_WAIT_V(6); PG8_BAR;
    } else {
        PG8_STAGE(PG8_SB(0, 0), cB, voffB); PG8_STAGE(PG8_SA(0, 0), cA, voffA); PG8_STAGE(PG8_SB(0, 1), cB + hstep, voffB); PG8_STAGE(PG8_SA(0, 1), cA + hstep, voffA);
        if (wr == 1) PG8_BAR;
        PG8_WAIT_V(4); PG8_BAR;
        PG8_STAGE(PG8_SB(1, 0), cB + kstep, voffB); PG8_STAGE(PG8_SA(1, 0), cA + kstep, voffA); PG8_STAGE(PG8_SB(1, 1), cB + hstep + kstep, voffB);
        PG8_WAIT_V(6); PG8_BAR;
    }
    for (;;) {
        const bool has_next = S.next(ui + 1, nxt);
        const char* nA = has_next ? (const char*)g.A + (size_t)nxt.pm * tstep : cA; const char* nB = has_next ? (const char*)g.Bt + (size_t)nxt.pn * tstep : cB;
        for (int t = 0; t < nt; t += 2) {
            const bool last = (t == nt - 2);
            const char* a1 = cA + (size_t)(t + 1) * kstep;
            const char* a2 = last ? nA : cA + (size_t)(t + 2) * kstep; const char* b2 = last ? nB : cB + (size_t)(t + 2) * kstep;
            const char* a3 = a2 + kstep; const char* b3 = b2 + kstep;
            if (last && has_next) S.a_ready(nxt);
            if constexpr (SP2) {
            PG8_LDB(B0, 0, 0); PG8_LDB(B1, 0, 1); PG8_SCHED; PG8_LDA(At, 0, 0); PG8_STAGE(PG8_SA(1, 1), a1 + hstep, voffA);
            PG8_WAIT_V(8); PG8_WAIT_L(0); PG8_BAR; PG8_MMA(0, 0, At, B0); PG8_MMA(0, 1, At, B1); PG8_BAR; PG8_SCHED;
            PG8_LDA(At, 0, 1); PG8_STAGE(PG8_SB(0, 0), b2, voffB); PG8_STAGE(PG8_SB(0, 1), b2 + hstep, voffB); PG8_STAGE(PG8_SA(0, 0), a2, voffA);
            PG8_WAIT_V(8); PG8_WAIT_L(0); PG8_BAR; PG8_MMA(1, 0, At, B0); PG8_MMA(1, 1, At, B1); PG8_BAR; PG8_SCHED;
            PG8_LDB(B0, 1, 0); PG8_LDB(B1, 1, 1); PG8_SCHED; PG8_LDA(At, 1, 0); PG8_STAGE(PG8_SA(0, 1), a2 + hstep, voffA);
            PG8_WAIT_V(8); PG8_WAIT_L(0); PG8_BAR; PG8_MMA(0, 0, At, B0); PG8_MMA(0, 1, At, B1); PG8_BAR; PG8_SCHED;
            PG8_LDA(At, 1, 1); PG8_STAGE(PG8_SB(1, 0), b3, voffB); PG8_STAGE(PG8_SB(1, 1), b3 + hstep, voffB); PG8_STAGE(PG8_SA(1, 0), a3, voffA);
            PG8_WAIT_V(8); PG8_WAIT_L(0); PG8_BAR; PG8_MMA(1, 0, At, B0); PG8_MMA(1, 1, At, B1); PG8_BAR; PG8_SCHED;
            } else {
            PG8_LDB(B0, 0, 0); PG8_SCHED; PG8_LDA(At, 0, 0); PG8_STAGE(PG8_SA(1, 1), a1 + hstep, voffA);
            PG8_WAIT_L(8); PG8_BAR; PG8_WAIT_L(0); PG8_MMA(0, 0, At, B0); PG8_BAR; PG8_SCHED;
            PG8_LDB(B1, 0, 1); PG8_STAGE(PG8_SB(0, 0), b2, voffB);
            PG8_BAR; PG8_WAIT_L(0); PG8_MMA(0, 1, At, B1); PG8_BAR;
            PG8_LDA(At, 0, 1); PG8_STAGE(PG8_SA(0, 0), a2, voffA);
            PG8_BAR; PG8_WAIT_L(0); PG8_MMA(1, 0, At, B0); PG8_BAR; PG8_SCHED;
            PG8_STAGE(PG8_SB(0, 1), b2 + hstep, voffB);
            PG8_WAIT_V(6); PG8_BAR; PG8_MMA(1, 1, At, B1); PG8_BAR;
            PG8_LDB(B0, 1, 0); PG8_SCHED; PG8_LDA(At, 1, 0); PG8_STAGE(PG8_SA(0, 1), a2 + hstep, voffA);
            PG8_WAIT_L(8); PG8_BAR; PG8_WAIT_L(0); PG8_MMA(0, 0, At, B0); PG8_BAR; PG8_SCHED;
            PG8_LDB(B1, 1, 1); PG8_STAGE(PG8_SB(1, 0), b3, voffB);
            PG8_BAR; PG8_WAIT_L(0); PG8_MMA(0, 1, At, B1); PG8_BAR;
            PG8_LDA(At, 1, 1); PG8_STAGE(PG8_SA(1, 0), a3, voffA);
            PG8_BAR; PG8_WAIT_L(0); PG8_MMA(1, 0, At, B0); PG8_BAR; PG8_SCHED;
            PG8_STAGE(PG8_SB(1, 1), b3 + hstep, voffB);
            PG8_WAIT_V(6); PG8_BAR; PG8_MMA(1, 1, At, B1); PG8_BAR;
            }
        }
        if constexpr (ALIGN_EPI) { if (wr == 0) PG8_BAR; }
        if constexpr (!Epi::AFTER_DRAIN) { E(acc, cur, wr, wc, fr, fq); S.done(cur); }
        if (!has_next) break;
#pragma unroll
        for (int a = 0; a < 2; ++a)
#pragma unroll
            for (int b = 0; b < 2; ++b)
#pragma unroll
                for (int m = 0; m < 4; ++m)
#pragma unroll
                    for (int n = 0; n < 2; ++n) acc[a][b][m][n] = (f32x4){0.f, 0.f, 0.f, 0.f};
        cur = nxt; cA = nA; cB = nB; ++ui;
        if constexpr (ALIGN_EPI) { if (wr == 1) PG8_BAR; }
    }
    PG8_WAIT_V(0);
    if constexpr (!ALIGN_EPI) { if (wr == 0) PG8_BAR; }
    PG8_BAR;
    if constexpr (Epi::AFTER_DRAIN) { E.fused(acc, cur, wr, wc, fr, fq, lds, wid, lane); S.done(cur); }
#undef PG8_SA
#undef PG8_SB
#undef PG8_STAGE
#undef PG8_LDA
#undef PG8_LDB
#undef PG8_MMA
#undef PG8_WAIT_V
#undef PG8_WAIT_L
#undef PG8_BAR
#undef PG8_SCHED
}
}

template <class EW> struct EpiAdapt { static constexpr bool PERM = false, AFTER_DRAIN = false; EW e;
    __device__ __forceinline__ void operator()(const f32x4 (&acc)[2][2][4][2], const pg8::Unit& u, int wr, int wc, int fr, int fq) const {
#pragma unroll
        for (int ai = 0; ai < 2; ++ai)
#pragma unroll
            for (int m = 0; m < 4; ++m) { const int row = u.pm * 256 + ai * 128 + wr * 64 + m * 16 + fr;
#pragma unroll
                for (int bj = 0; bj < 2; ++bj)
#pragma unroll
                    for (int n = 0; n < 2; ++n) e(row, u.pn * 256 + bj * 128 + wc * 32 + n * 16 + 4 * fq, acc[ai][bj][m][n]); } } };
template <class EW>
__device__ __forceinline__ void gemm_fast(unsigned char* lds, const bf16_t* A, const bf16_t* Bt, int M, int N, int K, const EW& e) {
    pg8::Gemm g{A, Bt, M, N, K}; pg8::StaticOrder S; S.init(M, N, (int)gridDim.x, (int)blockIdx.x);
    EpiAdapt<EW> E{e};
    pg8::gemm_phase<EpiAdapt<EW>, pg8::StaticOrder, true, true>((PG8_LAS unsigned char*)lds, g, S, E);
}

struct EpiBf16 { bf16_t* O; int ldc;
    __device__ __forceinline__ void operator()(int r, int c, f32x4 v) const { u32x2 w; w.x = pk2(v.x, v.y); w.y = pk2(v.z, v.w); *(u32x2*)(O + (size_t)r * ldc + c) = w; } };
struct EpiGate { bf16_t* S0; const float* bias;
    __device__ __forceinline__ void operator()(int r, int c, f32x4 v) const { const f32x4 b = *(const f32x4*)(bias + c); const int s = c >> 10, cc = c & 1023; bf16_t* O = S0 + (size_t)(3 + s + (s > 0 ? 1 : 0)) * (SLOT_BYTES / 2);
        u32x2 w; w.x = pk2(sigmoidf_(v.x + b.x), sigmoidf_(v.y + b.y)); w.y = pk2(sigmoidf_(v.z + b.z), sigmoidf_(v.w + b.w)); *(u32x2*)(O + (size_t)r * D + cc) = w; } };
template <int MODE>
struct EpiMix { const bf16_t* G; float* Mx; bf16_t* O;
    __device__ __forceinline__ void operator()(int r, int c, f32x4 v) const { const size_t off = (size_t)r * D + c; const u32x2 gw = *(const u32x2*)(G + off);
        f32x4 m = (f32x4){bflo(gw.x) * v.x, bfhi(gw.x) * v.y, bflo(gw.y) * v.z, bfhi(gw.y) * v.w};
        if (MODE >= 1) m = m + *(const f32x4*)(Mx + off);
        if (MODE <= 1) *(f32x4*)(Mx + off) = m; else { u32x2 w; w.x = pk2(m.x, m.y); w.y = pk2(m.z, m.w); *(u32x2*)(O + off) = w; } } };
struct EpiResid { const float* base; float* out;
    __device__ __forceinline__ void operator()(int r, int c, f32x4 v) const { const size_t off = (size_t)r * D + c; *(f32x4*)(out + off) = *(const f32x4*)(base + off) + v; } };
struct EpiRelu2 { bf16_t* O; int ldc;
    __device__ __forceinline__ void operator()(int r, int c, f32x4 v) const { f32x4 t = (f32x4){fmaxf(v.x, 0.f), fmaxf(v.y, 0.f), fmaxf(v.z, 0.f), fmaxf(v.w, 0.f)}; t = t * t;
        u32x2 w; w.x = pk2(t.x, t.y); w.y = pk2(t.z, t.w); *(u32x2*)(O + (size_t)r * ldc + c) = w; } };

__device__ __forceinline__ void sb_naive(bf16_t* Q, const bf16_t* Kk, const bf16_t* VT, float* qs, int gw, int NGW, int lane) {
    const float scale = 0.08838834764831845f;
    for (int w = gw; w < 2048; w += NGW) {
        for (int i = 0; i < 128; ++i) {
            const int bh = i >> 1, t = (i & 1) ? (SEQ - 1 - w) : w, b = bh >> 3, h = bh & 7;
            const size_t row = (size_t)b * SEQ + t;
            bf16_t* qrow = Q + row * D + h * 128;
            { const unsigned qw = *(const unsigned*)(qrow + 2 * lane); qs[2 * lane] = bflo(qw) * scale; qs[2 * lane + 1] = bfhi(qw) * scale; }
            LDS_WAIT();
            float acc[128];
#pragma unroll
            for (int d = 0; d < 128; ++d) acc[d] = 0.f;
            float R = 0.f;
            const int nb = (t + 63) >> 6;
            for (int blk = nb - 1; blk >= 0; --blk) {
                const int s = blk * 64 + lane; const bool valid = s < t;
                const bf16_t* krow = Kk + ((size_t)b * SEQ + s) * D + h * 128;
                float z = 0.f;
#pragma unroll
                for (int c = 0; c < 16; ++c) { const u32x4 kw = *(const u32x4*)(krow + 8 * c); const f32x4 q0 = *(const f32x4*)(qs + 8 * c), q1 = *(const f32x4*)(qs + 8 * c + 4);
                    z += bflo(kw.x) * q0.x + bfhi(kw.x) * q0.y + bflo(kw.y) * q0.z + bfhi(kw.y) * q0.w + bflo(kw.z) * q1.x + bfhi(kw.z) * q1.y + bflo(kw.w) * q1.z + bfhi(kw.w) * q1.w; }
                const float e = __expf(-fabsf(z)); const float sp = fmaxf(z, 0.f) + __logf(1.f + e);
                const float lm = valid ? -sp : 0.f, ls = z - sp;
                float incl = lm;
#pragma unroll
                for (int off = 1; off < 64; off <<= 1) { const float tmp = __shfl_down(incl, off); if (lane + off < 64) incl += tmp; }
                const float later = R + incl - lm;
                const float p = valid ? __expf(ls + later) : 0.f;
                R += __shfl(incl, 0);
                const bf16_t* vcol = VT + (size_t)(h * 128) * T + (size_t)b * SEQ + s;
#pragma unroll
                for (int d0 = 0; d0 < 128; d0 += 16) {
#pragma unroll
                    for (int d = d0; d < d0 + 16; ++d) acc[d] += p * bf2f(vcol[(size_t)d * T]);
                    asm volatile("" ::: "memory"); }
            }
            float o0 = 0.f, o1 = 0.f;
#pragma unroll
            for (int d = 0; d < 128; ++d) { const float tot = wave_sum(acc[d]); if ((d & 63) == lane) { if (d < 64) o0 = tot; else o1 = tot; } }
            qrow[lane] = (bf16_t)f2bf(o0); qrow[64 + lane] = (bf16_t)f2bf(o1);
            LDS_WAIT();
        }
    }
}

#define LAS __attribute__((address_space(3)))
typedef float f32x16 __attribute__((ext_vector_type(16)));
constexpr int SB_KST = 272, SB_VST = 136, SB_KBYTES = 64 * SB_KST, SB_VBYTES = 128 * SB_VST, SB_BUF = SB_KBYTES + SB_VBYTES;
template <bool DIAG>
__device__ __forceinline__ void sb_subtile(LAS unsigned char* buf, int st, const bf16x8 (&qf)[8], f32x16 (&Y)[4], float& R, int k0, int qi, int r32, int hh) {
    f32x16 X;
#pragma unroll
    for (int r = 0; r < 16; ++r) X[r] = 0.f;
    LAS unsigned char* kp = buf + (32 * st + r32) * SB_KST + hh * 16;
#pragma unroll
    for (int s = 0; s < 8; ++s) { const bf16x8 kf = *(LAS bf16x8*)(kp + s * 32); X = __builtin_amdgcn_mfma_f32_32x32x16_bf16(kf, qf[s], X, 0, 0, 0); }
    float lm[16];
#pragma unroll
    for (int r = 0; r < 16; ++r) { const float z = X[r] * 0.08838834764831845f; const float e = __expf(-fabsf(z)); const float sp = fmaxf(z, 0.f) + __logf(1.f + e);
        const int key = k0 + (r & 3) + 8 * (r >> 2) + 4 * hh; const bool valid = !DIAG || key < qi;
        lm[r] = valid ? -sp : 0.f; X[r] = z - sp; }
    float g[4], og[4], pr[4];
#pragma unroll
    for (int c = 0; c < 4; ++c) { g[c] = (lm[4 * c] + lm[4 * c + 1]) + (lm[4 * c + 2] + lm[4 * c + 3]); og[c] = __shfl_xor(g[c], 32); pr[c] = g[c] + og[c]; }
    float Tc[4]; Tc[3] = 0.f; Tc[2] = pr[3]; Tc[1] = pr[3] + pr[2]; Tc[0] = Tc[1] + pr[1];
    const float total = Tc[0] + pr[0];
#pragma unroll
    for (int c = 0; c < 4; ++c) { float later = R + Tc[c] + (hh == 0 ? og[c] : 0.f);
#pragma unroll
        for (int i = 3; i >= 0; --i) { const int r = 4 * c + i; const int key = k0 + i + 8 * c + 4 * hh; const bool valid = !DIAG || key < qi;
            const float pv = valid ? __expf(X[r] + later) : 0.f; later += lm[r]; X[r] = pv; } }
    R += total;
    bf16x8 pf[2];
#pragma unroll
    for (int s2 = 0; s2 < 2; ++s2) { u32x4 w; w.x = pk2(X[8 * s2], X[8 * s2 + 1]); w.y = pk2(X[8 * s2 + 2], X[8 * s2 + 3]); w.z = pk2(X[8 * s2 + 4], X[8 * s2 + 5]); w.w = pk2(X[8 * s2 + 6], X[8 * s2 + 7]); pf[s2] = __builtin_bit_cast(bf16x8, w); }
#pragma unroll
    for (int dt = 0; dt < 4; ++dt) { LAS unsigned char* vp = buf + SB_KBYTES + (32 * dt + r32) * SB_VST + (32 * st + 4 * hh) * 2;
#pragma unroll
        for (int s2 = 0; s2 < 2; ++s2) { const u32x2 lo = *(LAS u32x2*)(vp + s2 * 32), hi = *(LAS u32x2*)(vp + s2 * 32 + 16);
            u32x4 w; w.x = lo.x; w.y = lo.y; w.z = hi.x; w.w = hi.y;
            Y[dt] = __builtin_amdgcn_mfma_f32_32x32x16_bf16(__builtin_bit_cast(bf16x8, w), pf[s2], Y[dt], 0, 0, 0); } }
}
__device__ __forceinline__ void sb_fast(bf16_t* Q, const bf16_t* Kk, const bf16_t* VT, LAS unsigned char* lds) {
    int tid_ = threadIdx.x; asm volatile("" : "+v"(tid_));
    const int tid = tid_, lane = tid & 63, wid = tid >> 6, r32 = lane & 31, hh = lane >> 5;
    for (int vw = blockIdx.x; vw < 256; vw += gridDim.x) {
        const int bh = vw >> 2, jj = vw & 3, b = bh >> 3, h = bh & 7;
        const bf16_t* kg = Kk + ((size_t)b * SEQ) * D + h * 128;
        const bf16_t* vg = VT + (size_t)(h * 128) * T + (size_t)b * SEQ;
        for (int ui = 0; ui < 4; ++ui) {
            const int qb = ui == 0 ? 2 * jj : (ui == 1 ? 15 - 2 * jj : (ui == 2 ? 2 * jj + 1 : 14 - 2 * jj));
            const int q0w = qb * 256 + 32 * wid, qi = q0w + r32;
            bf16_t* qrow = Q + ((size_t)b * SEQ + qi) * D + h * 128;
            bf16x8 qf[8];
#pragma unroll
            for (int s = 0; s < 8; ++s) qf[s] = *(const bf16x8*)(qrow + 16 * s + 8 * hh);
            f32x16 Y[4];
#pragma unroll
            for (int dt = 0; dt < 4; ++dt)
#pragma unroll
                for (int r = 0; r < 16; ++r) Y[dt][r] = 0.f;
            float R = 0.f;
            const int ktmax = 4 * qb + 3;
            u32x4 kr[2], vr[2];
#define SB_LOADG(kt) do { _Pragma("unroll") for (int i_ = 0; i_ < 2; ++i_) { const int c_ = tid + 512 * i_; \
                kr[i_] = *(const u32x4*)(kg + (size_t)(64 * (kt) + (c_ >> 4)) * D + (c_ & 15) * 8); \
                vr[i_] = *(const u32x4*)(vg + (size_t)(c_ >> 3) * T + 64 * (kt) + (c_ & 7) * 8); } } while (0)
#define SB_STORES(bufp) do { _Pragma("unroll") for (int i_ = 0; i_ < 2; ++i_) { const int c_ = tid + 512 * i_; \
                *(LAS u32x4*)((bufp) + (c_ >> 4) * SB_KST + (c_ & 15) * 16) = kr[i_]; \
                LAS u32x2* vp_ = (LAS u32x2*)((bufp) + SB_KBYTES + (c_ >> 3) * SB_VST + (c_ & 7) * 16); \
                u32x2 a_; a_.x = vr[i_].x; a_.y = vr[i_].y; u32x2 b_; b_.x = vr[i_].z; b_.y = vr[i_].w; vp_[0] = a_; vp_[1] = b_; } } while (0)
            SB_LOADG(ktmax); SB_STORES(lds); __syncthreads();
            for (int kt = ktmax, it = 0; kt >= 0; --kt, ++it) {
                LAS unsigned char* cur = lds + (it & 1) * SB_BUF; LAS unsigned char* nxt = lds + ((it & 1) ^ 1) * SB_BUF;
                if (kt > 0) SB_LOADG(kt - 1);
#pragma unroll
                for (int st = 1; st >= 0; --st) { const int k0 = 64 * kt + 32 * st;
                    if (k0 < q0w + 31) { if (k0 + 31 >= q0w) sb_subtile<true>(cur, st, qf, Y, R, k0, qi, r32, hh); else sb_subtile<false>(cur, st, qf, Y, R, k0, qi, r32, hh); } }
                if (kt > 0) SB_STORES(nxt);
                __syncthreads();
            }
#undef SB_LOADG
#undef SB_STORES
#pragma unroll
            for (int dt = 0; dt < 4; ++dt)
#pragma unroll
                for (int c = 0; c < 4; ++c) { u32x2 w; w.x = pk2(Y[dt][4 * c], Y[dt][4 * c + 1]); w.y = pk2(Y[dt][4 * c + 2], Y[dt][4 * c + 3]); *(u32x2*)(qrow + 32 * dt + 8 * c + 4 * hh) = w; }
        }
    }
}

__device__ __forceinline__ void mlstm_naive(const bf16_t* MQ, const bf16_t* MK, const bf16_t* MVT, const float* ifp, const float* conv_w, const float* conv_b, bf16_t* HUN, float* lq) {
    const int tid = threadIdx.x, lane = tid & 63;
    for (int item = blockIdx.x; item < 256; item += gridDim.x) {
        const int bh = item >> 3, vs = item & 7, b = bh >> 2, h = bh & 3;
        const bool isk = tid >= 256; const int cc = h * 256 + (tid & 255), ch2 = (isk ? 1024 : 0) + cc;
        const bf16_t* src = (isk ? MK : MQ) + (size_t)b * SEQ * D + cc;
        const float w0 = conv_w[ch2], w1 = conv_w[2048 + ch2], w2 = conv_w[4096 + ch2], w3 = conv_w[6144 + ch2], cb = conv_b[ch2];
        const float osc = isk ? 0.0625f : 1.f;
        float r0 = 0.f, r1 = 0.f, r2 = 0.f;
        float C[16], n[16];
#pragma unroll
        for (int i = 0; i < 16; ++i) { C[i] = 0.f; n[i] = 0.f; }
        const int v = tid >> 4, kq = tid & 15;
        for (int t0 = 0; t0 < SEQ; t0 += 16) {
            float raw[16];
#pragma unroll
            for (int j = 0; j < 16; ++j) raw[j] = bf2f(src[(size_t)(t0 + j) * D]);
#pragma unroll
            for (int j = 0; j < 16; ++j) { const float u = w0 * r0 + w1 * r1 + w2 * r2 + w3 * raw[j] + cb; r0 = r1; r1 = r2; r2 = raw[j]; lq[j * 512 + tid] = u * sigmoidf_(u) * osc; }
            const size_t trow = (size_t)b * SEQ + t0 + kq;
            const float vv = bf2f(MVT[(size_t)(h * 256 + vs * 32 + v) * T + trow]);
            const float ei = __expf(ifp[trow * 8 + h]), fg = sigmoidf_(ifp[trow * 8 + 4 + h]);
            __syncthreads();
            float hkeep = 0.f;
#pragma unroll 1
            for (int j = 0; j < 16; ++j) {
                const int srcl = (lane & 48) | j;
                const float vj = __shfl(vv, srcl), eij = __shfl(ei, srcl), fj = __shfl(fg, srcl);
                const float ev = eij * vj;
                const f32x4* qp = (const f32x4*)(lq + j * 512 + 16 * kq); const f32x4* kp = (const f32x4*)(lq + j * 512 + 256 + 16 * kq);
                float pn = 0.f, pd = 0.f;
#pragma unroll
                for (int i4 = 0; i4 < 4; ++i4) { const f32x4 q4 = qp[i4], k4 = kp[i4];
#pragma unroll
                    for (int e = 0; e < 4; ++e) { const int i = 4 * i4 + e; C[i] = fj * C[i] + ev * k4[e]; n[i] = fj * n[i] + eij * k4[e]; pn += C[i] * q4[e]; pd += n[i] * q4[e]; } }
#pragma unroll
                for (int o = 1; o < 16; o <<= 1) { pn += __shfl_xor(pn, o); pd += __shfl_xor(pd, o); }
                const float hv = pn / fmaxf(fabsf(pd), 1.f);
                if (kq == j) hkeep = hv;
            }
            HUN[trow * D + h * 256 + vs * 32 + v] = (bf16_t)f2bf(hkeep);
            __syncthreads();
        }
    }
}

__device__ __forceinline__ void memk_norm(bf16_t* KV, const float* gk, int gw, int NGW, int lane) {
    for (int r = gw; r < TMEM * 4; r += NGW) { const int bm = r >> 2, h = r & 3; bf16_t* p = KV + (size_t)bm * 2048 + h * 256 + 4 * lane;
        const u32x2 w = *(const u32x2*)p; f32x4 v = (f32x4){bflo(w.x), bfhi(w.x), bflo(w.y), bfhi(w.y)};
        const float rs = rsqrtf(wave_sum(v.x * v.x + v.y * v.y + v.z * v.z + v.w * v.w) * (1.f / 256.f) + EPS);
        const f32x4 g = *(const f32x4*)(gk + 4 * lane); v = v * rs * g;
        u32x2 o; o.x = pk2(v.x, v.y); o.y = pk2(v.z, v.w); *(u32x2*)p = o; }
}
__device__ __forceinline__ void cross_naive(bf16_t* XQ, const bf16_t* KV, const float* gq, float* pw, int gw, int NGW, int lane) {
    for (int r = gw; r < T * 4; r += NGW) {
        const int t = r >> 2, h = r & 3, b = t >> 12;
        bf16_t* qp = XQ + (size_t)t * D + h * 256 + 4 * lane;
        const u32x2 w = *(const u32x2*)qp; f32x4 q = (f32x4){bflo(w.x), bfhi(w.x), bflo(w.y), bfhi(w.y)};
        const float rs = rsqrtf(wave_sum(q.x * q.x + q.y * q.y + q.z * q.z + q.w * q.w) * (1.f / 256.f) + EPS);
        q = q * rs * *(const f32x4*)(gq + 4 * lane);
        const bf16_t* kb = KV + (size_t)b * NMEM * 2048 + h * 256 + 4 * lane;
        float lg[4];
#pragma unroll
        for (int mi = 0; mi < 4; ++mi) { lg[mi] = 0.f;
            for (int mj = 0; mj < 64; ++mj) { const u32x2 kw = *(const u32x2*)(kb + (size_t)(mi * 64 + mj) * 2048);
                const float dsum = wave_sum(bflo(kw.x) * q.x + bfhi(kw.x) * q.y + bflo(kw.y) * q.z + bfhi(kw.y) * q.w); if (lane == mj) lg[mi] = dsum * 0.0625f; } }
        const float mx = wave_max(fmaxf(fmaxf(lg[0], lg[1]), fmaxf(lg[2], lg[3])));
        float ps = 0.f;
#pragma unroll
        for (int mi = 0; mi < 4; ++mi) { lg[mi] = __expf(lg[mi] - mx); ps += lg[mi]; }
        const float inv = 1.f / wave_sum(ps);
#pragma unroll
        for (int mi = 0; mi < 4; ++mi) pw[mi * 64 + lane] = lg[mi] * inv;
        LDS_WAIT();
        f32x4 o = (f32x4){0.f, 0.f, 0.f, 0.f};
        const bf16_t* vb = kb + 1024;
        for (int m = 0; m < 256; ++m) { const float pm = pw[m]; const u32x2 vw = *(const u32x2*)(vb + (size_t)m * 2048);
            o.x += pm * bflo(vw.x); o.y += pm * bfhi(vw.x); o.z += pm * bflo(vw.y); o.w += pm * bfhi(vw.y); }
        u32x2 ow; ow.x = pk2(o.x, o.y); ow.y = pk2(o.z, o.w); *(u32x2*)qp = ow;
        LDS_WAIT();
    }
}
__device__ __forceinline__ void ml_finalize(const bf16_t* HUN, const bf16_t* MO, const float* g, bf16_t* Y, int gw, int NGW, int lane) {
    for (int r = gw; r < T * 4; r += NGW) { const size_t off = (size_t)(r >> 2) * D + (r & 3) * 256 + 4 * lane;
        const u32x2 w = *(const u32x2*)(HUN + off); f32x4 v = (f32x4){bflo(w.x), bfhi(w.x), bflo(w.y), bfhi(w.y)};
        const float rs = rsqrtf(wave_sum(v.x * v.x + v.y * v.y + v.z * v.z + v.w * v.w) * (1.f / 256.f) + EPS);
        const f32x4 gg = *(const f32x4*)(g + (r & 3) * 256 + 4 * lane); const u32x2 ow = *(const u32x2*)(MO + off);
        v = v * rs * gg; v.x *= sigmoidf_(bflo(ow.x)); v.y *= sigmoidf_(bfhi(ow.x)); v.z *= sigmoidf_(bflo(ow.y)); v.w *= sigmoidf_(bfhi(ow.y));
        u32x2 o; o.x = pk2(v.x, v.y); o.y = pk2(v.z, v.w); *(u32x2*)(Y + off) = o; }
}

__global__ void __launch_bounds__(NTHREADS) fwd_megakernel(Params p) {
    extern __shared__ __attribute__((aligned(16))) unsigned char lds[];
    cg::grid_group grid = cg::this_grid();
    const int tid = threadIdx.x, lane = tid & 63, wave = tid >> 6;
    const int gw = blockIdx.x * NWAVES + wave, NGW = gridDim.x * NWAVES;
    unsigned char* ws = p.ws; unsigned char* dob = (unsigned char*)p.out;
    const float* x = p.in[0]; const float* mem = p.in[1]; const float* g_mix = p.in[2]; const float* w_in = p.in[3]; const float* b_if = p.in[4]; const float* b_gate = p.in[5];
    const float* conv_w = p.in[6]; const float* conv_b = p.in[7]; const float* ml_norm_g = p.in[8]; const float* g_mem = p.in[9]; const float* w_mem_kv = p.in[10];
    const float* q_norm_g = p.in[11]; const float* k_norm_g = p.in[12]; const float* w_sb = p.in[13]; const float* w_ml = p.in[14]; const float* w_x = p.in[15]; const float* w_out = p.in[16];
    const float* g_mlp = p.in[17]; const float* w_ff1 = p.in[18]; const float* w_ff2 = p.in[19];
    bf16_t* Wt_in = (bf16_t*)(ws + WS_WIN); bf16_t* Wt_mkv = (bf16_t*)(ws + WS_WMKV); bf16_t* Wt_sb = (bf16_t*)(ws + WS_WSB); bf16_t* Wt_ml = (bf16_t*)(ws + WS_WML);
    bf16_t* Wt_x = (bf16_t*)(ws + WS_WX); bf16_t* Wt_out = (bf16_t*)(ws + WS_WOUT); bf16_t* Wt_ff1 = (bf16_t*)(ws + WS_WFF1); bf16_t* Wt_ff2 = (bf16_t*)(ws + WS_WFF2);
    float* ifp = (float*)(ws + WS_IF);
#define SLOT(i) ((bf16_t*)(ws + WS_SLOT0 + (size_t)(i) * SLOT_BYTES))
    bf16_t* memn = (bf16_t*)(dob + DO_MEMN); bf16_t* memkv = (bf16_t*)(dob + DO_MEMKV); bf16_t* hun = (bf16_t*)(dob + DO_HUN);
    float* wscr = (float*)(lds + wave * 8448);

    transpose_matrix(w_in, NIN, D, 7168, Wt_in, wscr, gw, NGW, lane);
    transpose_matrix(w_in + 7176, NIN, D, 4096, Wt_in + (size_t)7168 * D, wscr, gw, NGW, lane);
    transpose_matrix(w_mem_kv, 2048, D, 2048, Wt_mkv, wscr, gw, NGW, lane);
    transpose_matrix(w_sb, D, D, D, Wt_sb, wscr, gw, NGW, lane);
    transpose_matrix(w_ml, D, D, D, Wt_ml, wscr, gw, NGW, lane);
    transpose_matrix(w_x, D, D, D, Wt_x, wscr, gw, NGW, lane);
    transpose_matrix(w_out, D, D, D, Wt_out, wscr, gw, NGW, lane);
    transpose_matrix(w_ff1, FF, D, FF, Wt_ff1, wscr, gw, NGW, lane);
    transpose_matrix(w_ff2, D, FF, D, Wt_ff2, wscr, gw, NGW, lane);
    for (int m = gw; m < T; m += NGW) rms_row<true>(x + (size_t)m * D, g_mix, SLOT(0) + (size_t)m * D, w_in, b_if, ifp + (size_t)m * 8, lane);
    for (int m = gw; m < TMEM; m += NGW) rms_row<false>(mem + (size_t)m * D, g_mem, memn + (size_t)m * D, nullptr, nullptr, nullptr, lane);
    grid.sync();

    { const bf16_t* hN = SLOT(0);
      gemm_fast(lds, hN, Wt_in + (size_t)0 * D, T, 1024, D, EpiBf16{SLOT(1), D});
      gemm_fast(lds, hN, Wt_in + (size_t)1024 * D, T, 1024, D, EpiBf16{SLOT(2), D});
      gemm_fast(lds, Wt_in + (size_t)2048 * D, hN, 1024, T, D, EpiBf16{SLOT(3), T});
      gemm_fast(lds, hN, Wt_in + (size_t)3072 * D, T, 1024, D, EpiBf16{SLOT(4), D});
      gemm_fast(lds, hN, Wt_in + (size_t)4096 * D, T, 1024, D, EpiBf16{SLOT(5), D});
      gemm_fast(lds, Wt_in + (size_t)5120 * D, hN, 1024, T, D, EpiBf16{SLOT(6), T});
      gemm_fast(lds, memn, Wt_mkv, TMEM, 2048, D, EpiBf16{memkv, 2048}); }
    grid.sync();

    memk_norm(memkv, k_norm_g, gw, NGW, lane);
    mlstm_naive(SLOT(4), SLOT(5), SLOT(6), ifp, conv_w, conv_b, hun, (float*)lds);
    __syncthreads();
    sb_fast(SLOT(1), SLOT(2), SLOT(3), (LAS unsigned char*)lds);
    grid.sync();

    gemm_fast(lds, SLOT(0), Wt_in + (size_t)7168 * D, T, 1024, D, EpiBf16{SLOT(2), D});
    gemm_fast(lds, SLOT(0), Wt_in + (size_t)6144 * D, T, 1024, D, EpiBf16{SLOT(3), D});
    grid.sync();

    cross_naive(SLOT(2), memkv, q_norm_g, wscr, gw, NGW, lane);
    ml_finalize(hun, SLOT(3), ml_norm_g, SLOT(4), gw, NGW, lane);
    grid.sync();

    gemm_fast(lds, SLOT(0), Wt_in + (size_t)8192 * D, T, 3072, D, EpiGate{SLOT(0), b_gate});
    grid.sync();

    gemm_fast(lds, SLOT(1), Wt_sb, T, D, D, EpiMix<0>{SLOT(3), p.out, nullptr});
    grid.sync();
    gemm_fast(lds, SLOT(4), Wt_ml, T, D, D, EpiMix<1>{SLOT(5), p.out, nullptr});
    grid.sync();
    gemm_fast(lds, SLOT(2), Wt_x, T, D, D, EpiMix<2>{SLOT(6), p.out, SLOT(0)});
    grid.sync();

    gemm_fast(lds, SLOT(0), Wt_out, T, D, D, EpiResid{x, p.out});
    grid.sync();

    for (int m = gw; m < T; m += NGW) rms_row<false>(p.out + (size_t)m * D, g_mlp, SLOT(1) + (size_t)m * D, nullptr, nullptr, nullptr, lane);
    grid.sync();

    gemm_fast(lds, SLOT(1), Wt_ff1, T, FF, D, EpiRelu2{SLOT(2), FF});
    grid.sync();

    gemm_fast(lds, SLOT(2), Wt_ff2, T, D, FF, EpiResid{p.out, p.out});
}

extern "C" void kernel_launch(void* const* d_in, const int* in_sizes, int n_in, void* d_out, int out_size, void* d_ws, size_t ws_size, hipStream_t stream) {
    static int grid_blocks = 0;
    if (grid_blocks == 0) {
        if (n_in != 20 || out_size != T * D || ws_size < WS_NEED) { fprintf(stderr, "kernel_launch: unexpected shapes (n_in %d out %d ws %zu)\n", n_in, out_size, ws_size); grid_blocks = -1; return; }
        int dev = 0, cus = 0, per_cu = 0;
        hipGetDevice(&dev);
        hipDeviceGetAttribute(&cus, hipDeviceAttributeMultiprocessorCount, dev);
        hipFuncSetAttribute((const void*)fwd_megakernel, hipFuncAttributeMaxDynamicSharedMemorySize, LDS_BYTES);
        hipOccupancyMaxActiveBlocksPerMultiprocessor(&per_cu, (const void*)fwd_megakernel, NTHREADS, LDS_BYTES);
        if (per_cu < 1) per_cu = 1;
        grid_blocks = cus * per_cu;
    }
    if (grid_blocks < 0) return;
    Params p{};
    for (int i = 0; i < 20; ++i) p.in[i] = (const float*)d_in[i];
    p.out = (float*)d_out; p.ws = (unsigned char*)d_ws;
    void* args[] = {&p};
    hipError_t e = hipLaunchCooperativeKernel((const void*)fwd_megakernel, dim3(grid_blocks), dim3(NTHREADS), args, LDS_BYTES, stream);
    if (e != hipSuccess) fprintf(stderr, "cooperative launch failed: %s (grid %d)\n", hipGetErrorString(e), grid_blocks);
}
```

```cpp
#include <hip/hip_runtime.h>
#include <hip/hip_cooperative_groups.h>
#include <cstdint>
#include <cstdio>
namespace cg = cooperative_groups;

typedef unsigned short bf16_t;
typedef short bf16x8 __attribute__((ext_vector_type(8)));
typedef float f32x4 __attribute__((ext_vector_type(4)));
typedef unsigned u32x2 __attribute__((ext_vector_type(2)));
typedef unsigned u32x4 __attribute__((ext_vector_type(4)));

constexpr int D = 1024, BATCH = 8, SEQ = 4096, T = BATCH * SEQ, NMEM = 256, TMEM = BATCH * NMEM, FF = 4096;
constexpr int NIN = 11272;
constexpr int IF_COL = 7168;
constexpr float EPS = 1e-6f;
constexpr int NTHREADS = 512, NWAVES = 8;
constexpr int LDS_BYTES = 144 * 1024;

constexpr size_t MiB = (size_t)1 << 20;
constexpr size_t WS_WIN = 0;
constexpr size_t WS_WMKV = 22 * MiB;
constexpr size_t WS_WSB = 26 * MiB, WS_WML = 28 * MiB, WS_WX = 30 * MiB, WS_WOUT = 32 * MiB;
constexpr size_t WS_WFF1 = 34 * MiB;
constexpr size_t WS_WFF2 = 42 * MiB;
constexpr size_t WS_IF = 50 * MiB;
constexpr size_t WS_SLOT0 = 64 * MiB, SLOT_BYTES = 64 * MiB;
constexpr size_t WS_NEED = WS_SLOT0 + 7 * SLOT_BYTES;
constexpr size_t DO_MEMN = 0;
constexpr size_t DO_MEMK = 4 * MiB;
constexpr size_t DO_MEMVT = 8 * MiB;
constexpr size_t DO_HUN = 64 * MiB;

struct Params { const float* in[20]; float* out; unsigned char* ws; };

__device__ __forceinline__ unsigned f2bf(float f) { unsigned u = __builtin_bit_cast(unsigned, f); return (u + 0x7fffu + ((u >> 16) & 1u)) >> 16; }
__device__ __forceinline__ unsigned pk2(float lo, float hi) { return f2bf(lo) | (f2bf(hi) << 16); }
__device__ __forceinline__ float bf2f(bf16_t v) { return __builtin_bit_cast(float, (unsigned)v << 16); }
__device__ __forceinline__ float bflo(unsigned w) { return __builtin_bit_cast(float, w << 16); }
__device__ __forceinline__ float bfhi(unsigned w) { return __builtin_bit_cast(float, w & 0xffff0000u); }
__device__ __forceinline__ float wave_sum(float v) {
#pragma unroll
    for (int o = 1; o < 64; o <<= 1) v += __shfl_xor(v, o);
    return v;
}
__device__ __forceinline__ float wave_max(float v) {
#pragma unroll
    for (int o = 1; o < 64; o <<= 1) v = fmaxf(v, __shfl_xor(v, o));
    return v;
}
__device__ __forceinline__ float sigmoidf_(float x) { return 1.f / (1.f + __expf(-x)); }
#define LDS_WAIT() asm volatile("s_waitcnt lgkmcnt(0)" ::: "memory")

__device__ __forceinline__ void transpose_item(const float* W, int ldw, int K, bf16_t* WT, int k0, int n0, float* scr, int lane) {
#pragma unroll 8
    for (int i = 0; i < 32; ++i) { const int kk = 2 * i + (lane >> 5); scr[kk * 33 + (lane & 31)] = W[(size_t)(k0 + kk) * ldw + n0 + (lane & 31)]; }
    LDS_WAIT();
    const int c = lane & 7;
#pragma unroll
    for (int j = 0; j < 4; ++j) { const int n = (lane >> 3) + 8 * j; const float* s = scr + (8 * c) * 33 + n;
        u32x4 o; o.x = pk2(s[0 * 33], s[1 * 33]); o.y = pk2(s[2 * 33], s[3 * 33]); o.z = pk2(s[4 * 33], s[5 * 33]); o.w = pk2(s[6 * 33], s[7 * 33]);
        *(u32x4*)(WT + (size_t)(n0 + n) * K + k0 + 8 * c) = o; }
    LDS_WAIT();
}
__device__ __forceinline__ void transpose_matrix(const float* W, int ldw, int K, int N, bf16_t* WT, float* scr, int gw, int NGW, int lane) {
    const int nblk = N / 32, items = (K / 64) * nblk;
    for (int it = gw; it < items; it += NGW) { const int kb = it / nblk, nb = it % nblk; transpose_item(W, ldw, K, WT, 64 * kb, 32 * nb, scr, lane); }
}

template <bool WITH_IF>
__device__ __forceinline__ void rms_row(const float* xrow, const float* g, bf16_t* orow, const float* w_in, const float* b_if, float* ifout, int lane) {
    const f32x4* xr = (const f32x4*)xrow + lane; const f32x4* gr = (const f32x4*)g + lane;
    f32x4 v[4]; float s = 0.f;
#pragma unroll
    for (int j = 0; j < 4; ++j) { v[j] = xr[64 * j]; s += (v[j].x * v[j].x + v[j].y * v[j].y) + (v[j].z * v[j].z + v[j].w * v[j].w); }
    const float r = rsqrtf(wave_sum(s) * (1.f / D) + EPS);
#pragma unroll
    for (int j = 0; j < 4; ++j) v[j] = v[j] * r * gr[64 * j];
    u32x2* o8 = (u32x2*)orow + lane;
#pragma unroll
    for (int j = 0; j < 4; ++j) { u32x2 w; w.x = pk2(v[j].x, v[j].y); w.y = pk2(v[j].z, v[j].w); o8[64 * j] = w; }
    if (WITH_IF) {
        float a[8];
#pragma unroll
        for (int e = 0; e < 8; ++e) a[e] = 0.f;
#pragma unroll
        for (int j = 0; j < 4; ++j)
#pragma unroll
            for (int i = 0; i < 4; ++i) { const int k = 256 * j + 4 * lane + i; const f32x4* wp = (const f32x4*)(w_in + (size_t)k * NIN + IF_COL); const f32x4 w0 = wp[0], w1 = wp[1]; const float hv = v[j][i];
                a[0] += hv * w0.x; a[1] += hv * w0.y; a[2] += hv * w0.z; a[3] += hv * w0.w; a[4] += hv * w1.x; a[5] += hv * w1.y; a[6] += hv * w1.z; a[7] += hv * w1.w; }
#pragma unroll
        for (int e = 0; e < 8; ++e) a[e] = wave_sum(a[e]);
        if (lane == 0) {
#pragma unroll
            for (int e = 0; e < 8; ++e) ifout[e] = a[e] + b_if[e]; }
    }
}

namespace pg8 {
#define PG8_LAS __attribute__((address_space(3)))
typedef unsigned short bf16_t;
typedef short bf16x8 __attribute__((ext_vector_type(8)));
typedef float f32x4 __attribute__((ext_vector_type(4)));
typedef unsigned u32x4 __attribute__((ext_vector_type(4)));
constexpr int BM = 256, BK = 64, HALF = 128, HTB = HALF * BK * 2  , STAGE_BYTES = 8 * HTB, NXCD = 8, WGM = 8;

__host__ __device__ __forceinline__ int lds_byte(int r, int c) { const int st = (r >> 4) * 2 + (c >> 5), rr = r & 15, cc = c & 31, ob = rr * 64 + cc * 2; return st * 1024 + (ob ^ (((ob >> 9) & 1) << 5)); }
__host__ __device__ __forceinline__ void stage_rc(int b, int& R, int& C) { const int st = b / 1024, sb = b % 1024, swz = sb ^ (((sb >> 9) & 1) << 5); R = (st >> 1) * 16 + swz / 64; C = (st & 1) * 32 + (swz % 64) / 2; }
__host__ __device__ __forceinline__ int perm32(int rho) { const int n = rho >> 4, i = rho & 15; return 8 * (i >> 2) + 4 * n + (i & 3); }

struct Unit { int pm, pn; };
struct Gemm { const bf16_t* A; const bf16_t* Bt; int M, N, K; };

struct StaticOrder {
    int nM, nN, nwg, G, c;
    __host__ __device__ void init(int M, int N, int G_, int c_) { nM = M / BM; nN = N / BM; nwg = nM * nN; G = G_; c = c_; }
    __host__ __device__ bool next(int i, Unit& u) const {
        const long L = (long)i * G + c; if (L >= nwg) return false;
        int wgid = (int)L; { const int q = nwg / NXCD, r = nwg % NXCD, xcd = wgid % NXCD, off = wgid / NXCD; wgid = (xcd < r ? xcd * (q + 1) : r * (q + 1) + (xcd - r) * q) + off; }
        const int nig = WGM * nN, gid = wgid / nig, fm = gid * WGM, gsz = (nM - fm) < WGM ? (nM - fm) : WGM;
        u.pm = fm + ((wgid % nig) % gsz); u.pn = (wgid % nig) / gsz; return true;
    }
    __device__ __forceinline__ void a_ready(const Unit&) const {}
    __device__ __forceinline__ void done(const Unit&) const {}
};
template <class Epi, class Sched, bool ALIGN_EPI = false, bool SP2 = false>
__device__ __forceinline__ void gemm_phase(PG8_LAS unsigned char* lds, const Gemm g, const Sched& S, const Epi& E) {
    int tid_ = threadIdx.x; asm volatile("" : "+v"(tid_));
    const int tid = tid_, wid = __builtin_amdgcn_readfirstlane(tid >> 6), lane = tid & 63, wr = wid >> 2, wc = wid & 3, fr = lane & 15, fq = lane >> 4;
    const int K = g.K, nt = K / BK;
    unsigned voffA[2], voffB[2];
#pragma unroll
    for (int i = 0; i < 2; ++i) { int R, C; stage_rc(tid * 16 + i * 8192, R, C); const int Rb = Epi::PERM ? ((R & ~31) + perm32(R & 31)) : R;
        voffA[i] = (unsigned)(R * K + C) * 2u; voffB[i] = (unsigned)(Rb * K + C) * 2u; }
    const size_t kstep = (size_t)(BK * 2);
    const size_t hstep = (size_t)HALF * K * 2;
    const size_t tstep = 2 * hstep;
    const unsigned ldsw = (unsigned)wid * 1024u;
    const int aoff = lds_byte(wr * 64 + fr, fq * 8), boff = lds_byte(wc * 32 + fr, fq * 8);
#define PG8_SA(b, h) (((b) * 2 + (h)) * HTB)
#define PG8_SB(b, h) ((4 + (b) * 2 + (h)) * HTB)
#define PG8_STAGE(bufoff, gbase, voff) do { _Pragma("unroll") for (int _i = 0; _i < 2; ++_i) \
        __builtin_amdgcn_global_load_lds((const unsigned*)((const char*)(gbase) + (voff)[_i]), (PG8_LAS unsigned*)(lds + (bufoff) + ldsw + _i * 8192), 16, 0, 0); } while (0)
#define PG8_LDA(dst, b, h) do { _Pragma("unroll") for (int m = 0; m < 4; ++m) _Pragma("unroll") for (int k = 0; k < 2; ++k) dst[m][k] = *(const PG8_LAS bf16x8*)(lds + PG8_SA(b, h) + aoff + m * 2048 + k * 1024); } while (0)
#define PG8_LDB(dst, b, h) do { _Pragma("unroll") for (int n = 0; n < 2; ++n) _Pragma("unroll") for (int k = 0; k < 2; ++k) dst[n][k] = *(const PG8_LAS bf16x8*)(lds + PG8_SB(b, h) + boff + n * 2048 + k * 1024); } while (0)
#define PG8_MMA(ai, bj, At, Bt) do { __builtin_amdgcn_s_setprio(1); _Pragma("unroll") for (int m = 0; m < 4; ++m) _Pragma("unroll") for (int n = 0; n < 2; ++n) _Pragma("unroll") for (int k = 0; k < 2; ++k) \
        acc[ai][bj][m][n] = __builtin_amdgcn_mfma_f32_16x16x32_bf16(Bt[n][k], At[m][k], acc[ai][bj][m][n], 0, 0, 0); __builtin_amdgcn_s_setprio(0); } while (0)
#define PG8_WAIT_V(n) asm volatile("s_waitcnt vmcnt(" #n ")" ::: "memory")
#define PG8_WAIT_L(n) asm volatile("s_waitcnt lgkmcnt(" #n ")" ::: "memory")
#define PG8_BAR __builtin_amdgcn_s_barrier()
#define PG8_SCHED __builtin_amdgcn_sched_barrier(0)
    Unit cur, nxt; int ui = 0;
    if (!S.next(0, cur)) return;
    f32x4 acc[2][2][4][2];
#pragma unroll
    for (int a = 0; a < 2; ++a)
#pragma unroll
        for (int b = 0; b < 2; ++b)
#pragma unroll
            for (int m = 0; m < 4; ++m)
#pragma unroll
                for (int n = 0; n < 2; ++n) acc[a][b][m][n] = (f32x4){0.f, 0.f, 0.f, 0.f};
    bf16x8 At[4][2], B0[2][2], B1[2][2];
    const char* cA = (const char*)g.A + (size_t)cur.pm * tstep; const char* cB = (const char*)g.Bt + (size_t)cur.pn * tstep;
    S.a_ready(cur);
    if constexpr (SP2) {
        PG8_STAGE(PG8_SB(0, 0), cB, voffB); PG8_STAGE(PG8_SB(0, 1), cB + hstep, voffB); PG8_STAGE(PG8_SA(0, 0), cA, voffA); PG8_STAGE(PG8_SA(0, 1), cA + hstep, voffA);
        if (wr == 1) PG8_BAR;
        PG8_WAIT_V(2); PG8_BAR;
        PG8_STAGE(PG8_SB(1, 0), cB + kstep, voffB); PG8_STAGE(PG8_SA(1, 0), cA + kstep, voffA); PG8_STAGE(PG8_SB(1, 1), cB + hstep + kstep, voffB);
        PG8_WAIT_V(6); PG8_BAR;
    } else {
        PG8_STAGE(PG8_SB(0, 0), cB, voffB); PG8_STAGE(PG8_SA(0, 0), cA, voffA); PG8_STAGE(PG8_SB(0, 1), cB + hstep, voffB); PG8_STAGE(PG8_SA(0, 1), cA + hstep, voffA);
        if (wr == 1) PG8_BAR;
        PG8_WAIT_V(4); PG8_BAR;
        PG8_STAGE(PG8_SB(1, 0), cB + kstep, voffB); PG8_STAGE(PG8_SA(1, 0), cA + kstep, voffA); PG8_STAGE(PG8_SB(1, 1), cB + hstep + kstep, voffB);
        PG8_WAIT_V(6); PG8_BAR;
    }
    for (;;) {
        const bool has_next = S.next(ui + 1, nxt);
        const char* nA = has_next ? (const char*)g.A + (size_t)nxt.pm * tstep : cA; const char* nB = has_next ? (const char*)g.Bt + (size_t)nxt.pn * tstep : cB;
        for (int t = 0; t < nt; t += 2) {
            const bool last = (t == nt - 2);
            const char* a1 = cA + (size_t)(t + 1) * kstep;
            const char* a2 = last ? nA : cA + (size_t)(t + 2) * kstep; const char* b2 = last ? nB : cB + (size_t)(t + 2) * kstep;
            const char* a3 = a2 + kstep; const char* b3 = b2 + kstep;
            if (last && has_next) S.a_ready(nxt);
            if constexpr (SP2) {
            PG8_LDB(B0, 0, 0); PG8_LDB(B1, 0, 1); PG8_SCHED; PG8_LDA(At, 0, 0); PG8_STAGE(PG8_SA(1, 1), a1 + hstep, voffA);
            PG8_WAIT_V(8); PG8_WAIT_L(0); PG8_BAR; PG8_MMA(0, 0, At, B0); PG8_MMA(0, 1, At, B1); PG8_BAR; PG8_SCHED;
            PG8_LDA(At, 0, 1); PG8_STAGE(PG8_SB(0, 0), b2, voffB); PG8_STAGE(PG8_SB(0, 1), b2 + hstep, voffB); PG8_STAGE(PG8_SA(0, 0), a2, voffA);
            PG8_WAIT_V(8); PG8_WAIT_L(0); PG8_BAR; PG8_MMA(1, 0, At, B0); PG8_MMA(1, 1, At, B1); PG8_BAR; PG8_SCHED;
            PG8_LDB(B0, 1, 0); PG8_LDB(B1, 1, 1); PG8_SCHED; PG8_LDA(At, 1, 0); PG8_STAGE(PG8_SA(0, 1), a2 + hstep, voffA);
            PG8_WAIT_V(8); PG8_WAIT_L(0); PG8_BAR; PG8_MMA(0, 0, At, B0); PG8_MMA(0, 1, At, B1); PG8_BAR; PG8_SCHED;
            PG8_LDA(At, 1, 1); PG8_STAGE(PG8_SB(1, 0), b3, voffB); PG8_STAGE(PG8_SB(1, 1), b3 + hstep, voffB); PG8_STAGE(PG8_SA(1, 0), a3, voffA);
            PG8_WAIT_V(8); PG8_WAIT_L(0); PG8_BAR; PG8_MMA(1, 0, At, B0); PG8_MMA(1, 1, At, B1); PG8_BAR; PG8_SCHED;
            } else {
            PG8_LDB(B0, 0, 0); PG8_SCHED; PG8_LDA(At, 0, 0); PG8_STAGE(PG8_SA(1, 1), a1 + hstep, voffA);
            PG8_WAIT_L(8); PG8_BAR; PG8_WAIT_L(0); PG8_MMA(0, 0, At, B0); PG8_BAR; PG8_SCHED;
            PG8_LDB(B1, 0, 1); PG8_STAGE(PG8_SB(0, 0), b2, voffB);
            PG8_BAR; PG8_WAIT_L(0); PG8_MMA(0, 1, At, B1); PG8_BAR;
            PG8_LDA(At, 0, 1); PG8_STAGE(PG8_SA(0, 0), a2, voffA);
            PG8_BAR; PG8_WAIT_L(0); PG8_MMA(1, 0, At, B0); PG8_BAR; PG8_SCHED;
            PG8_STAGE(PG8_SB(0, 1), b2 + hstep, voffB);
            PG8_WAIT_V(6); PG8_BAR; PG8_MMA(1, 1, At, B1); PG8_BAR;
            PG8_LDB(B0, 1, 0); PG8_SCHED; PG8_LDA(At, 1, 0); PG8_STAGE(PG8_SA(0, 1), a2 + hstep, voffA);
            PG8_WAIT_L(8); PG8_BAR; PG8_WAIT_L(0); PG8_MMA(0, 0, At, B0); PG8_BAR; PG8_SCHED;
            PG8_LDB(B1, 1, 1); PG8_STAGE(PG8_SB(1, 0), b3, voffB);
            PG8_BAR; PG8_WAIT_L(0); PG8_MMA(0, 1, At, B1); PG8_BAR;
            PG8_LDA(At, 1, 1); PG8_STAGE(PG8_SA(1, 0), a3, voffA);
            PG8_BAR; PG8_WAIT_L(0); PG8_MMA(1, 0, At, B0); PG8_BAR; PG8_SCHED;
            PG8_STAGE(PG8_SB(1, 1), b3 + hstep, voffB);
            PG8_WAIT_V(6); PG8_BAR; PG8_MMA(1, 1, At, B1); PG8_BAR;
            }
        }
        if constexpr (ALIGN_EPI) { if (wr == 0) PG8_BAR; }
        if constexpr (!Epi::AFTER_DRAIN) { E(acc, cur, wr, wc, fr, fq); S.done(cur); }
        if (!has_next) break;
#pragma unroll
        for (int a = 0; a < 2; ++a)
#pragma unroll
            for (int b = 0; b < 2; ++b)
#pragma unroll
                for (int m = 0; m < 4; ++m)
#pragma unroll
                    for (int n = 0; n < 2; ++n) acc[a][b][m][n] = (f32x4){0.f, 0.f, 0.f, 0.f};
        cur = nxt; cA = nA; cB = nB; ++ui;
        if constexpr (ALIGN_EPI) { if (wr == 1) PG8_BAR; }
    }
    PG8_WAIT_V(0);
    if constexpr (!ALIGN_EPI) { if (wr == 0) PG8_BAR; }
    PG8_BAR;
    if constexpr (Epi::AFTER_DRAIN) { E.fused(acc, cur, wr, wc, fr, fq, lds, wid, lane); S.done(cur); }
#undef PG8_SA
#undef PG8_SB
#undef PG8_STAGE
#undef PG8_LDA
#undef PG8_LDB
#undef PG8_MMA
#undef PG8_WAIT_V
#undef PG8_WAIT_L
#undef PG8_BAR
#undef PG8_SCHED
}
}

template <class EW> struct EpiAdapt { static constexpr bool PERM = false, AFTER_DRAIN = false; EW e;
    __device__ __forceinline__ void operator()(const f32x4 (&acc)[2][2][4][2], const pg8::Unit& u, int wr, int wc, int fr, int fq) const {
#pragma unroll
        for (int ai = 0; ai < 2; ++ai)
#pragma unroll
            for (int m = 0; m < 4; ++m) { const int row = u.pm * 256 + ai * 128 + wr * 64 + m * 16 + fr;
#pragma unroll
                for (int bj = 0; bj < 2; ++bj)
#pragma unroll
                    for (int n = 0; n < 2; ++n) e(row, u.pn * 256 + bj * 128 + wc * 32 + n * 16 + 4 * fq, acc[ai][bj][m][n]); } } };
template <class EW>
__device__ __forceinline__ void gemm_fast(unsigned char* lds, const bf16_t* A, const bf16_t* Bt, int M, int N, int K, const EW& e) {
    pg8::Gemm g{A, Bt, M, N, K}; pg8::StaticOrder S; S.init(M, N, (int)gridDim.x, (int)blockIdx.x);
    EpiAdapt<EW> E{e};
    pg8::gemm_phase<EpiAdapt<EW>, pg8::StaticOrder, true, true>((PG8_LAS unsigned char*)lds, g, S, E);
}

struct EpiBf16 { bf16_t* O; int ldc;
    __device__ __forceinline__ void operator()(int r, int c, f32x4 v) const { u32x2 w; w.x = pk2(v.x, v.y); w.y = pk2(v.z, v.w); *(u32x2*)(O + (size_t)r * ldc + c) = w; } };
struct EpiGate { bf16_t* S0; const float* bias;
    __device__ __forceinline__ void operator()(int r, int c, f32x4 v) const { const f32x4 b = *(const f32x4*)(bias + c); const int s = c >> 10, cc = c & 1023; bf16_t* O = S0 + (size_t)(3 + s + (s > 0 ? 1 : 0)) * (SLOT_BYTES / 2);
        u32x2 w; w.x = pk2(sigmoidf_(v.x + b.x), sigmoidf_(v.y + b.y)); w.y = pk2(sigmoidf_(v.z + b.z), sigmoidf_(v.w + b.w)); *(u32x2*)(O + (size_t)r * D + cc) = w; } };
template <int MODE>
struct EpiMix { const bf16_t* G; float* Mx; bf16_t* O;
    __device__ __forceinline__ void operator()(int r, int c, f32x4 v) const { const size_t off = (size_t)r * D + c; const u32x2 gw = *(const u32x2*)(G + off);
        f32x4 m = (f32x4){bflo(gw.x) * v.x, bfhi(gw.x) * v.y, bflo(gw.y) * v.z, bfhi(gw.y) * v.w};
        if (MODE >= 1) m = m + *(const f32x4*)(Mx + off);
        if (MODE <= 1) *(f32x4*)(Mx + off) = m; else { u32x2 w; w.x = pk2(m.x, m.y); w.y = pk2(m.z, m.w); *(u32x2*)(O + off) = w; } } };
struct EpiResid { const float* base; float* out;
    __device__ __forceinline__ void operator()(int r, int c, f32x4 v) const { const size_t off = (size_t)r * D + c; *(f32x4*)(out + off) = *(const f32x4*)(base + off) + v; } };
struct EpiRelu2 { bf16_t* O; int ldc;
    __device__ __forceinline__ void operator()(int r, int c, f32x4 v) const { f32x4 t = (f32x4){fmaxf(v.x, 0.f), fmaxf(v.y, 0.f), fmaxf(v.z, 0.f), fmaxf(v.w, 0.f)}; t = t * t;
        u32x2 w; w.x = pk2(t.x, t.y); w.y = pk2(t.z, t.w); *(u32x2*)(O + (size_t)r * ldc + c) = w; } };

__device__ __forceinline__ void sb_naive(bf16_t* Q, const bf16_t* Kk, const bf16_t* VT, float* qs, int gw, int NGW, int lane) {
    const float scale = 0.08838834764831845f;
    for (int w = gw; w < 2048; w += NGW) {
        for (int i = 0; i < 128; ++i) {
            const int bh = i >> 1, t = (i & 1) ? (SEQ - 1 - w) : w, b = bh >> 3, h = bh & 7;
            const size_t row = (size_t)b * SEQ + t;
            bf16_t* qrow = Q + row * D + h * 128;
            { const unsigned qw = *(const unsigned*)(qrow + 2 * lane); qs[2 * lane] = bflo(qw) * scale; qs[2 * lane + 1] = bfhi(qw) * scale; }
            LDS_WAIT();
            float acc[128];
#pragma unroll
            for (int d = 0; d < 128; ++d) acc[d] = 0.f;
            float R = 0.f;
            const int nb = (t + 63) >> 6;
            for (int blk = nb - 1; blk >= 0; --blk) {
                const int s = blk * 64 + lane; const bool valid = s < t;
                const bf16_t* krow = Kk + ((size_t)b * SEQ + s) * D + h * 128;
                float z = 0.f;
#pragma unroll
                for (int c = 0; c < 16; ++c) { const u32x4 kw = *(const u32x4*)(krow + 8 * c); const f32x4 q0 = *(const f32x4*)(qs + 8 * c), q1 = *(const f32x4*)(qs + 8 * c + 4);
                    z += bflo(kw.x) * q0.x + bfhi(kw.x) * q0.y + bflo(kw.y) * q0.z + bfhi(kw.y) * q0.w + bflo(kw.z) * q1.x + bfhi(kw.z) * q1.y + bflo(kw.w) * q1.z + bfhi(kw.w) * q1.w; }
                const float e = __expf(-fabsf(z)); const float sp = fmaxf(z, 0.f) + __logf(1.f + e);
                const float lm = valid ? -sp : 0.f, ls = z - sp;
                float incl = lm;
#pragma unroll
                for (int off = 1; off < 64; off <<= 1) { const float tmp = __shfl_down(incl, off); if (lane + off < 64) incl += tmp; }
                const float later = R + incl - lm;
                const float p = valid ? __expf(ls + later) : 0.f;
                R += __shfl(incl, 0);
                const bf16_t* vcol = VT + (size_t)(h * 128) * T + (size_t)b * SEQ + s;
#pragma unroll
                for (int d0 = 0; d0 < 128; d0 += 16) {
#pragma unroll
                    for (int d = d0; d < d0 + 16; ++d) acc[d] += p * bf2f(vcol[(size_t)d * T]);
                    asm volatile("" ::: "memory"); }
            }
            float o0 = 0.f, o1 = 0.f;
#pragma unroll
            for (int d = 0; d < 128; ++d) { const float tot = wave_sum(acc[d]); if ((d & 63) == lane) { if (d < 64) o0 = tot; else o1 = tot; } }
            qrow[lane] = (bf16_t)f2bf(o0); qrow[64 + lane] = (bf16_t)f2bf(o1);
            LDS_WAIT();
        }
    }
}

#define LAS __attribute__((address_space(3)))
typedef float f32x16 __attribute__((ext_vector_type(16)));
constexpr int SB_KST = 272, SB_VST = 136, SB_KBYTES = 64 * SB_KST, SB_VBYTES = 128 * SB_VST, SB_BUF = SB_KBYTES + SB_VBYTES;
template <bool DIAG>
__device__ __forceinline__ void sb_subtile(LAS unsigned char* buf, int st, const bf16x8 (&qf)[8], f32x16 (&Y)[4], float& R, int k0, int qi, int r32, int hh) {
    f32x16 X;
#pragma unroll
    for (int r = 0; r < 16; ++r) X[r] = 0.f;
    LAS unsigned char* kp = buf + (32 * st + r32) * SB_KST + hh * 16;
#pragma unroll
    for (int s = 0; s < 8; ++s) { const bf16x8 kf = *(LAS bf16x8*)(kp + s * 32); X = __builtin_amdgcn_mfma_f32_32x32x16_bf16(kf, qf[s], X, 0, 0, 0); }
    float lm[16];
#pragma unroll
    for (int r = 0; r < 16; ++r) { const float z = X[r] * 0.08838834764831845f; const float e = __expf(-fabsf(z)); const float sp = fmaxf(z, 0.f) + __logf(1.f + e);
        const int key = k0 + (r & 3) + 8 * (r >> 2) + 4 * hh; const bool valid = !DIAG || key < qi;
        lm[r] = valid ? -sp : 0.f; X[r] = z - sp; }
    float g[4], og[4], pr[4];
#pragma unroll
    for (int c = 0; c < 4; ++c) { g[c] = (lm[4 * c] + lm[4 * c + 1]) + (lm[4 * c + 2] + lm[4 * c + 3]); og[c] = __shfl_xor(g[c], 32); pr[c] = g[c] + og[c]; }
    float Tc[4]; Tc[3] = 0.f; Tc[2] = pr[3]; Tc[1] = pr[3] + pr[2]; Tc[0] = Tc[1] + pr[1];
    const float total = Tc[0] + pr[0];
#pragma unroll
    for (int c = 0; c < 4; ++c) { float later = R + Tc[c] + (hh == 0 ? og[c] : 0.f);
#pragma unroll
        for (int i = 3; i >= 0; --i) { const int r = 4 * c + i; const int key = k0 + i + 8 * c + 4 * hh; const bool valid = !DIAG || key < qi;
            const float pv = valid ? __expf(X[r] + later) : 0.f; later += lm[r]; X[r] = pv; } }
    R += total;
    bf16x8 pf[2];
#pragma unroll
    for (int s2 = 0; s2 < 2; ++s2) { u32x4 w; w.x = pk2(X[8 * s2], X[8 * s2 + 1]); w.y = pk2(X[8 * s2 + 2], X[8 * s2 + 3]); w.z = pk2(X[8 * s2 + 4], X[8 * s2 + 5]); w.w = pk2(X[8 * s2 + 6], X[8 * s2 + 7]); pf[s2] = __builtin_bit_cast(bf16x8, w); }
#pragma unroll
    for (int dt = 0; dt < 4; ++dt) { LAS unsigned char* vp = buf + SB_KBYTES + (32 * dt + r32) * SB_VST + (32 * st + 4 * hh) * 2;
#pragma unroll
        for (int s2 = 0; s2 < 2; ++s2) { const u32x2 lo = *(LAS u32x2*)(vp + s2 * 32), hi = *(LAS u32x2*)(vp + s2 * 32 + 16);
            u32x4 w; w.x = lo.x; w.y = lo.y; w.z = hi.x; w.w = hi.y;
            Y[dt] = __builtin_amdgcn_mfma_f32_32x32x16_bf16(__builtin_bit_cast(bf16x8, w), pf[s2], Y[dt], 0, 0, 0); } }
}
__device__ __forceinline__ void sb_fast(bf16_t* Q, const bf16_t* Kk, const bf16_t* VT, LAS unsigned char* lds) {
    int tid_ = threadIdx.x; asm volatile("" : "+v"(tid_));
    const int tid = tid_, lane = tid & 63, wid = tid >> 6, r32 = lane & 31, hh = lane >> 5;
    for (int vw = blockIdx.x; vw < 256; vw += gridDim.x) {
        const int bh = vw >> 2, jj = vw & 3, b = bh >> 3, h = bh & 7;
        const bf16_t* kg = Kk + ((size_t)b * SEQ) * D + h * 128;
        const bf16_t* vg = VT + (size_t)(h * 128) * T + (size_t)b * SEQ;
        for (int ui = 0; ui < 4; ++ui) {
            const int qb = ui == 0 ? 2 * jj : (ui == 1 ? 15 - 2 * jj : (ui == 2 ? 2 * jj + 1 : 14 - 2 * jj));
            const int q0w = qb * 256 + 32 * wid, qi = q0w + r32;
            bf16_t* qrow = Q + ((size_t)b * SEQ + qi) * D + h * 128;
            bf16x8 qf[8];
#pragma unroll
            for (int s = 0; s < 8; ++s) qf[s] = *(const bf16x8*)(qrow + 16 * s + 8 * hh);
            f32x16 Y[4];
#pragma unroll
            for (int dt = 0; dt < 4; ++dt)
#pragma unroll
                for (int r = 0; r < 16; ++r) Y[dt][r] = 0.f;
            float R = 0.f;
            const int ktmax = 4 * qb + 3;
            u32x4 kr[2], vr[2];
#define SB_LOADG(kt) do { _Pragma("unroll") for (int i_ = 0; i_ < 2; ++i_) { const int c_ = tid + 512 * i_; \
                kr[i_] = *(const u32x4*)(kg + (size_t)(64 * (kt) + (c_ >> 4)) * D + (c_ & 15) * 8); \
                vr[i_] = *(const u32x4*)(vg + (size_t)(c_ >> 3) * T + 64 * (kt) + (c_ & 7) * 8); } } while (0)
#define SB_STORES(bufp) do { _Pragma("unroll") for (int i_ = 0; i_ < 2; ++i_) { const int c_ = tid + 512 * i_; \
                *(LAS u32x4*)((bufp) + (c_ >> 4) * SB_KST + (c_ & 15) * 16) = kr[i_]; \
                LAS u32x2* vp_ = (LAS u32x2*)((bufp) + SB_KBYTES + (c_ >> 3) * SB_VST + (c_ & 7) * 16); \
                u32x2 a_; a_.x = vr[i_].x; a_.y = vr[i_].y; u32x2 b_; b_.x = vr[i_].z; b_.y = vr[i_].w; vp_[0] = a_; vp_[1] = b_; } } while (0)
            SB_LOADG(ktmax); SB_STORES(lds); __syncthreads();
            for (int kt = ktmax, it = 0; kt >= 0; --kt, ++it) {
                LAS unsigned char* cur = lds + (it & 1) * SB_BUF; LAS unsigned char* nxt = lds + ((it & 1) ^ 1) * SB_BUF;
                if (kt > 0) SB_LOADG(kt - 1);
#pragma unroll
                for (int st = 1; st >= 0; --st) { const int k0 = 64 * kt + 32 * st;
                    if (k0 < q0w + 31) { if (k0 + 31 >= q0w) sb_subtile<true>(cur, st, qf, Y, R, k0, qi, r32, hh); else sb_subtile<false>(cur, st, qf, Y, R, k0, qi, r32, hh); } }
                if (kt > 0) SB_STORES(nxt);
                __syncthreads();
            }
#undef SB_LOADG
#undef SB_STORES
#pragma unroll
            for (int dt = 0; dt < 4; ++dt)
#pragma unroll
                for (int c = 0; c < 4; ++c) { u32x2 w; w.x = pk2(Y[dt][4 * c], Y[dt][4 * c + 1]); w.y = pk2(Y[dt][4 * c + 2], Y[dt][4 * c + 3]); *(u32x2*)(qrow + 32 * dt + 8 * c + 4 * hh) = w; }
        }
    }
}

__device__ __forceinline__ void mlstm_naive(const bf16_t* MQ, const bf16_t* MK, const bf16_t* MVT, const float* ifp, const float* conv_w, const float* conv_b, bf16_t* HUN, float* lq) {
    const int tid = threadIdx.x, lane = tid & 63;
    for (int item = blockIdx.x; item < 256; item += gridDim.x) {
        const int bh = item >> 3, vs = item & 7, b = bh >> 2, h = bh & 3;
        const bool isk = tid >= 256; const int cc = h * 256 + (tid & 255), ch2 = (isk ? 1024 : 0) + cc;
        const bf16_t* src = (isk ? MK : MQ) + (size_t)b * SEQ * D + cc;
        const float w0 = conv_w[ch2], w1 = conv_w[2048 + ch2], w2 = conv_w[4096 + ch2], w3 = conv_w[6144 + ch2], cb = conv_b[ch2];
        const float osc = isk ? 0.0625f : 1.f;
        float r0 = 0.f, r1 = 0.f, r2 = 0.f;
        float C[16], n[16];
#pragma unroll
        for (int i = 0; i < 16; ++i) { C[i] = 0.f; n[i] = 0.f; }
        const int v = tid >> 4, kq = tid & 15;
        for (int t0 = 0; t0 < SEQ; t0 += 16) {
            float raw[16];
#pragma unroll
            for (int j = 0; j < 16; ++j) raw[j] = bf2f(src[(size_t)(t0 + j) * D]);
#pragma unroll
            for (int j = 0; j < 16; ++j) { const float u = w0 * r0 + w1 * r1 + w2 * r2 + w3 * raw[j] + cb; r0 = r1; r1 = r2; r2 = raw[j]; lq[j * 512 + tid] = u * sigmoidf_(u) * osc; }
            const size_t trow = (size_t)b * SEQ + t0 + kq;
            const float vv = bf2f(MVT[(size_t)(h * 256 + vs * 32 + v) * T + trow]);
            const float ei = __expf(ifp[trow * 8 + h]), fg = sigmoidf_(ifp[trow * 8 + 4 + h]);
            __syncthreads();
            float hkeep = 0.f;
#pragma unroll 1
            for (int j = 0; j < 16; ++j) {
                const int srcl = (lane & 48) | j;
                const float vj = __shfl(vv, srcl), eij = __shfl(ei, srcl), fj = __shfl(fg, srcl);
                const float ev = eij * vj;
                const f32x4* qp = (const f32x4*)(lq + j * 512 + 16 * kq); const f32x4* kp = (const f32x4*)(lq + j * 512 + 256 + 16 * kq);
                float pn = 0.f, pd = 0.f;
#pragma unroll
                for (int i4 = 0; i4 < 4; ++i4) { const f32x4 q4 = qp[i4], k4 = kp[i4];
#pragma unroll
                    for (int e = 0; e < 4; ++e) { const int i = 4 * i4 + e; C[i] = fj * C[i] + ev * k4[e]; n[i] = fj * n[i] + eij * k4[e]; pn += C[i] * q4[e]; pd += n[i] * q4[e]; } }
#pragma unroll
                for (int o = 1; o < 16; o <<= 1) { pn += __shfl_xor(pn, o); pd += __shfl_xor(pd, o); }
                const float hv = pn / fmaxf(fabsf(pd), 1.f);
                if (kq == j) hkeep = hv;
            }
            HUN[trow * D + h * 256 + vs * 32 + v] = (bf16_t)f2bf(hkeep);
            __syncthreads();
        }
    }
}

__device__ __forceinline__ void memk_norm(bf16_t* MK, const float* gk, const float* gq, int gw, int NGW, int lane) {
    for (int r = gw; r < TMEM * 4; r += NGW) { const int bm = r >> 2, h = r & 3; bf16_t* p = MK + (size_t)bm * D + h * 256 + 4 * lane;
        const u32x2 w = *(const u32x2*)p; f32x4 v = (f32x4){bflo(w.x), bfhi(w.x), bflo(w.y), bfhi(w.y)};
        const float rs = rsqrtf(wave_sum(v.x * v.x + v.y * v.y + v.z * v.z + v.w * v.w) * (1.f / 256.f) + EPS);
        const f32x4 g = *(const f32x4*)(gk + 4 * lane); const f32x4 g2 = *(const f32x4*)(gq + 4 * lane); v = v * rs * g * g2 * 0.0625f;
        u32x2 o; o.x = pk2(v.x, v.y); o.y = pk2(v.z, v.w); *(u32x2*)p = o; }
}
__device__ __forceinline__ void cross_fast(bf16_t* XQ, const bf16_t* MK, const bf16_t* MVT, int gw, int NGW, int lane) {
    const int fr = lane & 15, fq = lane >> 4;
    for (int wu = gw; wu < (T / 16) * 4; wu += NGW) {
        const int h = wu & 3, t0 = (wu >> 2) * 16, b = t0 >> 12;
        bf16_t* qrow = XQ + (size_t)(t0 + fr) * D + h * 256;
        bf16x8 qf[8]; float ss = 0.f;
#pragma unroll
        for (int s = 0; s < 8; ++s) { const u32x4 w = *(const u32x4*)(qrow + 32 * s + 8 * fq); qf[s] = __builtin_bit_cast(bf16x8, w);
            ss += bflo(w.x) * bflo(w.x) + bfhi(w.x) * bfhi(w.x) + bflo(w.y) * bflo(w.y) + bfhi(w.y) * bfhi(w.y) + bflo(w.z) * bflo(w.z) + bfhi(w.z) * bfhi(w.z) + bflo(w.w) * bflo(w.w) + bfhi(w.w) * bfhi(w.w); }
        ss += __shfl_xor(ss, 16); ss += __shfl_xor(ss, 32);
        const float rs = rsqrtf(ss * (1.f / 256.f) + EPS);
        const bf16_t* kb = MK + (size_t)(b * NMEM + fr) * D + h * 256 + 8 * fq;
        f32x4 X[16];
#pragma unroll
        for (int kt = 0; kt < 16; ++kt) { X[kt] = (f32x4){0.f, 0.f, 0.f, 0.f};
#pragma unroll
            for (int s = 0; s < 8; ++s) { const bf16x8 kf = *(const bf16x8*)(kb + (size_t)(16 * kt) * D + 32 * s); X[kt] = __builtin_amdgcn_mfma_f32_16x16x32_bf16(kf, qf[s], X[kt], 0, 0, 0); } }
        float mx = -3.0e38f;
#pragma unroll
        for (int kt = 0; kt < 16; ++kt) { X[kt] = X[kt] * rs; mx = fmaxf(mx, fmaxf(fmaxf(X[kt].x, X[kt].y), fmaxf(X[kt].z, X[kt].w))); }
        mx = fmaxf(mx, __shfl_xor(mx, 16)); mx = fmaxf(mx, __shfl_xor(mx, 32));
        float sum = 0.f;
#pragma unroll
        for (int kt = 0; kt < 16; ++kt) { X[kt].x = __expf(X[kt].x - mx); X[kt].y = __expf(X[kt].y - mx); X[kt].z = __expf(X[kt].z - mx); X[kt].w = __expf(X[kt].w - mx); sum += (X[kt].x + X[kt].y) + (X[kt].z + X[kt].w); }
        sum += __shfl_xor(sum, 16); sum += __shfl_xor(sum, 32);
        const float inv = 1.f / sum;
        bf16x8 pf[8];
#pragma unroll
        for (int kp = 0; kp < 8; ++kp) { u32x4 w; w.x = pk2(X[2 * kp].x, X[2 * kp].y); w.y = pk2(X[2 * kp].z, X[2 * kp].w); w.z = pk2(X[2 * kp + 1].x, X[2 * kp + 1].y); w.w = pk2(X[2 * kp + 1].z, X[2 * kp + 1].w); pf[kp] = __builtin_bit_cast(bf16x8, w); }
        const bf16_t* vb = MVT + (size_t)(h * 256 + fr) * TMEM + b * NMEM + 4 * fq;
#pragma unroll 4
        for (int dt = 0; dt < 16; ++dt) { f32x4 Y = (f32x4){0.f, 0.f, 0.f, 0.f};
#pragma unroll
            for (int kp = 0; kp < 8; ++kp) { const u32x2 lo = *(const u32x2*)(vb + (size_t)(16 * dt) * TMEM + 32 * kp), hi = *(const u32x2*)(vb + (size_t)(16 * dt) * TMEM + 32 * kp + 16);
                u32x4 w; w.x = lo.x; w.y = lo.y; w.z = hi.x; w.w = hi.y; Y = __builtin_amdgcn_mfma_f32_16x16x32_bf16(__builtin_bit_cast(bf16x8, w), pf[kp], Y, 0, 0, 0); }
            Y = Y * inv; u32x2 o; o.x = pk2(Y.x, Y.y); o.y = pk2(Y.z, Y.w); *(u32x2*)(qrow + 16 * dt + 4 * fq) = o; }
    }
}
__device__ __forceinline__ void ml_finalize(const bf16_t* HUN, const bf16_t* MO, const float* g, bf16_t* Y, int gw, int NGW, int lane) {
    for (int r = gw; r < T * 4; r += NGW) { const size_t off = (size_t)(r >> 2) * D + (r & 3) * 256 + 4 * lane;
        const u32x2 w = *(const u32x2*)(HUN + off); f32x4 v = (f32x4){bflo(w.x), bfhi(w.x), bflo(w.y), bfhi(w.y)};
        const float rs = rsqrtf(wave_sum(v.x * v.x + v.y * v.y + v.z * v.z + v.w * v.w) * (1.f / 256.f) + EPS);
        const f32x4 gg = *(const f32x4*)(g + (r & 3) * 256 + 4 * lane); const u32x2 ow = *(const u32x2*)(MO + off);
        v = v * rs * gg; v.x *= sigmoidf_(bflo(ow.x)); v.y *= sigmoidf_(bfhi(ow.x)); v.z *= sigmoidf_(bflo(ow.y)); v.w *= sigmoidf_(bfhi(ow.y));
        u32x2 o; o.x = pk2(v.x, v.y); o.y = pk2(v.z, v.w); *(u32x2*)(Y + off) = o; }
}

__global__ void __launch_bounds__(NTHREADS) fwd_megakernel(Params p) {
    extern __shared__ __attribute__((aligned(16))) unsigned char lds[];
    cg::grid_group grid = cg::this_grid();
    const int tid = threadIdx.x, lane = tid & 63, wave = tid >> 6;
    const int gw = blockIdx.x * NWAVES + wave, NGW = gridDim.x * NWAVES;
    unsigned char* ws = p.ws; unsigned char* dob = (unsigned char*)p.out;
    const float* x = p.in[0]; const float* mem = p.in[1]; const float* g_mix = p.in[2]; const float* w_in = p.in[3]; const float* b_if = p.in[4]; const float* b_gate = p.in[5];
    const float* conv_w = p.in[6]; const float* conv_b = p.in[7]; const float* ml_norm_g = p.in[8]; const float* g_mem = p.in[9]; const float* w_mem_kv = p.in[10];
    const float* q_norm_g = p.in[11]; const float* k_norm_g = p.in[12]; const float* w_sb = p.in[13]; const float* w_ml = p.in[14]; const float* w_x = p.in[15]; const float* w_out = p.in[16];
    const float* g_mlp = p.in[17]; const float* w_ff1 = p.in[18]; const float* w_ff2 = p.in[19];
    bf16_t* Wt_in = (bf16_t*)(ws + WS_WIN); bf16_t* Wt_mkv = (bf16_t*)(ws + WS_WMKV); bf16_t* Wt_sb = (bf16_t*)(ws + WS_WSB); bf16_t* Wt_ml = (bf16_t*)(ws + WS_WML);
    bf16_t* Wt_x = (bf16_t*)(ws + WS_WX); bf16_t* Wt_out = (bf16_t*)(ws + WS_WOUT); bf16_t* Wt_ff1 = (bf16_t*)(ws + WS_WFF1); bf16_t* Wt_ff2 = (bf16_t*)(ws + WS_WFF2);
    float* ifp = (float*)(ws + WS_IF);
#define SLOT(i) ((bf16_t*)(ws + WS_SLOT0 + (size_t)(i) * SLOT_BYTES))
    bf16_t* memn = (bf16_t*)(dob + DO_MEMN); bf16_t* memk = (bf16_t*)(dob + DO_MEMK); bf16_t* memvt = (bf16_t*)(dob + DO_MEMVT); bf16_t* hun = (bf16_t*)(dob + DO_HUN);
    float* wscr = (float*)(lds + wave * 8448);

    transpose_matrix(w_in, NIN, D, 7168, Wt_in, wscr, gw, NGW, lane);
    transpose_matrix(w_in + 7176, NIN, D, 4096, Wt_in + (size_t)7168 * D, wscr, gw, NGW, lane);
    transpose_matrix(w_mem_kv, 2048, D, 2048, Wt_mkv, wscr, gw, NGW, lane);
    transpose_matrix(w_sb, D, D, D, Wt_sb, wscr, gw, NGW, lane);
    transpose_matrix(w_ml, D, D, D, Wt_ml, wscr, gw, NGW, lane);
    transpose_matrix(w_x, D, D, D, Wt_x, wscr, gw, NGW, lane);
    transpose_matrix(w_out, D, D, D, Wt_out, wscr, gw, NGW, lane);
    transpose_matrix(w_ff1, FF, D, FF, Wt_ff1, wscr, gw, NGW, lane);
    transpose_matrix(w_ff2, D, FF, D, Wt_ff2, wscr, gw, NGW, lane);
    for (int m = gw; m < T; m += NGW) rms_row<true>(x + (size_t)m * D, g_mix, SLOT(0) + (size_t)m * D, w_in, b_if, ifp + (size_t)m * 8, lane);
    for (int m = gw; m < TMEM; m += NGW) rms_row<false>(mem + (size_t)m * D, g_mem, memn + (size_t)m * D, nullptr, nullptr, nullptr, lane);
    grid.sync();

    { const bf16_t* hN = SLOT(0);
      gemm_fast(lds, hN, Wt_in + (size_t)0 * D, T, 1024, D, EpiBf16{SLOT(1), D});
      gemm_fast(lds, hN, Wt_in + (size_t)1024 * D, T, 1024, D, EpiBf16{SLOT(2), D});
      gemm_fast(lds, Wt_in + (size_t)2048 * D, hN, 1024, T, D, EpiBf16{SLOT(3), T});
      gemm_fast(lds, hN, Wt_in + (size_t)3072 * D, T, 1024, D, EpiBf16{SLOT(4), D});
      gemm_fast(lds, hN, Wt_in + (size_t)4096 * D, T, 1024, D, EpiBf16{SLOT(5), D});
      gemm_fast(lds, Wt_in + (size_t)5120 * D, hN, 1024, T, D, EpiBf16{SLOT(6), T});
      gemm_fast(lds, memn, Wt_mkv, TMEM, 1024, D, EpiBf16{memk, D});
      gemm_fast(lds, Wt_mkv + (size_t)1024 * D, memn, 1024, TMEM, D, EpiBf16{memvt, TMEM}); }
    grid.sync();

    memk_norm(memk, k_norm_g, q_norm_g, gw, NGW, lane);
    mlstm_naive(SLOT(4), SLOT(5), SLOT(6), ifp, conv_w, conv_b, hun, (float*)lds);
    __syncthreads();
    sb_fast(SLOT(1), SLOT(2), SLOT(3), (LAS unsigned char*)lds);
    grid.sync();

    gemm_fast(lds, SLOT(0), Wt_in + (size_t)7168 * D, T, 1024, D, EpiBf16{SLOT(2), D});
    gemm_fast(lds, SLOT(0), Wt_in + (size_t)6144 * D, T, 1024, D, EpiBf16{SLOT(3), D});
    grid.sync();

    cross_fast(SLOT(2), memk, memvt, gw, NGW, lane);
    ml_finalize(hun, SLOT(3), ml_norm_g, SLOT(4), gw, NGW, lane);
    grid.sync();

    gemm_fast(lds, SLOT(0), Wt_in + (size_t)8192 * D, T, 3072, D, EpiGate{SLOT(0), b_gate});
    grid.sync();

    gemm_fast(lds, SLOT(1), Wt_sb, T, D, D, EpiMix<0>{SLOT(3), p.out, nullptr});
    grid.sync();
    gemm_fast(lds, SLOT(4), Wt_ml, T, D, D, EpiMix<1>{SLOT(5), p.out, nullptr});
    grid.sync();
    gemm_fast(lds, SLOT(2), Wt_x, T, D, D, EpiMix<2>{SLOT(6), p.out, SLOT(0)});
    grid.sync();

    gemm_fast(lds, SLOT(0), Wt_out, T, D, D, EpiResid{x, p.out});
    grid.sync();

    for (int m = gw; m < T; m += NGW) rms_row<false>(p.out + (size_t)m * D, g_mlp, SLOT(1) + (size_t)m * D, nullptr, nullptr, nullptr, lane);
    grid.sync();

    gemm_fast(lds, SLOT(1), Wt_ff1, T, FF, D, EpiRelu2{SLOT(2), FF});
    grid.sync();

    gemm_fast(lds, SLOT(2), Wt_ff2, T, D, FF, EpiResid{p.out, p.out});
}

extern "C" void kernel_launch(void* const* d_in, const int* in_sizes, int n_in, void* d_out, int out_size, void* d_ws, size_t ws_size, hipStream_t stream) {
    static int grid_blocks = 0;
    if (grid_blocks == 0) {
        if (n_in != 20 || out_size != T * D || ws_size < WS_NEED) { fprintf(stderr, "kernel_launch: unexpected shapes (n_in %d out %d ws %zu)\n", n_in, out_size, ws_size); grid_blocks = -1; return; }
        int dev = 0, cus = 0, per_cu = 0;
        hipGetDevice(&dev);
        hipDeviceGetAttribute(&cus, hipDeviceAttributeMultiprocessorCount, dev);
        hipFuncSetAttribute((const void*)fwd_megakernel, hipFuncAttributeMaxDynamicSharedMemorySize, LDS_BYTES);
        hipOccupancyMaxActiveBlocksPerMultiprocessor(&per_cu, (const void*)fwd_megakernel, NTHREADS, LDS_BYTES);
        if (per_cu < 1) per_cu = 1;
        grid_blocks = cus * per_cu;
    }
    if (grid_blocks < 0) return;
    Params p{};
    for (int i = 0; i < 20; ++i) p.in[i] = (const float*)d_in[i];
    p.out = (float*)d_out; p.ws = (unsigned char*)d_ws;
    void* args[] = {&p};
    hipError_t e = hipLaunchCooperativeKernel((const void*)fwd_megakernel, dim3(grid_blocks), dim3(NTHREADS), args, LDS_BYTES, stream);
    if (e != hipSuccess) fprintf(stderr, "cooperative launch failed: %s (grid %d)\n", hipGetErrorString(e), grid_blocks);
}
```

```cpp
#include <hip/hip_runtime.h>
#include <hip/hip_cooperative_groups.h>
#include <cstdint>
#include <cstdio>
namespace cg = cooperative_groups;

typedef unsigned short bf16_t;
typedef short bf16x8 __attribute__((ext_vector_type(8)));
typedef float f32x4 __attribute__((ext_vector_type(4)));
typedef unsigned u32x2 __attribute__((ext_vector_type(2)));
typedef unsigned u32x4 __attribute__((ext_vector_type(4)));

constexpr int D = 1024, BATCH = 8, SEQ = 4096, T = BATCH * SEQ, NMEM = 256, TMEM = BATCH * NMEM, FF = 4096;
constexpr int NIN = 11272;
constexpr int IF_COL = 7168;
constexpr float EPS = 1e-6f;
constexpr int NTHREADS = 512, NWAVES = 8;
constexpr int LDS_BYTES = 144 * 1024;

constexpr size_t MiB = (size_t)1 << 20;
constexpr size_t WS_WIN = 0;
constexpr size_t WS_WMKV = 22 * MiB;
constexpr size_t WS_WSB = 26 * MiB, WS_WML = 28 * MiB, WS_WX = 30 * MiB, WS_WOUT = 32 * MiB;
constexpr size_t WS_WFF1 = 34 * MiB;
constexpr size_t WS_WFF2 = 42 * MiB;
constexpr size_t WS_IF = 50 * MiB;
constexpr size_t WS_HALOQ = 51 * MiB, WS_HALOK = 54 * MiB;
constexpr size_t WS_SLOT0 = 64 * MiB, SLOT_BYTES = 64 * MiB;
constexpr size_t WS_NEED = WS_SLOT0 + 7 * SLOT_BYTES;
constexpr size_t DO_MEMN = 0;
constexpr size_t DO_MEMK = 4 * MiB;
constexpr size_t DO_MEMVT = 8 * MiB;
constexpr size_t DO_HUN = 64 * MiB;

struct Params { const float* in[20]; float* out; unsigned char* ws; };

__device__ __forceinline__ unsigned f2bf(float f) { unsigned u = __builtin_bit_cast(unsigned, f); return (u + 0x7fffu + ((u >> 16) & 1u)) >> 16; }
__device__ __forceinline__ unsigned pk2(float lo, float hi) { return f2bf(lo) | (f2bf(hi) << 16); }
__device__ __forceinline__ float bf2f(bf16_t v) { return __builtin_bit_cast(float, (unsigned)v << 16); }
__device__ __forceinline__ float bflo(unsigned w) { return __builtin_bit_cast(float, w << 16); }
__device__ __forceinline__ float bfhi(unsigned w) { return __builtin_bit_cast(float, w & 0xffff0000u); }
__device__ __forceinline__ float wave_sum(float v) {
#pragma unroll
    for (int o = 1; o < 64; o <<= 1) v += __shfl_xor(v, o);
    return v;
}
__device__ __forceinline__ float wave_max(float v) {
#pragma unroll
    for (int o = 1; o < 64; o <<= 1) v = fmaxf(v, __shfl_xor(v, o));
    return v;
}
__device__ __forceinline__ float sigmoidf_(float x) { return 1.f / (1.f + __expf(-x)); }
#define LDS_WAIT() asm volatile("s_waitcnt lgkmcnt(0)" ::: "memory")

__device__ __forceinline__ void transpose_item(const float* W, int ldw, int K, bf16_t* WT, int k0, int n0, float* scr, int lane) {
#pragma unroll 8
    for (int i = 0; i < 32; ++i) { const int kk = 2 * i + (lane >> 5); scr[kk * 33 + (lane & 31)] = W[(size_t)(k0 + kk) * ldw + n0 + (lane & 31)]; }
    LDS_WAIT();
    const int c = lane & 7;
#pragma unroll
    for (int j = 0; j < 4; ++j) { const int n = (lane >> 3) + 8 * j; const float* s = scr + (8 * c) * 33 + n;
        u32x4 o; o.x = pk2(s[0 * 33], s[1 * 33]); o.y = pk2(s[2 * 33], s[3 * 33]); o.z = pk2(s[4 * 33], s[5 * 33]); o.w = pk2(s[6 * 33], s[7 * 33]);
        *(u32x4*)(WT + (size_t)(n0 + n) * K + k0 + 8 * c) = o; }
    LDS_WAIT();
}
__device__ __forceinline__ void transpose_matrix(const float* W, int ldw, int K, int N, bf16_t* WT, float* scr, int gw, int NGW, int lane) {
    const int nblk = N / 32, items = (K / 64) * nblk;
    for (int it = gw; it < items; it += NGW) { const int kb = it / nblk, nb = it % nblk; transpose_item(W, ldw, K, WT, 64 * kb, 32 * nb, scr, lane); }
}

template <bool WITH_IF>
__device__ __forceinline__ void rms_row(const float* xrow, const float* g, bf16_t* orow, const float* w_in, const float* b_if, float* ifout, int lane) {
    const f32x4* xr = (const f32x4*)xrow + lane; const f32x4* gr = (const f32x4*)g + lane;
    f32x4 v[4]; float s = 0.f;
#pragma unroll
    for (int j = 0; j < 4; ++j) { v[j] = xr[64 * j]; s += (v[j].x * v[j].x + v[j].y * v[j].y) + (v[j].z * v[j].z + v[j].w * v[j].w); }
    const float r = rsqrtf(wave_sum(s) * (1.f / D) + EPS);
#pragma unroll
    for (int j = 0; j < 4; ++j) v[j] = v[j] * r * gr[64 * j];
    u32x2* o8 = (u32x2*)orow + lane;
#pragma unroll
    for (int j = 0; j < 4; ++j) { u32x2 w; w.x = pk2(v[j].x, v[j].y); w.y = pk2(v[j].z, v[j].w); o8[64 * j] = w; }
    if (WITH_IF) {
        float a[8];
#pragma unroll
        for (int e = 0; e < 8; ++e) a[e] = 0.f;
#pragma unroll
        for (int j = 0; j < 4; ++j)
#pragma unroll
            for (int i = 0; i < 4; ++i) { const int k = 256 * j + 4 * lane + i; const f32x4* wp = (const f32x4*)(w_in + (size_t)k * NIN + IF_COL); const f32x4 w0 = wp[0], w1 = wp[1]; const float hv = v[j][i];
                a[0] += hv * w0.x; a[1] += hv * w0.y; a[2] += hv * w0.z; a[3] += hv * w0.w; a[4] += hv * w1.x; a[5] += hv * w1.y; a[6] += hv * w1.z; a[7] += hv * w1.w; }
#pragma unroll
        for (int e = 0; e < 8; ++e) a[e] = wave_sum(a[e]);
        if (lane == 0) {
#pragma unroll
            for (int e = 0; e < 8; ++e) ifout[e] = a[e] + b_if[e]; }
    }
}

namespace pg8 {
#define PG8_LAS __attribute__((address_space(3)))
typedef unsigned short bf16_t;
typedef short bf16x8 __attribute__((ext_vector_type(8)));
typedef float f32x4 __attribute__((ext_vector_type(4)));
typedef unsigned u32x4 __attribute__((ext_vector_type(4)));
constexpr int BM = 256, BK = 64, HALF = 128, HTB = HALF * BK * 2  , STAGE_BYTES = 8 * HTB, NXCD = 8, WGM = 8;

__host__ __device__ __forceinline__ int lds_byte(int r, int c) { const int st = (r >> 4) * 2 + (c >> 5), rr = r & 15, cc = c & 31, ob = rr * 64 + cc * 2; return st * 1024 + (ob ^ (((ob >> 9) & 1) << 5)); }
__host__ __device__ __forceinline__ void stage_rc(int b, int& R, int& C) { const int st = b / 1024, sb = b % 1024, swz = sb ^ (((sb >> 9) & 1) << 5); R = (st >> 1) * 16 + swz / 64; C = (st & 1) * 32 + (swz % 64) / 2; }
__host__ __device__ __forceinline__ int perm32(int rho) { const int n = rho >> 4, i = rho & 15; return 8 * (i >> 2) + 4 * n + (i & 3); }

struct Unit { int pm, pn; };
struct Gemm { const bf16_t* A; const bf16_t* Bt; int M, N, K; };

struct StaticOrder {
    int nM, nN, nwg, G, c;
    __host__ __device__ void init(int M, int N, int G_, int c_) { nM = M / BM; nN = N / BM; nwg = nM * nN; G = G_; c = c_; }
    __host__ __device__ bool next(int i, Unit& u) const {
        const long L = (long)i * G + c; if (L >= nwg) return false;
        int wgid = (int)L; { const int q = nwg / NXCD, r = nwg % NXCD, xcd = wgid % NXCD, off = wgid / NXCD; wgid = (xcd < r ? xcd * (q + 1) : r * (q + 1) + (xcd - r) * q) + off; }
        const int nig = WGM * nN, gid = wgid / nig, fm = gid * WGM, gsz = (nM - fm) < WGM ? (nM - fm) : WGM;
        u.pm = fm + ((wgid % nig) % gsz); u.pn = (wgid % nig) / gsz; return true;
    }
    __device__ __forceinline__ void a_ready(const Unit&) const {}
    __device__ __forceinline__ void done(const Unit&) const {}
};
template <class Epi, class Sched, bool ALIGN_EPI = false, bool SP2 = false>
__device__ __forceinline__ void gemm_phase(PG8_LAS unsigned char* lds, const Gemm g, const Sched& S, const Epi& E) {
    int tid_ = threadIdx.x; asm volatile("" : "+v"(tid_));
    const int tid = tid_, wid = __builtin_amdgcn_readfirstlane(tid >> 6), lane = tid & 63, wr = wid >> 2, wc = wid & 3, fr = lane & 15, fq = lane >> 4;
    const int K = g.K, nt = K / BK;
    unsigned voffA[2], voffB[2];
#pragma unroll
    for (int i = 0; i < 2; ++i) { int R, C; stage_rc(tid * 16 + i * 8192, R, C); const int Rb = Epi::PERM ? ((R & ~31) + perm32(R & 31)) : R;
        voffA[i] = (unsigned)(R * K + C) * 2u; voffB[i] = (unsigned)(Rb * K + C) * 2u; }
    const size_t kstep = (size_t)(BK * 2);
    const size_t hstep = (size_t)HALF * K * 2;
    const size_t tstep = 2 * hstep;
    const unsigned ldsw = (unsigned)wid * 1024u;
    const int aoff = lds_byte(wr * 64 + fr, fq * 8), boff = lds_byte(wc * 32 + fr, fq * 8);
#define PG8_SA(b, h) (((b) * 2 + (h)) * HTB)
#define PG8_SB(b, h) ((4 + (b) * 2 + (h)) * HTB)
#define PG8_STAGE(bufoff, gbase, voff) do { _Pragma("unroll") for (int _i = 0; _i < 2; ++_i) \
        __builtin_amdgcn_global_load_lds((const unsigned*)((const char*)(gbase) + (voff)[_i]), (PG8_LAS unsigned*)(lds + (bufoff) + ldsw + _i * 8192), 16, 0, 0); } while (0)
#define PG8_LDA(dst, b, h) do { _Pragma("unroll") for (int m = 0; m < 4; ++m) _Pragma("unroll") for (int k = 0; k < 2; ++k) dst[m][k] = *(const PG8_LAS bf16x8*)(lds + PG8_SA(b, h) + aoff + m * 2048 + k * 1024); } while (0)
#define PG8_LDB(dst, b, h) do { _Pragma("unroll") for (int n = 0; n < 2; ++n) _Pragma("unroll") for (int k = 0; k < 2; ++k) dst[n][k] = *(const PG8_LAS bf16x8*)(lds + PG8_SB(b, h) + boff + n * 2048 + k * 1024); } while (0)
#define PG8_MMA(ai, bj, At, Bt) do { __builtin_amdgcn_s_setprio(1); _Pragma("unroll") for (int m = 0; m < 4; ++m) _Pragma("unroll") for (int n = 0; n < 2; ++n) _Pragma("unroll") for (int k = 0; k < 2; ++k) \
        acc[ai][bj][m][n] = __builtin_amdgcn_mfma_f32_16x16x32_bf16(Bt[n][k], At[m][k], acc[ai][bj][m][n], 0, 0, 0); __builtin_amdgcn_s_setprio(0); } while (0)
#define PG8_WAIT_V(n) asm volatile("s_waitcnt vmcnt(" #n ")" ::: "memory")
#define PG8_WAIT_L(n) asm volatile("s_waitcnt lgkmcnt(" #n ")" ::: "memory")
#define PG8_BAR __builtin_amdgcn_s_barrier()
#define PG8_SCHED __builtin_amdgcn_sched_barrier(0)
    Unit cur, nxt; int ui = 0;
    if (!S.next(0, cur)) return;
    f32x4 acc[2][2][4][2];
#pragma unroll
    for (int a = 0; a < 2; ++a)
#pragma unroll
        for (int b = 0; b < 2; ++b)
#pragma unroll
            for (int m = 0; m < 4; ++m)
#pragma unroll
                for (int n = 0; n < 2; ++n) acc[a][b][m][n] = (f32x4){0.f, 0.f, 0.f, 0.f};
    bf16x8 At[4][2], B0[2][2], B1[2][2];
    const char* cA = (const char*)g.A + (size_t)cur.pm * tstep; const char* cB = (const char*)g.Bt + (size_t)cur.pn * tstep;
    S.a_ready(cur);
    if constexpr (SP2) {
        PG8_STAGE(PG8_SB(0, 0), cB, voffB); PG8_STAGE(PG8_SB(0, 1), cB + hstep, voffB); PG8_STAGE(PG8_SA(0, 0), cA, voffA); PG8_STAGE(PG8_SA(0, 1), cA + hstep, voffA);
        if (wr == 1) PG8_BAR;
        PG8_WAIT_V(2); PG8_BAR;
        PG8_STAGE(PG8_SB(1, 0), cB + kstep, voffB); PG8_STAGE(PG8_SA(1, 0), cA + kstep, voffA); PG8_STAGE(PG8_SB(1, 1), cB + hstep + kstep, voffB);
        PG8_WAIT_V(6); PG8_BAR;
    } else {
        PG8_STAGE(PG8_SB(0, 0), cB, voffB); PG8_STAGE(PG8_SA(0, 0), cA, voffA); PG8_STAGE(PG8_SB(0, 1), cB + hstep, voffB); PG8_STAGE(PG8_SA(0, 1), cA + hstep, voffA);
        if (wr == 1) PG8_BAR;
        PG8_WAIT_V(4); PG8_BAR;
        PG8_STAGE(PG8_SB(1, 0), cB + kstep, voffB); PG8_STAGE(PG8_SA(1, 0), cA + kstep, voffA); PG8_STAGE(PG8_SB(1, 1), cB + hstep + kstep, voffB);
        PG8_WAIT_V(6); PG8_BAR;
    }
    for (;;) {
        const bool has_next = S.next(ui + 1, nxt);
        const char* nA = has_next ? (const char*)g.A + (size_t)nxt.pm * tstep : cA; const char* nB = has_next ? (const char*)g.Bt + (size_t)nxt.pn * tstep : cB;
        for (int t = 0; t < nt; t += 2) {
            const bool last = (t == nt - 2);
            const char* a1 = cA + (size_t)(t + 1) * kstep;
            const char* a2 = last ? nA : cA + (size_t)(t + 2) * kstep; const char* b2 = last ? nB : cB + (size_t)(t + 2) * kstep;
            const char* a3 = a2 + kstep; const char* b3 = b2 + kstep;
            if (last && has_next) S.a_ready(nxt);
            if constexpr (SP2) {
            PG8_LDB(B0, 0, 0); PG8_LDB(B1, 0, 1); PG8_SCHED; PG8_LDA(At, 0, 0); PG8_STAGE(PG8_SA(1, 1), a1 + hstep, voffA);
            PG8_WAIT_V(8); PG8_WAIT_L(0); PG8_BAR; PG8_MMA(0, 0, At, B0); PG8_MMA(0, 1, At, B1); PG8_BAR; PG8_SCHED;
            PG8_LDA(At, 0, 1); PG8_STAGE(PG8_SB(0, 0), b2, voffB); PG8_STAGE(PG8_SB(0, 1), b2 + hstep, voffB); PG8_STAGE(PG8_SA(0, 0), a2, voffA);
            PG8_WAIT_V(8); PG8_WAIT_L(0); PG8_BAR; PG8_MMA(1, 0, At, B0); PG8_MMA(1, 1, At, B1); PG8_BAR; PG8_SCHED;
            PG8_LDB(B0, 1, 0); PG8_LDB(B1, 1, 1); PG8_SCHED; PG8_LDA(At, 1, 0); PG8_STAGE(PG8_SA(0, 1), a2 + hstep, voffA);
            PG8_WAIT_V(8); PG8_WAIT_L(0); PG8_BAR; PG8_MMA(0, 0, At, B0); PG8_MMA(0, 1, At, B1); PG8_BAR; PG8_SCHED;
            PG8_LDA(At, 1, 1); PG8_STAGE(PG8_SB(1, 0), b3, voffB); PG8_STAGE(PG8_SB(1, 1), b3 + hstep, voffB); PG8_STAGE(PG8_SA(1, 0), a3, voffA);
            PG8_WAIT_V(8); PG8_WAIT_L(0); PG8_BAR; PG8_MMA(1, 0, At, B0); PG8_MMA(1, 1, At, B1); PG8_BAR; PG8_SCHED;
            } else {
            PG8_LDB(B0, 0, 0); PG8_SCHED; PG8_LDA(At, 0, 0); PG8_STAGE(PG8_SA(1, 1), a1 + hstep, voffA);
            PG8_WAIT_L(8); PG8_BAR; PG8_WAIT_L(0); PG8_MMA(0, 0, At, B0); PG8_BAR; PG8_SCHED;
            PG8_LDB(B1, 0, 1); PG8_STAGE(PG8_SB(0, 0), b2, voffB);
            PG8_BAR; PG8_WAIT_L(0); PG8_MMA(0, 1, At, B1); PG8_BAR;
            PG8_LDA(At, 0, 1); PG8_STAGE(PG8_SA(0, 0), a2, voffA);
            PG8_BAR; PG8_WAIT_L(0); PG8_MMA(1, 0, At, B0); PG8_BAR; PG8_SCHED;
            PG8_STAGE(PG8_SB(0, 1), b2 + hstep, voffB);
            PG8_WAIT_V(6); PG8_BAR; PG8_MMA(1, 1, At, B1); PG8_BAR;
            PG8_LDB(B0, 1, 0); PG8_SCHED; PG8_LDA(At, 1, 0); PG8_STAGE(PG8_SA(0, 1), a2 + hstep, voffA);
            PG8_WAIT_L(8); PG8_BAR; PG8_WAIT_L(0); PG8_MMA(0, 0, At, B0); PG8_BAR; PG8_SCHED;
            PG8_LDB(B1, 1, 1); PG8_STAGE(PG8_SB(1, 0), b3, voffB);
            PG8_BAR; PG8_WAIT_L(0); PG8_MMA(0, 1, At, B1); PG8_BAR;
            PG8_LDA(At, 1, 1); PG8_STAGE(PG8_SA(1, 0), a3, voffA);
            PG8_BAR; PG8_WAIT_L(0); PG8_MMA(1, 0, At, B0); PG8_BAR; PG8_SCHED;
            PG8_STAGE(PG8_SB(1, 1), b3 + hstep, voffB);
            PG8_WAIT_V(6); PG8_BAR; PG8_MMA(1, 1, At, B1); PG8_BAR;
            }
        }
        if constexpr (ALIGN_EPI) { if (wr == 0) PG8_BAR; }
        if constexpr (!Epi::AFTER_DRAIN) { E(acc, cur, wr, wc, fr, fq); S.done(cur); }
        if (!has_next) break;
#pragma unroll
        for (int a = 0; a < 2; ++a)
#pragma unroll
            for (int b = 0; b < 2; ++b)
#pragma unroll
                for (int m = 0; m < 4; ++m)
#pragma unroll
                    for (int n = 0; n < 2; ++n) acc[a][b][m][n] = (f32x4){0.f, 0.f, 0.f, 0.f};
        cur = nxt; cA = nA; cB = nB; ++ui;
        if constexpr (ALIGN_EPI) { if (wr == 1) PG8_BAR; }
    }
    PG8_WAIT_V(0);
    if constexpr (!ALIGN_EPI) { if (wr == 0) PG8_BAR; }
    PG8_BAR;
    if constexpr (Epi::AFTER_DRAIN) { E.fused(acc, cur, wr, wc, fr, fq, lds, wid, lane); S.done(cur); }
#undef PG8_SA
#undef PG8_SB
#undef PG8_STAGE
#undef PG8_LDA
#undef PG8_LDB
#undef PG8_MMA
#undef PG8_WAIT_V
#undef PG8_WAIT_L
#undef PG8_BAR
#undef PG8_SCHED
}
}

template <class EW> struct EpiAdapt { static constexpr bool PERM = false, AFTER_DRAIN = false; EW e;
    __device__ __forceinline__ void operator()(const f32x4 (&acc)[2][2][4][2], const pg8::Unit& u, int wr, int wc, int fr, int fq) const {
#pragma unroll
        for (int ai = 0; ai < 2; ++ai)
#pragma unroll
            for (int m = 0; m < 4; ++m) { const int row = u.pm * 256 + ai * 128 + wr * 64 + m * 16 + fr;
#pragma unroll
                for (int bj = 0; bj < 2; ++bj)
#pragma unroll
                    for (int n = 0; n < 2; ++n) e(row, u.pn * 256 + bj * 128 + wc * 32 + n * 16 + 4 * fq, acc[ai][bj][m][n]); } } };
template <class EW>
__device__ __forceinline__ void gemm_fast(unsigned char* lds, const bf16_t* A, const bf16_t* Bt, int M, int N, int K, const EW& e) {
    pg8::Gemm g{A, Bt, M, N, K}; pg8::StaticOrder S; S.init(M, N, (int)gridDim.x, (int)blockIdx.x);
    EpiAdapt<EW> E{e};
    pg8::gemm_phase<EpiAdapt<EW>, pg8::StaticOrder, true, true>((PG8_LAS unsigned char*)lds, g, S, E);
}

struct EpiBf16 { bf16_t* O; int ldc;
    __device__ __forceinline__ void operator()(int r, int c, f32x4 v) const { u32x2 w; w.x = pk2(v.x, v.y); w.y = pk2(v.z, v.w); *(u32x2*)(O + (size_t)r * ldc + c) = w; } };
struct EpiBf16Halo { bf16_t* O; bf16_t* H;
    __device__ __forceinline__ void operator()(int r, int c, f32x4 v) const { u32x2 w; w.x = pk2(v.x, v.y); w.y = pk2(v.z, v.w); *(u32x2*)(O + (size_t)r * D + c) = w;
        const int rr = r & 63; if (rr >= 61) *(u32x2*)(H + ((size_t)(r >> 6) * 3 + (rr - 61)) * D + c) = w; } };
struct EpiGate { bf16_t* S0; const float* bias;
    __device__ __forceinline__ void operator()(int r, int c, f32x4 v) const { const f32x4 b = *(const f32x4*)(bias + c); const int s = c >> 10, cc = c & 1023; bf16_t* O = S0 + (size_t)(3 + s + (s > 0 ? 1 : 0)) * (SLOT_BYTES / 2);
        u32x2 w; w.x = pk2(sigmoidf_(v.x + b.x), sigmoidf_(v.y + b.y)); w.y = pk2(sigmoidf_(v.z + b.z), sigmoidf_(v.w + b.w)); *(u32x2*)(O + (size_t)r * D + cc) = w; } };
template <int MODE>
struct EpiMix { const bf16_t* G; float* Mx; bf16_t* O;
    __device__ __forceinline__ void operator()(int r, int c, f32x4 v) const { const size_t off = (size_t)r * D + c; const u32x2 gw = *(const u32x2*)(G + off);
        f32x4 m = (f32x4){bflo(gw.x) * v.x, bfhi(gw.x) * v.y, bflo(gw.y) * v.z, bfhi(gw.y) * v.w};
        if (MODE >= 1) m = m + *(const f32x4*)(Mx + off);
        if (MODE <= 1) *(f32x4*)(Mx + off) = m; else { u32x2 w; w.x = pk2(m.x, m.y); w.y = pk2(m.z, m.w); *(u32x2*)(O + off) = w; } } };
struct EpiResid { const float* base; float* out;
    __device__ __forceinline__ void operator()(int r, int c, f32x4 v) const { const size_t off = (size_t)r * D + c; *(f32x4*)(out + off) = *(const f32x4*)(base + off) + v; } };
struct EpiRelu2 { bf16_t* O; int ldc;
    __device__ __forceinline__ void operator()(int r, int c, f32x4 v) const { f32x4 t = (f32x4){fmaxf(v.x, 0.f), fmaxf(v.y, 0.f), fmaxf(v.z, 0.f), fmaxf(v.w, 0.f)}; t = t * t;
        u32x2 w; w.x = pk2(t.x, t.y); w.y = pk2(t.z, t.w); *(u32x2*)(O + (size_t)r * ldc + c) = w; } };

__device__ __forceinline__ void sb_naive(bf16_t* Q, const bf16_t* Kk, const bf16_t* VT, float* qs, int gw, int NGW, int lane) {
    const float scale = 0.08838834764831845f;
    for (int w = gw; w < 2048; w += NGW) {
        for (int i = 0; i < 128; ++i) {
            const int bh = i >> 1, t = (i & 1) ? (SEQ - 1 - w) : w, b = bh >> 3, h = bh & 7;
            const size_t row = (size_t)b * SEQ + t;
            bf16_t* qrow = Q + row * D + h * 128;
            { const unsigned qw = *(const unsigned*)(qrow + 2 * lane); qs[2 * lane] = bflo(qw) * scale; qs[2 * lane + 1] = bfhi(qw) * scale; }
            LDS_WAIT();
            float acc[128];
#pragma unroll
            for (int d = 0; d < 128; ++d) acc[d] = 0.f;
            float R = 0.f;
            const int nb = (t + 63) >> 6;
            for (int blk = nb - 1; blk >= 0; --blk) {
                const int s = blk * 64 + lane; const bool valid = s < t;
                const bf16_t* krow = Kk + ((size_t)b * SEQ + s) * D + h * 128;
                float z = 0.f;
#pragma unroll
                for (int c = 0; c < 16; ++c) { const u32x4 kw = *(const u32x4*)(krow + 8 * c); const f32x4 q0 = *(const f32x4*)(qs + 8 * c), q1 = *(const f32x4*)(qs + 8 * c + 4);
                    z += bflo(kw.x) * q0.x + bfhi(kw.x) * q0.y + bflo(kw.y) * q0.z + bfhi(kw.y) * q0.w + bflo(kw.z) * q1.x + bfhi(kw.z) * q1.y + bflo(kw.w) * q1.z + bfhi(kw.w) * q1.w; }
                const float e = __expf(-fabsf(z)); const float sp = fmaxf(z, 0.f) + __logf(1.f + e);
                const float lm = valid ? -sp : 0.f, ls = z - sp;
                float incl = lm;
#pragma unroll
                for (int off = 1; off < 64; off <<= 1) { const float tmp = __shfl_down(incl, off); if (lane + off < 64) incl += tmp; }
                const float later = R + incl - lm;
                const float p = valid ? __expf(ls + later) : 0.f;
                R += __shfl(incl, 0);
                const bf16_t* vcol = VT + (size_t)(h * 128) * T + (size_t)b * SEQ + s;
#pragma unroll
                for (int d0 = 0; d0 < 128; d0 += 16) {
#pragma unroll
                    for (int d = d0; d < d0 + 16; ++d) acc[d] += p * bf2f(vcol[(size_t)d * T]);
                    asm volatile("" ::: "memory"); }
            }
            float o0 = 0.f, o1 = 0.f;
#pragma unroll
            for (int d = 0; d < 128; ++d) { const float tot = wave_sum(acc[d]); if ((d & 63) == lane) { if (d < 64) o0 = tot; else o1 = tot; } }
            qrow[lane] = (bf16_t)f2bf(o0); qrow[64 + lane] = (bf16_t)f2bf(o1);
            LDS_WAIT();
        }
    }
}

#define LAS __attribute__((address_space(3)))
typedef float f32x16 __attribute__((ext_vector_type(16)));
constexpr int SB_KST = 272, SB_VST = 136, SB_KBYTES = 64 * SB_KST, SB_VBYTES = 128 * SB_VST, SB_BUF = SB_KBYTES + SB_VBYTES;
template <bool DIAG>
__device__ __forceinline__ void sb_subtile(LAS unsigned char* buf, int st, const bf16x8 (&qf)[8], f32x16 (&Y)[4], float& R, int k0, int qi, int r32, int hh) {
    f32x16 X;
#pragma unroll
    for (int r = 0; r < 16; ++r) X[r] = 0.f;
    LAS unsigned char* kp = buf + (32 * st + r32) * SB_KST + hh * 16;
#pragma unroll
    for (int s = 0; s < 8; ++s) { const bf16x8 kf = *(LAS bf16x8*)(kp + s * 32); X = __builtin_amdgcn_mfma_f32_32x32x16_bf16(kf, qf[s], X, 0, 0, 0); }
    float lm[16];
#pragma unroll
    for (int r = 0; r < 16; ++r) { const float z = X[r] * 0.08838834764831845f; const float e = __expf(-fabsf(z)); const float sp = fmaxf(z, 0.f) + __logf(1.f + e);
        const int key = k0 + (r & 3) + 8 * (r >> 2) + 4 * hh; const bool valid = !DIAG || key < qi;
        lm[r] = valid ? -sp : 0.f; X[r] = z - sp; }
    float g[4], og[4], pr[4];
#pragma unroll
    for (int c = 0; c < 4; ++c) { g[c] = (lm[4 * c] + lm[4 * c + 1]) + (lm[4 * c + 2] + lm[4 * c + 3]); og[c] = __shfl_xor(g[c], 32); pr[c] = g[c] + og[c]; }
    float Tc[4]; Tc[3] = 0.f; Tc[2] = pr[3]; Tc[1] = pr[3] + pr[2]; Tc[0] = Tc[1] + pr[1];
    const float total = Tc[0] + pr[0];
#pragma unroll
    for (int c = 0; c < 4; ++c) { float later = R + Tc[c] + (hh == 0 ? og[c] : 0.f);
#pragma unroll
        for (int i = 3; i >= 0; --i) { const int r = 4 * c + i; const int key = k0 + i + 8 * c + 4 * hh; const bool valid = !DIAG || key < qi;
            const float pv = valid ? __expf(X[r] + later) : 0.f; later += lm[r]; X[r] = pv; } }
    R += total;
    bf16x8 pf[2];
#pragma unroll
    for (int s2 = 0; s2 < 2; ++s2) { u32x4 w; w.x = pk2(X[8 * s2], X[8 * s2 + 1]); w.y = pk2(X[8 * s2 + 2], X[8 * s2 + 3]); w.z = pk2(X[8 * s2 + 4], X[8 * s2 + 5]); w.w = pk2(X[8 * s2 + 6], X[8 * s2 + 7]); pf[s2] = __builtin_bit_cast(bf16x8, w); }
#pragma unroll
    for (int dt = 0; dt < 4; ++dt) { LAS unsigned char* vp = buf + SB_KBYTES + (32 * dt + r32) * SB_VST + (32 * st + 4 * hh) * 2;
#pragma unroll
        for (int s2 = 0; s2 < 2; ++s2) { const u32x2 lo = *(LAS u32x2*)(vp + s2 * 32), hi = *(LAS u32x2*)(vp + s2 * 32 + 16);
            u32x4 w; w.x = lo.x; w.y = lo.y; w.z = hi.x; w.w = hi.y;
            Y[dt] = __builtin_amdgcn_mfma_f32_32x32x16_bf16(__builtin_bit_cast(bf16x8, w), pf[s2], Y[dt], 0, 0, 0); } }
}
__device__ __forceinline__ void sb_fast(bf16_t* Q, const bf16_t* Kk, const bf16_t* VT, LAS unsigned char* lds) {
    int tid_ = threadIdx.x; asm volatile("" : "+v"(tid_));
    const int tid = tid_, lane = tid & 63, wid = tid >> 6, r32 = lane & 31, hh = lane >> 5;
    for (int vw = blockIdx.x; vw < 256; vw += gridDim.x) {
        const int bh = vw >> 2, jj = vw & 3, b = bh >> 3, h = bh & 7;
        const bf16_t* kg = Kk + ((size_t)b * SEQ) * D + h * 128;
        const bf16_t* vg = VT + (size_t)(h * 128) * T + (size_t)b * SEQ;
        for (int ui = 0; ui < 4; ++ui) {
            const int qb = ui == 0 ? 2 * jj : (ui == 1 ? 15 - 2 * jj : (ui == 2 ? 2 * jj + 1 : 14 - 2 * jj));
            const int q0w = qb * 256 + 32 * wid, qi = q0w + r32;
            bf16_t* qrow = Q + ((size_t)b * SEQ + qi) * D + h * 128;
            bf16x8 qf[8];
#pragma unroll
            for (int s = 0; s < 8; ++s) qf[s] = *(const bf16x8*)(qrow + 16 * s + 8 * hh);
            f32x16 Y[4];
#pragma unroll
            for (int dt = 0; dt < 4; ++dt)
#pragma unroll
                for (int r = 0; r < 16; ++r) Y[dt][r] = 0.f;
            float R = 0.f;
            const int ktmax = 4 * qb + 3;
            u32x4 kr[2], vr[2];
#define SB_LOADG(kt) do { _Pragma("unroll") for (int i_ = 0; i_ < 2; ++i_) { const int c_ = tid + 512 * i_; \
                kr[i_] = *(const u32x4*)(kg + (size_t)(64 * (kt) + (c_ >> 4)) * D + (c_ & 15) * 8); \
                vr[i_] = *(const u32x4*)(vg + (size_t)(c_ >> 3) * T + 64 * (kt) + (c_ & 7) * 8); } } while (0)
#define SB_STORES(bufp) do { _Pragma("unroll") for (int i_ = 0; i_ < 2; ++i_) { const int c_ = tid + 512 * i_; \
                *(LAS u32x4*)((bufp) + (c_ >> 4) * SB_KST + (c_ & 15) * 16) = kr[i_]; \
                LAS u32x2* vp_ = (LAS u32x2*)((bufp) + SB_KBYTES + (c_ >> 3) * SB_VST + (c_ & 7) * 16); \
                u32x2 a_; a_.x = vr[i_].x; a_.y = vr[i_].y; u32x2 b_; b_.x = vr[i_].z; b_.y = vr[i_].w; vp_[0] = a_; vp_[1] = b_; } } while (0)
            SB_LOADG(ktmax); SB_STORES(lds); __syncthreads();
            for (int kt = ktmax, it = 0; kt >= 0; --kt, ++it) {
                LAS unsigned char* cur = lds + (it & 1) * SB_BUF; LAS unsigned char* nxt = lds + ((it & 1) ^ 1) * SB_BUF;
                if (kt > 0) SB_LOADG(kt - 1);
#pragma unroll
                for (int st = 1; st >= 0; --st) { const int k0 = 64 * kt + 32 * st;
                    if (k0 < q0w + 31) { if (k0 + 31 >= q0w) sb_subtile<true>(cur, st, qf, Y, R, k0, qi, r32, hh); else sb_subtile<false>(cur, st, qf, Y, R, k0, qi, r32, hh); } }
                if (kt > 0) SB_STORES(nxt);
                __syncthreads();
            }
#undef SB_LOADG
#undef SB_STORES
#pragma unroll
            for (int dt = 0; dt < 4; ++dt)
#pragma unroll
                for (int c = 0; c < 4; ++c) { u32x2 w; w.x = pk2(Y[dt][4 * c], Y[dt][4 * c + 1]); w.y = pk2(Y[dt][4 * c + 2], Y[dt][4 * c + 3]); *(u32x2*)(qrow + 32 * dt + 8 * c + 4 * hh) = w; }
        }
    }
}

__device__ __forceinline__ void conv_pass(bf16_t* MQ, bf16_t* MK, const bf16_t* haloQ, const bf16_t* haloK, const float* conv_w, const float* conv_b, int gw, int NGW, int lane) {
    for (int it = gw; it < 2048; it += NGW) {
        const int blk = it >> 2, isk = (it >> 1) & 1, half = it & 1;
        const int ch0 = (half * 64 + lane) * 8;
        bf16_t* base = (isk ? MK : MQ) + (size_t)blk * 64 * D + ch0;
        const float* cw = conv_w + isk * 1024 + ch0;
        float w0[8], w1[8], w2[8], w3[8], cb[8], r0[8], r1[8], r2[8];
#pragma unroll
        for (int e = 0; e < 8; ++e) { w0[e] = cw[e]; w1[e] = cw[2048 + e]; w2[e] = cw[4096 + e]; w3[e] = cw[6144 + e]; cb[e] = conv_b[isk * 1024 + ch0 + e]; r0[e] = 0.f; r1[e] = 0.f; r2[e] = 0.f; }
        if ((blk & 63) != 0) { const bf16_t* hal = (isk ? haloK : haloQ) + (size_t)(blk - 1) * 3 * D + ch0;
            const u32x4 h0 = *(const u32x4*)hal, h1 = *(const u32x4*)(hal + D), h2 = *(const u32x4*)(hal + 2 * D);
#pragma unroll
            for (int e2 = 0; e2 < 4; ++e2) { r0[2 * e2] = bflo(h0[e2]); r0[2 * e2 + 1] = bfhi(h0[e2]); r1[2 * e2] = bflo(h1[e2]); r1[2 * e2 + 1] = bfhi(h1[e2]); r2[2 * e2] = bflo(h2[e2]); r2[2 * e2 + 1] = bfhi(h2[e2]); } }
        const float osc = isk ? 0.0625f : 1.f;
        for (int r8 = 0; r8 < 64; r8 += 8) {
            u32x4 in[8];
#pragma unroll
            for (int i = 0; i < 8; ++i) in[i] = *(const u32x4*)(base + (size_t)(r8 + i) * D);
#pragma unroll
            for (int i = 0; i < 8; ++i) { float y[8];
#pragma unroll
                for (int e = 0; e < 8; ++e) { const float xv = (e & 1) ? bfhi(in[i][e >> 1]) : bflo(in[i][e >> 1]);
                    const float u = w0[e] * r0[e] + w1[e] * r1[e] + w2[e] * r2[e] + w3[e] * xv + cb[e]; r0[e] = r1[e]; r1[e] = r2[e]; r2[e] = xv; y[e] = u / (1.f + __expf(-u)) * osc; }
                u32x4 o; o.x = pk2(y[0], y[1]); o.y = pk2(y[2], y[3]); o.z = pk2(y[4], y[5]); o.w = pk2(y[6], y[7]); *(u32x4*)(base + (size_t)(r8 + i) * D) = o; }
        }
    }
}

constexpr int ML_QS = 0, ML_KS = 33792, ML_KST = 67584, ML_VTS = 104448, ML_VWT = 109200, ML_SCB = 113952, ML_CB = 123168, ML_VEC = 140592, ML_RS = 528, ML_TS = 144;
__device__ __forceinline__ void mlstm_fast(const bf16_t* MQ, const bf16_t* MK, const bf16_t* MVT, const float* ifp, bf16_t* HUN, LAS unsigned char* lds) {
    int tid_ = threadIdx.x; asm volatile("" : "+v"(tid_));
    const int tid = tid_, lane = tid & 63, w = tid >> 6, fr = lane & 15, fq = lane >> 4;
    LAS float* vA = (LAS float*)(lds + ML_VEC); LAS float* vM = vA + 64; LAS float* vSI = vA + 128; LAS float* vEM = vA + 192; LAS float* vWK = vA + 256; LAS float* vDEC = vA + 320;
    const int tt = w & 3, sp = w >> 2;
    for (int item = blockIdx.x; item < 256; item += gridDim.x) {
        const int bh = item >> 3, vs = item & 7, b = bh >> 2, h = bh & 3;
        const bf16_t* qg = MQ + ((size_t)b * SEQ + lane) * D + h * 256 + 32 * w;
        const bf16_t* kg = MK + ((size_t)b * SEQ + lane) * D + h * 256 + 32 * w;
        const bf16_t* vg = MVT + (size_t)(h * 256 + vs * 32 + ((tid >> 3) & 31)) * T + (size_t)b * SEQ + (tid & 7) * 8;
        const float* ig = ifp + ((size_t)b * SEQ + lane) * 8 + h;
        bf16_t* hg = HUN + ((size_t)b * SEQ + 16 * tt + fr) * D + h * 256 + vs * 32 + 16 * sp + 4 * fq;
        for (int i = tid; i < 17424 / 16; i += NTHREADS) *(LAS u32x4*)(lds + ML_CB + i * 16) = (u32x4){0u, 0u, 0u, 0u};
        if (tid < 32) *(LAS unsigned*)(lds + ML_VTS + 32 * ML_TS + 4 * tid) = 0x3F803F80u;
        u32x4 pq[4], pk[4], pv; float gi = 0.f, gf = 0.f, ngi = 0.f, ngf = 0.f;
#define ML_LOAD(c) do { _Pragma("unroll") for (int i_ = 0; i_ < 4; ++i_) { pq[i_] = *(const u32x4*)(qg + (size_t)(64 * (c)) * D + 8 * i_); pk[i_] = *(const u32x4*)(kg + (size_t)(64 * (c)) * D + 8 * i_); } \
            if (tid < 256) pv = *(const u32x4*)(vg + 64 * (c)); if (w == 0) { ngi = ig[(size_t)(64 * (c)) * 8]; ngf = ig[(size_t)(64 * (c)) * 8 + 4]; } } while (0)
#define ML_STORE() do { _Pragma("unroll") for (int i_ = 0; i_ < 4; ++i_) { *(LAS u32x4*)(lds + ML_QS + lane * ML_RS + (4 * w + i_) * 16) = pq[i_]; *(LAS u32x4*)(lds + ML_KS + lane * ML_RS + (4 * w + i_) * 16) = pk[i_]; \
                _Pragma("unroll") for (int e_ = 0; e_ < 8; ++e_) { const unsigned wd_ = pk[i_][e_ >> 1]; *(LAS bf16_t*)(lds + ML_KST + (32 * w + 8 * i_ + e_) * ML_TS + 2 * lane) = (bf16_t)((e_ & 1) ? (wd_ >> 16) : (wd_ & 0xffffu)); } } \
            if (tid < 256) *(LAS u32x4*)(lds + ML_VTS + (tid >> 3) * ML_TS + (tid & 7) * 16) = pv; } while (0)
        ML_LOAD(0); ML_STORE(); gi = ngi; gf = ngf;
        __syncthreads();
        float m_prev = 0.f;
        f32x4 Cacc[2][3];
#pragma unroll
        for (int u = 0; u < 2; ++u)
#pragma unroll
            for (int v3 = 0; v3 < 3; ++v3) Cacc[u][v3] = (f32x4){0.f, 0.f, 0.f, 0.f};
#pragma unroll 1
        for (int c = 0; c < 64; ++c) {
            if (c < 63) ML_LOAD(c + 1);
            if (w == 0) {
                const float lf = -(fmaxf(-gf, 0.f) + __logf(1.f + __expf(-fabsf(gf))));
                float bc = lf;
#pragma unroll
                for (int o = 1; o < 64; o <<= 1) { const float t_ = __shfl_up(bc, o); if (lane >= o) bc += t_; }
                const float a = gi - bc;
                float pm = a;
#pragma unroll
                for (int o = 1; o < 64; o <<= 1) { const float t_ = __shfl_up(pm, o); if (lane >= o) pm = fmaxf(pm, t_); }
                const float Mt = fmaxf(m_prev, pm);
                const float Mend = __shfl(Mt, 63), bend = __shfl(bc, 63);
                vA[lane] = a; vM[lane] = Mt; vSI[lane] = __expf(m_prev - Mt); vEM[lane] = __expf(-(bc + Mt)); vWK[lane] = __expf(a - Mend);
                if (lane == 0) vDEC[0] = __expf(m_prev - Mend);
                m_prev = bend + Mend;
            }
            f32x4 S[2]; S[0] = (f32x4){0.f, 0.f, 0.f, 0.f}; S[1] = S[0];
            if (2 * sp <= tt) {
#pragma unroll
                for (int ks = 0; ks < 8; ++ks) { const bf16x8 bq = *(LAS bf16x8*)(lds + ML_QS + (16 * tt + fr) * ML_RS + (32 * ks + 8 * fq) * 2);
                    const bf16x8 a0 = *(LAS bf16x8*)(lds + ML_KS + (32 * sp + fr) * ML_RS + (32 * ks + 8 * fq) * 2); S[0] = __builtin_amdgcn_mfma_f32_16x16x32_bf16(a0, bq, S[0], 0, 0, 0);
                    if (2 * sp + 1 <= tt) { const bf16x8 a1 = *(LAS bf16x8*)(lds + ML_KS + (32 * sp + 16 + fr) * ML_RS + (32 * ks + 8 * fq) * 2); S[1] = __builtin_amdgcn_mfma_f32_16x16x32_bf16(a1, bq, S[1], 0, 0, 0); } }
            }
            __syncthreads();
            { const float Mt = vM[16 * tt + fr]; const int t = 16 * tt + fr;
#pragma unroll
              for (int u = 0; u < 2; ++u) { const int st = 2 * sp + u; const f32x4 av = *(LAS f32x4*)(vA + 16 * st + 4 * fq); float sc[4];
#pragma unroll
                  for (int j = 0; j < 4; ++j) { const int s_ = 16 * st + 4 * fq + j; sc[j] = (s_ <= t) ? S[u][j] * __expf(av[j] - Mt) : 0.f; }
                  u32x2 o; o.x = pk2(sc[0], sc[1]); o.y = pk2(sc[2], sc[3]); *(LAS u32x2*)(lds + ML_SCB + t * ML_TS + (16 * st + 4 * fq) * 2) = o; }
              const int v_ = tid >> 4, s4 = (tid & 15) * 4; const f32x4 wk = *(LAS f32x4*)(vWK + s4);
              const u32x2 vv = *(LAS u32x2*)(lds + ML_VTS + v_ * ML_TS + s4 * 2);
              u32x2 o; o.x = pk2(bflo(vv.x) * wk.x, bfhi(vv.x) * wk.y); o.y = pk2(bflo(vv.y) * wk.z, bfhi(vv.y) * wk.w); *(LAS u32x2*)(lds + ML_VWT + v_ * ML_TS + s4 * 2) = o;
              if (tid < 16) { u32x2 o2; o2.x = pk2(wk.x, wk.y); o2.y = pk2(wk.z, wk.w); *(LAS u32x2*)(lds + ML_VWT + 32 * ML_TS + s4 * 2) = o2; } }
            __syncthreads();
            { f32x4 a1 = (f32x4){0.f, 0.f, 0.f, 0.f}, a1n = a1, a2 = a1, a2n = a1;
#pragma unroll
              for (int ks = 0; ks < 8; ++ks) { const bf16x8 bq = *(LAS bf16x8*)(lds + ML_QS + (16 * tt + fr) * ML_RS + (32 * ks + 8 * fq) * 2);
                  const bf16x8 ac = *(LAS bf16x8*)(lds + ML_CB + (16 * sp + fr) * ML_RS + (32 * ks + 8 * fq) * 2); const bf16x8 an = *(LAS bf16x8*)(lds + ML_CB + 32 * ML_RS + (32 * ks + 8 * fq) * 2);
                  a1 = __builtin_amdgcn_mfma_f32_16x16x32_bf16(ac, bq, a1, 0, 0, 0); a1n = __builtin_amdgcn_mfma_f32_16x16x32_bf16(an, bq, a1n, 0, 0, 0); }
#pragma unroll
              for (int ks = 0; ks < 2; ++ks) { const bf16x8 bs = *(LAS bf16x8*)(lds + ML_SCB + (16 * tt + fr) * ML_TS + (32 * ks + 8 * fq) * 2);
                  const bf16x8 av = *(LAS bf16x8*)(lds + ML_VTS + (16 * sp + fr) * ML_TS + (32 * ks + 8 * fq) * 2); const bf16x8 an = *(LAS bf16x8*)(lds + ML_VTS + 32 * ML_TS + (32 * ks + 8 * fq) * 2);
                  a2 = __builtin_amdgcn_mfma_f32_16x16x32_bf16(av, bs, a2, 0, 0, 0); a2n = __builtin_amdgcn_mfma_f32_16x16x32_bf16(an, bs, a2n, 0, 0, 0); }
              const float si = vSI[16 * tt + fr], em = vEM[16 * tt + fr];
              const float den = a2n[0] + si * a1n[0]; const float rd = 1.f / fmaxf(fabsf(den), em);
              u32x2 o; o.x = pk2((a2[0] + si * a1[0]) * rd, (a2[1] + si * a1[1]) * rd); o.y = pk2((a2[2] + si * a1[2]) * rd, (a2[3] + si * a1[3]) * rd);
              *(u32x2*)(hg + (size_t)(64 * c) * D) = o; }
            { const float dec = vDEC[0];
#pragma unroll
              for (int u = 0; u < 2; ++u)
#pragma unroll
                  for (int v3 = 0; v3 < 3; ++v3) Cacc[u][v3] = Cacc[u][v3] * dec;
#pragma unroll
              for (int ks = 0; ks < 2; ++ks) { bf16x8 bv[3];
#pragma unroll
                  for (int v3 = 0; v3 < 3; ++v3) { const int vr = (v3 < 2) ? 16 * v3 + fr : 32; bv[v3] = *(LAS bf16x8*)(lds + ML_VWT + vr * ML_TS + (32 * ks + 8 * fq) * 2); }
#pragma unroll
                  for (int u = 0; u < 2; ++u) { const bf16x8 ak = *(LAS bf16x8*)(lds + ML_KST + (16 * (2 * w + u) + fr) * ML_TS + (32 * ks + 8 * fq) * 2);
#pragma unroll
                      for (int v3 = 0; v3 < 3; ++v3) Cacc[u][v3] = __builtin_amdgcn_mfma_f32_16x16x32_bf16(ak, bv[v3], Cacc[u][v3], 0, 0, 0); } } }
            __syncthreads();
#pragma unroll
            for (int u = 0; u < 2; ++u)
#pragma unroll
                for (int v3 = 0; v3 < 3; ++v3) { if (v3 < 2 || fr == 0) { const int vr = (v3 < 2) ? 16 * v3 + fr : 32; const f32x4 cv = Cacc[u][v3];
                    u32x2 o; o.x = pk2(cv.x, cv.y); o.y = pk2(cv.z, cv.w); *(LAS u32x2*)(lds + ML_CB + vr * ML_RS + (16 * (2 * w + u) + 4 * fq) * 2) = o; } }
            if (c < 63) { ML_STORE(); gi = ngi; gf = ngf; }
            __syncthreads();
        }
#undef ML_LOAD
#undef ML_STORE
    }
}

__device__ __forceinline__ void memk_norm(bf16_t* MK, const float* gk, const float* gq, int gw, int NGW, int lane) {
    for (int r = gw; r < TMEM * 4; r += NGW) { const int bm = r >> 2, h = r & 3; bf16_t* p = MK + (size_t)bm * D + h * 256 + 4 * lane;
        const u32x2 w = *(const u32x2*)p; f32x4 v = (f32x4){bflo(w.x), bfhi(w.x), bflo(w.y), bfhi(w.y)};
        const float rs = rsqrtf(wave_sum(v.x * v.x + v.y * v.y + v.z * v.z + v.w * v.w) * (1.f / 256.f) + EPS);
        const f32x4 g = *(const f32x4*)(gk + 4 * lane); const f32x4 g2 = *(const f32x4*)(gq + 4 * lane); v = v * rs * g * g2 * 0.0625f;
        u32x2 o; o.x = pk2(v.x, v.y); o.y = pk2(v.z, v.w); *(u32x2*)p = o; }
}
__device__ __forceinline__ void cross_fast(bf16_t* XQ, const bf16_t* MK, const bf16_t* MVT, int gw, int NGW, int lane) {
    const int fr = lane & 15, fq = lane >> 4;
    for (int wu = gw; wu < (T / 16) * 4; wu += NGW) {
        const int h = wu & 3, t0 = (wu >> 2) * 16, b = t0 >> 12;
        bf16_t* qrow = XQ + (size_t)(t0 + fr) * D + h * 256;
        bf16x8 qf[8]; float ss = 0.f;
#pragma unroll
        for (int s = 0; s < 8; ++s) { const u32x4 w = *(const u32x4*)(qrow + 32 * s + 8 * fq); qf[s] = __builtin_bit_cast(bf16x8, w);
            ss += bflo(w.x) * bflo(w.x) + bfhi(w.x) * bfhi(w.x) + bflo(w.y) * bflo(w.y) + bfhi(w.y) * bfhi(w.y) + bflo(w.z) * bflo(w.z) + bfhi(w.z) * bfhi(w.z) + bflo(w.w) * bflo(w.w) + bfhi(w.w) * bfhi(w.w); }
        ss += __shfl_xor(ss, 16); ss += __shfl_xor(ss, 32);
        const float rs = rsqrtf(ss * (1.f / 256.f) + EPS);
        const bf16_t* kb = MK + (size_t)(b * NMEM + fr) * D + h * 256 + 8 * fq;
        f32x4 X[16];
#pragma unroll
        for (int kt = 0; kt < 16; ++kt) { X[kt] = (f32x4){0.f, 0.f, 0.f, 0.f};
#pragma unroll
            for (int s = 0; s < 8; ++s) { const bf16x8 kf = *(const bf16x8*)(kb + (size_t)(16 * kt) * D + 32 * s); X[kt] = __builtin_amdgcn_mfma_f32_16x16x32_bf16(kf, qf[s], X[kt], 0, 0, 0); } }
        float mx = -3.0e38f;
#pragma unroll
        for (int kt = 0; kt < 16; ++kt) { X[kt] = X[kt] * rs; mx = fmaxf(mx, fmaxf(fmaxf(X[kt].x, X[kt].y), fmaxf(X[kt].z, X[kt].w))); }
        mx = fmaxf(mx, __shfl_xor(mx, 16)); mx = fmaxf(mx, __shfl_xor(mx, 32));
        float sum = 0.f;
#pragma unroll
        for (int kt = 0; kt < 16; ++kt) { X[kt].x = __expf(X[kt].x - mx); X[kt].y = __expf(X[kt].y - mx); X[kt].z = __expf(X[kt].z - mx); X[kt].w = __expf(X[kt].w - mx); sum += (X[kt].x + X[kt].y) + (X[kt].z + X[kt].w); }
        sum += __shfl_xor(sum, 16); sum += __shfl_xor(sum, 32);
        const float inv = 1.f / sum;
        bf16x8 pf[8];
#pragma unroll
        for (int kp = 0; kp < 8; ++kp) { u32x4 w; w.x = pk2(X[2 * kp].x, X[2 * kp].y); w.y = pk2(X[2 * kp].z, X[2 * kp].w); w.z = pk2(X[2 * kp + 1].x, X[2 * kp + 1].y); w.w = pk2(X[2 * kp + 1].z, X[2 * kp + 1].w); pf[kp] = __builtin_bit_cast(bf16x8, w); }
        const bf16_t* vb = MVT + (size_t)(h * 256 + fr) * TMEM + b * NMEM + 4 * fq;
#pragma unroll 4
        for (int dt = 0; dt < 16; ++dt) { f32x4 Y = (f32x4){0.f, 0.f, 0.f, 0.f};
#pragma unroll
            for (int kp = 0; kp < 8; ++kp) { const u32x2 lo = *(const u32x2*)(vb + (size_t)(16 * dt) * TMEM + 32 * kp), hi = *(const u32x2*)(vb + (size_t)(16 * dt) * TMEM + 32 * kp + 16);
                u32x4 w; w.x = lo.x; w.y = lo.y; w.z = hi.x; w.w = hi.y; Y = __builtin_amdgcn_mfma_f32_16x16x32_bf16(__builtin_bit_cast(bf16x8, w), pf[kp], Y, 0, 0, 0); }
            Y = Y * inv; u32x2 o; o.x = pk2(Y.x, Y.y); o.y = pk2(Y.z, Y.w); *(u32x2*)(qrow + 16 * dt + 4 * fq) = o; }
    }
}
__device__ __forceinline__ void ml_finalize(const bf16_t* HUN, const bf16_t* MO, const float* g, bf16_t* Y, int gw, int NGW, int lane) {
    for (int r = gw; r < T * 4; r += NGW) { const size_t off = (size_t)(r >> 2) * D + (r & 3) * 256 + 4 * lane;
        const u32x2 w = *(const u32x2*)(HUN + off); f32x4 v = (f32x4){bflo(w.x), bfhi(w.x), bflo(w.y), bfhi(w.y)};
        const float rs = rsqrtf(wave_sum(v.x * v.x + v.y * v.y + v.z * v.z + v.w * v.w) * (1.f / 256.f) + EPS);
        const f32x4 gg = *(const f32x4*)(g + (r & 3) * 256 + 4 * lane); const u32x2 ow = *(const u32x2*)(MO + off);
        v = v * rs * gg; v.x *= sigmoidf_(bflo(ow.x)); v.y *= sigmoidf_(bfhi(ow.x)); v.z *= sigmoidf_(bflo(ow.y)); v.w *= sigmoidf_(bfhi(ow.y));
        u32x2 o; o.x = pk2(v.x, v.y); o.y = pk2(v.z, v.w); *(u32x2*)(Y + off) = o; }
}

__global__ void __launch_bounds__(NTHREADS) fwd_megakernel(Params p) {
    extern __shared__ __attribute__((aligned(16))) unsigned char lds[];
    cg::grid_group grid = cg::this_grid();
    const int tid = threadIdx.x, lane = tid & 63, wave = tid >> 6;
    const int gw = blockIdx.x * NWAVES + wave, NGW = gridDim.x * NWAVES;
    unsigned char* ws = p.ws; unsigned char* dob = (unsigned char*)p.out;
    const float* x = p.in[0]; const float* mem = p.in[1]; const float* g_mix = p.in[2]; const float* w_in = p.in[3]; const float* b_if = p.in[4]; const float* b_gate = p.in[5];
    const float* conv_w = p.in[6]; const float* conv_b = p.in[7]; const float* ml_norm_g = p.in[8]; const float* g_mem = p.in[9]; const float* w_mem_kv = p.in[10];
    const float* q_norm_g = p.in[11]; const float* k_norm_g = p.in[12]; const float* w_sb = p.in[13]; const float* w_ml = p.in[14]; const float* w_x = p.in[15]; const float* w_out = p.in[16];
    const float* g_mlp = p.in[17]; const float* w_ff1 = p.in[18]; const float* w_ff2 = p.in[19];
    bf16_t* Wt_in = (bf16_t*)(ws + WS_WIN); bf16_t* Wt_mkv = (bf16_t*)(ws + WS_WMKV); bf16_t* Wt_sb = (bf16_t*)(ws + WS_WSB); bf16_t* Wt_ml = (bf16_t*)(ws + WS_WML);
    bf16_t* Wt_x = (bf16_t*)(ws + WS_WX); bf16_t* Wt_out = (bf16_t*)(ws + WS_WOUT); bf16_t* Wt_ff1 = (bf16_t*)(ws + WS_WFF1); bf16_t* Wt_ff2 = (bf16_t*)(ws + WS_WFF2);
    float* ifp = (float*)(ws + WS_IF);
#define SLOT(i) ((bf16_t*)(ws + WS_SLOT0 + (size_t)(i) * SLOT_BYTES))
    bf16_t* memn = (bf16_t*)(dob + DO_MEMN); bf16_t* memk = (bf16_t*)(dob + DO_MEMK); bf16_t* memvt = (bf16_t*)(dob + DO_MEMVT); bf16_t* hun = (bf16_t*)(dob + DO_HUN);
    float* wscr = (float*)(lds + wave * 8448);

    transpose_matrix(w_in, NIN, D, 7168, Wt_in, wscr, gw, NGW, lane);
    transpose_matrix(w_in + 7176, NIN, D, 4096, Wt_in + (size_t)7168 * D, wscr, gw, NGW, lane);
    transpose_matrix(w_mem_kv, 2048, D, 2048, Wt_mkv, wscr, gw, NGW, lane);
    transpose_matrix(w_sb, D, D, D, Wt_sb, wscr, gw, NGW, lane);
    transpose_matrix(w_ml, D, D, D, Wt_ml, wscr, gw, NGW, lane);
    transpose_matrix(w_x, D, D, D, Wt_x, wscr, gw, NGW, lane);
    transpose_matrix(w_out, D, D, D, Wt_out, wscr, gw, NGW, lane);
    transpose_matrix(w_ff1, FF, D, FF, Wt_ff1, wscr, gw, NGW, lane);
    transpose_matrix(w_ff2, D, FF, D, Wt_ff2, wscr, gw, NGW, lane);
    for (int m = gw; m < T; m += NGW) rms_row<true>(x + (size_t)m * D, g_mix, SLOT(0) + (size_t)m * D, w_in, b_if, ifp + (size_t)m * 8, lane);
    for (int m = gw; m < TMEM; m += NGW) rms_row<false>(mem + (size_t)m * D, g_mem, memn + (size_t)m * D, nullptr, nullptr, nullptr, lane);
    grid.sync();

    { const bf16_t* hN = SLOT(0);
      gemm_fast(lds, hN, Wt_in + (size_t)0 * D, T, 1024, D, EpiBf16{SLOT(1), D});
      gemm_fast(lds, hN, Wt_in + (size_t)1024 * D, T, 1024, D, EpiBf16{SLOT(2), D});
      gemm_fast(lds, Wt_in + (size_t)2048 * D, hN, 1024, T, D, EpiBf16{SLOT(3), T});
      gemm_fast(lds, hN, Wt_in + (size_t)3072 * D, T, 1024, D, EpiBf16Halo{SLOT(4), (bf16_t*)(ws + WS_HALOQ)});
      gemm_fast(lds, hN, Wt_in + (size_t)4096 * D, T, 1024, D, EpiBf16Halo{SLOT(5), (bf16_t*)(ws + WS_HALOK)});
      gemm_fast(lds, Wt_in + (size_t)5120 * D, hN, 1024, T, D, EpiBf16{SLOT(6), T});
      gemm_fast(lds, memn, Wt_mkv, TMEM, 1024, D, EpiBf16{memk, D});
      gemm_fast(lds, Wt_mkv + (size_t)1024 * D, memn, 1024, TMEM, D, EpiBf16{memvt, TMEM}); }
    grid.sync();

    memk_norm(memk, k_norm_g, q_norm_g, gw, NGW, lane);
    conv_pass(SLOT(4), SLOT(5), (const bf16_t*)(ws + WS_HALOQ), (const bf16_t*)(ws + WS_HALOK), conv_w, conv_b, gw, NGW, lane);
    grid.sync();
    mlstm_fast(SLOT(4), SLOT(5), SLOT(6), ifp, hun, (LAS unsigned char*)lds);
    __syncthreads();
    sb_fast(SLOT(1), SLOT(2), SLOT(3), (LAS unsigned char*)lds);
    grid.sync();

    gemm_fast(lds, SLOT(0), Wt_in + (size_t)7168 * D, T, 1024, D, EpiBf16{SLOT(2), D});
    gemm_fast(lds, SLOT(0), Wt_in + (size_t)6144 * D, T, 1024, D, EpiBf16{SLOT(3), D});
    grid.sync();

    cross_fast(SLOT(2), memk, memvt, gw, NGW, lane);
    ml_finalize(hun, SLOT(3), ml_norm_g, SLOT(4), gw, NGW, lane);
    grid.sync();

    gemm_fast(lds, SLOT(0), Wt_in + (size_t)8192 * D, T, 3072, D, EpiGate{SLOT(0), b_gate});
    grid.sync();

    gemm_fast(lds, SLOT(1), Wt_sb, T, D, D, EpiMix<0>{SLOT(3), p.out, nullptr});
    grid.sync();
    gemm_fast(lds, SLOT(4), Wt_ml, T, D, D, EpiMix<1>{SLOT(5), p.out, nullptr});
    grid.sync();
    gemm_fast(lds, SLOT(2), Wt_x, T, D, D, EpiMix<2>{SLOT(6), p.out, SLOT(0)});
    grid.sync();

    gemm_fast(lds, SLOT(0), Wt_out, T, D, D, EpiResid{x, p.out});
    grid.sync();

    for (int m = gw; m < T; m += NGW) rms_row<false>(p.out + (size_t)m * D, g_mlp, SLOT(1) + (size_t)m * D, nullptr, nullptr, nullptr, lane);
    grid.sync();

    gemm_fast(lds, SLOT(1), Wt_ff1, T, FF, D, EpiRelu2{SLOT(2), FF});
    grid.sync();

    gemm_fast(lds, SLOT(2), Wt_ff2, T, D, FF, EpiResid{p.out, p.out});
}

extern "C" void kernel_launch(void* const* d_in, const int* in_sizes, int n_in, void* d_out, int out_size, void* d_ws, size_t ws_size, hipStream_t stream) {
    static int grid_blocks = 0;
    if (grid_blocks == 0) {
        if (n_in != 20 || out_size != T * D || ws_size < WS_NEED) { fprintf(stderr, "kernel_launch: unexpected shapes (n_in %d out %d ws %zu)\n", n_in, out_size, ws_size); grid_blocks = -1; return; }
        int dev = 0, cus = 0, per_cu = 0;
        hipGetDevice(&dev);
        hipDeviceGetAttribute(&cus, hipDeviceAttributeMultiprocessorCount, dev);
        hipFuncSetAttribute((const void*)fwd_megakernel, hipFuncAttributeMaxDynamicSharedMemorySize, LDS_BYTES);
        hipOccupancyMaxActiveBlocksPerMultiprocessor(&per_cu, (const void*)fwd_megakernel, NTHREADS, LDS_BYTES);
        if (per_cu < 1) per_cu = 1;
        grid_blocks = cus * per_cu;
    }
    if (grid_blocks < 0) return;
    Params p{};
    for (int i = 0; i < 20; ++i) p.in[i] = (const float*)d_in[i];
    p.out = (float*)d_out; p.ws = (unsigned char*)d_ws;
    void* args[] = {&p};
    hipError_t e = hipLaunchCooperativeKernel((const void*)fwd_megakernel, dim3(grid_blocks), dim3(NTHREADS), args, LDS_BYTES, stream);
    if (e != hipSuccess) fprintf(stderr, "cooperative launch failed: %s (grid %d)\n", hipGetErrorString(e), grid_blocks);
}
```

```cpp
#include <hip/hip_runtime.h>
#include <hip/hip_cooperative_groups.h>
#include <cstdint>
#include <cstdio>
namespace cg = cooperative_groups;

typedef unsigned short bf16_t;
typedef short bf16x8 __attribute__((ext_vector_type(8)));
typedef float f32x4 __attribute__((ext_vector_type(4)));
typedef unsigned u32x2 __attribute__((ext_vector_type(2)));
typedef unsigned u32x4 __attribute__((ext_vector_type(4)));

constexpr int D = 1024, BATCH = 8, SEQ = 4096, T = BATCH * SEQ, NMEM = 256, TMEM = BATCH * NMEM, FF = 4096;
constexpr int NIN = 11272;
constexpr int IF_COL = 7168;
constexpr float EPS = 1e-6f;
constexpr int NTHREADS = 512, NWAVES = 8;
constexpr int LDS_BYTES = 144 * 1024;
#ifndef PROBE_PHASE
#define PROBE_PHASE 0
#endif
#define PROBE_BEGIN(k) do { if (PROBE_PHASE & (1 << (k))) probe_t0 = __builtin_amdgcn_s_memrealtime(); } while (0)
#define PROBE_END(k) do { if (PROBE_PHASE & (1 << (k))) probe_dur += __builtin_amdgcn_s_memrealtime() - probe_t0; } while (0)

constexpr size_t MiB = (size_t)1 << 20;
constexpr size_t WS_WIN = 0;
constexpr size_t WS_WMKV = 22 * MiB;
constexpr size_t WS_WSB = 26 * MiB, WS_WML = 28 * MiB, WS_WX = 30 * MiB, WS_WOUT = 32 * MiB;
constexpr size_t WS_WFF1 = 34 * MiB;
constexpr size_t WS_WFF2 = 42 * MiB;
constexpr size_t WS_IF = 50 * MiB;
constexpr size_t WS_GATE = 58 * MiB;
constexpr size_t WS_SSQ = 57 * MiB;
constexpr size_t WS_HALOQ = 51 * MiB, WS_HALOK = 54 * MiB;
constexpr size_t WS_SLOT0 = 64 * MiB, SLOT_BYTES = 64 * MiB;
constexpr size_t WS_NEED = WS_SLOT0 + 7 * SLOT_BYTES;
constexpr size_t DO_MEMN = 0;
constexpr size_t DO_MEMK = 4 * MiB;
constexpr size_t DO_MEMVT = 8 * MiB;
constexpr size_t DO_HUN = 64 * MiB;

struct Params { const float* in[20]; float* out; unsigned char* ws; };

__device__ __forceinline__ unsigned f2bf(float f) { unsigned u = __builtin_bit_cast(unsigned, f); return (u + 0x7fffu + ((u >> 16) & 1u)) >> 16; }
typedef float f32x2_t __attribute__((ext_vector_type(2))); typedef __bf16 bf16x2_t __attribute__((ext_vector_type(2)));
__device__ __forceinline__ unsigned pk2(float lo, float hi) { f32x2_t v = {lo, hi}; bf16x2_t b = __builtin_convertvector(v, bf16x2_t); return __builtin_bit_cast(unsigned, b); }
__device__ __forceinline__ float bf2f(bf16_t v) { return __builtin_bit_cast(float, (unsigned)v << 16); }
__device__ __forceinline__ float bflo(unsigned w) { return __builtin_bit_cast(float, w << 16); }
__device__ __forceinline__ float bfhi(unsigned w) { return __builtin_bit_cast(float, w & 0xffff0000u); }
__device__ __forceinline__ float wave_sum(float v) {
#pragma unroll
    for (int o = 1; o < 64; o <<= 1) v += __shfl_xor(v, o);
    return v;
}
__device__ __forceinline__ float wave_max(float v) {
#pragma unroll
    for (int o = 1; o < 64; o <<= 1) v = fmaxf(v, __shfl_xor(v, o));
    return v;
}
__device__ __forceinline__ float sigmoidf_(float x) { return __builtin_amdgcn_rcpf(1.f + __builtin_amdgcn_exp2f(x * -1.4426950408889634f)); }
#define LDS_WAIT() asm volatile("s_waitcnt lgkmcnt(0)" ::: "memory")
#define LDS_BARRIER() do { asm volatile("s_waitcnt lgkmcnt(0)" ::: "memory"); __builtin_amdgcn_s_barrier(); asm volatile("" ::: "memory"); } while (0)

__device__ __forceinline__ void transpose_item(const float* W, int ldw, int K, bf16_t* WT, int k0, int n0, float* scr, int lane, const float* kscale) {
#pragma unroll 8
    for (int i = 0; i < 32; ++i) { const int kk = 2 * i + (lane >> 5); float v = W[(size_t)(k0 + kk) * ldw + n0 + (lane & 31)]; if (kscale) v *= kscale[k0 + kk]; scr[kk * 33 + (lane & 31)] = v; }
    LDS_WAIT();
    const int c = lane & 7;
#pragma unroll
    for (int j = 0; j < 4; ++j) { const int n = (lane >> 3) + 8 * j; const float* s = scr + (8 * c) * 33 + n;
        u32x4 o; o.x = pk2(s[0 * 33], s[1 * 33]); o.y = pk2(s[2 * 33], s[3 * 33]); o.z = pk2(s[4 * 33], s[5 * 33]); o.w = pk2(s[6 * 33], s[7 * 33]);
        *(u32x4*)(WT + (size_t)(n0 + n) * K + k0 + 8 * c) = o; }
    LDS_WAIT();
}
__device__ __forceinline__ void transpose_matrix(const float* W, int ldw, int K, int N, bf16_t* WT, float* scr, int gw, int NGW, int lane, const float* kscale = nullptr) {
    const int nblk = N / 32, items = (K / 64) * nblk;
    for (int it = gw; it < items; it += NGW) { const int kb = it / nblk, nb = it % nblk; transpose_item(W, ldw, K, WT, 64 * kb, 32 * nb, scr, lane, kscale); }
}

template <bool WITH_IF>
__device__ __forceinline__ void rms_row(const float* xrow, const float* g, bf16_t* orow, const float* wif  , const float* b_if, float* ifout, int lane) {
    const f32x4* xr = (const f32x4*)xrow + lane; const f32x4* gr = (const f32x4*)g + lane;
    f32x4 v[4]; float s = 0.f;
#pragma unroll
    for (int j = 0; j < 4; ++j) { v[j] = xr[64 * j]; s += (v[j].x * v[j].x + v[j].y * v[j].y) + (v[j].z * v[j].z + v[j].w * v[j].w); }
    const float r = rsqrtf(wave_sum(s) * (1.f / D) + EPS);
#pragma unroll
    for (int j = 0; j < 4; ++j) v[j] = v[j] * r * gr[64 * j];
    u32x2* o8 = (u32x2*)orow + lane;
#pragma unroll
    for (int j = 0; j < 4; ++j) { u32x2 w; w.x = pk2(v[j].x, v[j].y); w.y = pk2(v[j].z, v[j].w); o8[64 * j] = w; }
    if (WITH_IF) {
        float a[8];
#pragma unroll
        for (int e = 0; e < 8; ++e) { a[e] = 0.f;
#pragma unroll
            for (int j = 0; j < 4; ++j) { const f32x4 w = *(const f32x4*)(wif + e * 1024 + 256 * j + 4 * lane); a[e] += (v[j].x * w.x + v[j].y * w.y) + (v[j].z * w.z + v[j].w * w.w); }
            a[e] = wave_sum(a[e]); }
        if (lane == 0) {
#pragma unroll
            for (int e = 0; e < 8; ++e) ifout[e] = a[e] + b_if[e]; }
    }
}

__device__ __forceinline__ void rms_row_regs(const f32x4 (&vin)[4], const float* g, bf16_t* orow, const float* wif  , const float* b_if, float* ifout, int lane) {
    const f32x4* gr = (const f32x4*)g + lane; f32x4 v[4]; float s = 0.f;
#pragma unroll
    for (int j = 0; j < 4; ++j) { v[j] = vin[j]; s += (v[j].x * v[j].x + v[j].y * v[j].y) + (v[j].z * v[j].z + v[j].w * v[j].w); }
    const float r = rsqrtf(wave_sum(s) * (1.f / D) + EPS);
#pragma unroll
    for (int j = 0; j < 4; ++j) v[j] = v[j] * r * gr[64 * j];
    u32x2* o8 = (u32x2*)orow + lane;
#pragma unroll
    for (int j = 0; j < 4; ++j) { u32x2 w; w.x = pk2(v[j].x, v[j].y); w.y = pk2(v[j].z, v[j].w); o8[64 * j] = w; }
    float a[8];
#pragma unroll
    for (int e = 0; e < 8; ++e) { a[e] = 0.f;
#pragma unroll
        for (int j = 0; j < 4; ++j) { const f32x4 w = *(const f32x4*)(wif + e * 1024 + 256 * j + 4 * lane); a[e] += (v[j].x * w.x + v[j].y * w.y) + (v[j].z * w.z + v[j].w * w.w); } }
#pragma unroll
    for (int o = 1; o < 64; o <<= 1) {
#pragma unroll
        for (int e = 0; e < 8; ++e) a[e] += __shfl_xor(a[e], o); }
    if (lane == 0) {
#pragma unroll
        for (int e = 0; e < 8; ++e) ifout[e] = a[e] + b_if[e]; }
}

namespace pg8 {
#define PG8_LAS __attribute__((address_space(3)))
typedef unsigned short bf16_t;
typedef short bf16x8 __attribute__((ext_vector_type(8)));
typedef float f32x4 __attribute__((ext_vector_type(4)));
typedef unsigned u32x4 __attribute__((ext_vector_type(4)));
constexpr int BM = 256, BK = 64, HALF = 128, HTB = HALF * BK * 2  , STAGE_BYTES = 8 * HTB, NXCD = 8, WGM = 8;

__host__ __device__ __forceinline__ int lds_byte(int r, int c) { const int st = (r >> 4) * 2 + (c >> 5), rr = r & 15, cc = c & 31, ob = rr * 64 + cc * 2; return st * 1024 + (ob ^ (((ob >> 9) & 1) << 5)); }
__host__ __device__ __forceinline__ void stage_rc(int b, int& R, int& C) { const int st = b / 1024, sb = b % 1024, swz = sb ^ (((sb >> 9) & 1) << 5); R = (st >> 1) * 16 + swz / 64; C = (st & 1) * 32 + (swz % 64) / 2; }
__host__ __device__ __forceinline__ int perm32(int rho) { const int n = rho >> 4, i = rho & 15; return 8 * (i >> 2) + 4 * n + (i & 3); }

struct Unit { int pm, pn; };
struct Gemm { const bf16_t* A; const bf16_t* Bt; int M, N, K; };

struct StaticOrder {
    int nM, nN, nwg, G, c;
    __host__ __device__ void init(int M, int N, int G_, int c_) { nM = M / BM; nN = N / BM; nwg = nM * nN; G = G_; c = c_; }
    __host__ __device__ bool next(int i, Unit& u) const {
        const long L = (long)i * G + c; if (L >= nwg) return false;
        int wgid = (int)L; { const int q = nwg / NXCD, r = nwg % NXCD, xcd = wgid % NXCD, off = wgid / NXCD; wgid = (xcd < r ? xcd * (q + 1) : r * (q + 1) + (xcd - r) * q) + off; }
        const int nig = WGM * nN, gid = wgid / nig, fm = gid * WGM, gsz = (nM - fm) < WGM ? (nM - fm) : WGM;
        u.pm = fm + ((wgid % nig) % gsz); u.pn = (wgid % nig) / gsz; return true;
    }
    __device__ __forceinline__ void a_ready(const Unit&) const {}
    __device__ __forceinline__ void done(const Unit&) const {}
};
template <class Epi, class Sched, bool ALIGN_EPI = false, bool SP2 = false>
__device__ __forceinline__ void gemm_phase(PG8_LAS unsigned char* lds, const Gemm g, const Sched& S, const Epi& E) {
    int tid_ = threadIdx.x; asm volatile("" : "+v"(tid_));
    const int tid = tid_, wid = __builtin_amdgcn_readfirstlane(tid >> 6), lane = tid & 63, wr = wid >> 2, wc = wid & 3, fr = lane & 15, fq = lane >> 4;
    const int K = g.K, nt = K / BK;
    unsigned voffA[2], voffB[2];
#pragma unroll
    for (int i = 0; i < 2; ++i) { int R, C; stage_rc(tid * 16 + i * 8192, R, C); const int Rb = Epi::PERM ? ((R & ~31) + perm32(R & 31)) : R;
        voffA[i] = (unsigned)(R * K + C) * 2u; voffB[i] = (unsigned)(Rb * K + C) * 2u; }
    const size_t kstep = (size_t)(BK * 2);
    const size_t hstep = (size_t)HALF * K * 2;
    const size_t tstep = 2 * hstep;
    const unsigned ldsw = (unsigned)wid * 1024u;
    const int aoff = lds_byte(wr * 64 + fr, fq * 8), boff = lds_byte(wc * 32 + fr, fq * 8);
#define PG8_SA(b, h) (((b) * 2 + (h)) * HTB)
#define PG8_SB(b, h) ((4 + (b) * 2 + (h)) * HTB)
#define PG8_STAGE(bufoff, gbase, voff) do { _Pragma("unroll") for (int _i = 0; _i < 2; ++_i) \
        __builtin_amdgcn_global_load_lds((const unsigned*)((const char*)(gbase) + (voff)[_i]), (PG8_LAS unsigned*)(lds + (bufoff) + ldsw + _i * 8192), 16, 0, 0); } while (0)
#define PG8_LDA(dst, b, h) do { _Pragma("unroll") for (int m = 0; m < 4; ++m) _Pragma("unroll") for (int k = 0; k < 2; ++k) dst[m][k] = *(const PG8_LAS bf16x8*)(lds + PG8_SA(b, h) + aoff + m * 2048 + k * 1024); } while (0)
#define PG8_LDB(dst, b, h) do { _Pragma("unroll") for (int n = 0; n < 2; ++n) _Pragma("unroll") for (int k = 0; k < 2; ++k) dst[n][k] = *(const PG8_LAS bf16x8*)(lds + PG8_SB(b, h) + boff + n * 2048 + k * 1024); } while (0)
#define PG8_MMA(ai, bj, At, Bt) do { __builtin_amdgcn_s_setprio(1); _Pragma("unroll") for (int m = 0; m < 4; ++m) _Pragma("unroll") for (int n = 0; n < 2; ++n) _Pragma("unroll") for (int k = 0; k < 2; ++k) \
        acc[ai][bj][m][n] = __builtin_amdgcn_mfma_f32_16x16x32_bf16(Bt[n][k], At[m][k], acc[ai][bj][m][n], 0, 0, 0); __builtin_amdgcn_s_setprio(0); } while (0)
#define PG8_WAIT_V(n) asm volatile("s_waitcnt vmcnt(" #n ")" ::: "memory")
#define PG8_WAIT_L(n) asm volatile("s_waitcnt lgkmcnt(" #n ")" ::: "memory")
#define PG8_BAR __builtin_amdgcn_s_barrier()
#define PG8_SCHED __builtin_amdgcn_sched_barrier(0)
    Unit cur, nxt; int ui = 0;
    if (!S.next(0, cur)) return;
    f32x4 acc[2][2][4][2];
#pragma unroll
    for (int a = 0; a < 2; ++a)
#pragma unroll
        for (int b = 0; b < 2; ++b)
#pragma unroll
            for (int m = 0; m < 4; ++m)
#pragma unroll
                for (int n = 0; n < 2; ++n) acc[a][b][m][n] = (f32x4){0.f, 0.f, 0.f, 0.f};
    bf16x8 At[4][2], B0[2][2], B1[2][2];
    const char* cA = (const char*)g.A + (size_t)cur.pm * tstep; const char* cB = (const char*)g.Bt + (size_t)cur.pn * tstep;
    S.a_ready(cur);
    if constexpr (SP2) {
        PG8_STAGE(PG8_SB(0, 0), cB, voffB); PG8_STAGE(PG8_SB(0, 1), cB + hstep, voffB); PG8_STAGE(PG8_SA(0, 0), cA, voffA); PG8_STAGE(PG8_SA(0, 1), cA + hstep, voffA);
        if (wr == 1) PG8_BAR;
        PG8_WAIT_V(2); PG8_BAR;
        PG8_STAGE(PG8_SB(1, 0), cB + kstep, voffB); PG8_STAGE(PG8_SA(1, 0), cA + kstep, voffA); PG8_STAGE(PG8_SB(1, 1), cB + hstep + kstep, voffB);
        PG8_WAIT_V(6); PG8_BAR;
    } else {
        PG8_STAGE(PG8_SB(0, 0), cB, voffB); PG8_STAGE(PG8_SA(0, 0), cA, voffA); PG8_STAGE(PG8_SB(0, 1), cB + hstep, voffB); PG8_STAGE(PG8_SA(0, 1), cA + hstep, voffA);
        if (wr == 1) PG8_BAR;
        PG8_WAIT_V(4); PG8_BAR;
        PG8_STAGE(PG8_SB(1, 0), cB + kstep, voffB); PG8_STAGE(PG8_SA(1, 0), cA + kstep, voffA); PG8_STAGE(PG8_SB(1, 1), cB + hstep + kstep, voffB);
        PG8_WAIT_V(6); PG8_BAR;
    }
    for (;;) {
        const bool has_next = S.next(ui + 1, nxt);
        const char* nA = has_next ? (const char*)g.A + (size_t)nxt.pm * tstep : cA; const char* nB = has_next ? (const char*)g.Bt + (size_t)nxt.pn * tstep : cB;
        for (int t = 0; t < nt; t += 2) {
            const bool last = (t == nt - 2);
            const char* a1 = cA + (size_t)(t + 1) * kstep;
            const char* a2 = last ? nA : cA + (size_t)(t + 2) * kstep; const char* b2 = last ? nB : cB + (size_t)(t + 2) * kstep;
            const char* a3 = a2 + kstep; const char* b3 = b2 + kstep;
            if (last && has_next) S.a_ready(nxt);
            if constexpr (SP2) {
            PG8_LDB(B0, 0, 0); PG8_LDB(B1, 0, 1); PG8_SCHED; PG8_LDA(At, 0, 0); PG8_STAGE(PG8_SA(1, 1), a1 + hstep, voffA);
            PG8_WAIT_V(8); PG8_WAIT_L(0); PG8_BAR; PG8_MMA(0, 0, At, B0); PG8_MMA(0, 1, At, B1); PG8_BAR; PG8_SCHED;
            PG8_LDA(At, 0, 1); PG8_STAGE(PG8_SB(0, 0), b2, voffB); PG8_STAGE(PG8_SB(0, 1), b2 + hstep, voffB); PG8_STAGE(PG8_SA(0, 0), a2, voffA);
            PG8_WAIT_V(8); PG8_WAIT_L(0); PG8_BAR; PG8_MMA(1, 0, At, B0); PG8_MMA(1, 1, At, B1); PG8_BAR; PG8_SCHED;
            PG8_LDB(B0, 1, 0); PG8_LDB(B1, 1, 1); PG8_SCHED; PG8_LDA(At, 1, 0); PG8_STAGE(PG8_SA(0, 1), a2 + hstep, voffA);
            PG8_WAIT_V(8); PG8_WAIT_L(0); PG8_BAR; PG8_MMA(0, 0, At, B0); PG8_MMA(0, 1, At, B1); PG8_BAR; PG8_SCHED;
            PG8_LDA(At, 1, 1); PG8_STAGE(PG8_SB(1, 0), b3, voffB); PG8_STAGE(PG8_SB(1, 1), b3 + hstep, voffB); PG8_STAGE(PG8_SA(1, 0), a3, voffA);
            PG8_WAIT_V(8); PG8_WAIT_L(0); PG8_BAR; PG8_MMA(1, 0, At, B0); PG8_MMA(1, 1, At, B1); PG8_BAR; PG8_SCHED;
            } else {
            PG8_LDB(B0, 0, 0); PG8_SCHED; PG8_LDA(At, 0, 0); PG8_STAGE(PG8_SA(1, 1), a1 + hstep, voffA);
            PG8_WAIT_L(8); PG8_BAR; PG8_WAIT_L(0); PG8_MMA(0, 0, At, B0); PG8_BAR; PG8_SCHED;
            PG8_LDB(B1, 0, 1); PG8_STAGE(PG8_SB(0, 0), b2, voffB);
            PG8_BAR; PG8_WAIT_L(0); PG8_MMA(0, 1, At, B1); PG8_BAR;
            PG8_LDA(At, 0, 1); PG8_STAGE(PG8_SA(0, 0), a2, voffA);
            PG8_BAR; PG8_WAIT_L(0); PG8_MMA(1, 0, At, B0); PG8_BAR; PG8_SCHED;
            PG8_STAGE(PG8_SB(0, 1), b2 + hstep, voffB);
            PG8_WAIT_V(6); PG8_BAR; PG8_MMA(1, 1, At, B1); PG8_BAR;
            PG8_LDB(B0, 1, 0); PG8_SCHED; PG8_LDA(At, 1, 0); PG8_STAGE(PG8_SA(0, 1), a2 + hstep, voffA);
            PG8_WAIT_L(8); PG8_BAR; PG8_WAIT_L(0); PG8_MMA(0, 0, At, B0); PG8_BAR; PG8_SCHED;
            PG8_LDB(B1, 1, 1); PG8_STAGE(PG8_SB(1, 0), b3, voffB);
            PG8_BAR; PG8_WAIT_L(0); PG8_MMA(0, 1, At, B1); PG8_BAR;
            PG8_LDA(At, 1, 1); PG8_STAGE(PG8_SA(1, 0), a3, voffA);
            PG8_BAR; PG8_WAIT_L(0); PG8_MMA(1, 0, At, B0); PG8_BAR; PG8_SCHED;
            PG8_STAGE(PG8_SB(1, 1), b3 + hstep, voffB);
            PG8_WAIT_V(6); PG8_BAR; PG8_MMA(1, 1, At, B1); PG8_BAR;
            }
        }
        if constexpr (ALIGN_EPI) { if (wr == 0) PG8_BAR; }
        if constexpr (!Epi::AFTER_DRAIN) { E(acc, cur, wr, wc, fr, fq); S.done(cur); }
        if (!has_next) break;
#pragma unroll
        for (int a = 0; a < 2; ++a)
#pragma unroll
            for (int b = 0; b < 2; ++b)
#pragma unroll
                for (int m = 0; m < 4; ++m)
#pragma unroll
                    for (int n = 0; n < 2; ++n) acc[a][b][m][n] = (f32x4){0.f, 0.f, 0.f, 0.f};
        cur = nxt; cA = nA; cB = nB; ++ui;
        if constexpr (ALIGN_EPI) { if (wr == 1) PG8_BAR; }
    }
    PG8_WAIT_V(0);
    if constexpr (!ALIGN_EPI) { if (wr == 0) PG8_BAR; }
    PG8_BAR;
    if constexpr (Epi::AFTER_DRAIN) { E.fused(acc, cur, wr, wc, fr, fq, lds, wid, lane); S.done(cur); }
#undef PG8_SA
#undef PG8_SB
#undef PG8_STAGE
#undef PG8_LDA
#undef PG8_LDB
#undef PG8_MMA
#undef PG8_WAIT_V
#undef PG8_WAIT_L
#undef PG8_BAR
#undef PG8_SCHED
}
}

template <class EW> struct EpiAdapt { static constexpr bool PERM = false, AFTER_DRAIN = false; EW e;
    __device__ __forceinline__ void operator()(const f32x4 (&acc)[2][2][4][2], const pg8::Unit& u, int wr, int wc, int fr, int fq) const {
#pragma unroll
        for (int ai = 0; ai < 2; ++ai)
#pragma unroll
            for (int m = 0; m < 4; ++m) { const int row = u.pm * 256 + ai * 128 + wr * 64 + m * 16 + fr;
#pragma unroll
                for (int bj = 0; bj < 2; ++bj)
#pragma unroll
                    for (int n = 0; n < 2; ++n) e(row, u.pn * 256 + bj * 128 + wc * 32 + n * 16 + 4 * fq, acc[ai][bj][m][n]); } } };
template <class EW> struct EpiAdapt8 { static constexpr bool PERM = true, AFTER_DRAIN = false; EW e;
    __device__ __forceinline__ void operator()(const f32x4 (&acc)[2][2][4][2], const pg8::Unit& u, int wr, int wc, int fr, int fq) const {
#pragma unroll
        for (int ai = 0; ai < 2; ++ai)
#pragma unroll
            for (int m = 0; m < 4; ++m) { const int row = u.pm * 256 + ai * 128 + wr * 64 + m * 16 + fr;
#pragma unroll
                for (int bj = 0; bj < 2; ++bj) e(row, u.pn * 256 + bj * 128 + wc * 32 + 8 * fq, acc[ai][bj][m][0], acc[ai][bj][m][1]); } } };
template <class EW>
__device__ __forceinline__ void gemm_fast8(unsigned char* lds, const bf16_t* A, const bf16_t* Bt, int M, int N, int K, const EW& e) {
    pg8::Gemm g{A, Bt, M, N, K}; pg8::StaticOrder S; S.init(M, N, (int)gridDim.x, (int)blockIdx.x);
    EpiAdapt8<EW> E{e};
    pg8::gemm_phase<EpiAdapt8<EW>, pg8::StaticOrder, true, true>((PG8_LAS unsigned char*)lds, g, S, E);
}
template <class EW>
__device__ __forceinline__ void gemm_fast(unsigned char* lds, const bf16_t* A, const bf16_t* Bt, int M, int N, int K, const EW& e) {
    pg8::Gemm g{A, Bt, M, N, K}; pg8::StaticOrder S; S.init(M, N, (int)gridDim.x, (int)blockIdx.x);
    EpiAdapt<EW> E{e};
    pg8::gemm_phase<EpiAdapt<EW>, pg8::StaticOrder, true, true>((PG8_LAS unsigned char*)lds, g, S, E);
}

struct EpiBf16 { bf16_t* O; int ldc;
    __device__ __forceinline__ void operator()(int r, int c, f32x4 v) const { u32x2 w; w.x = pk2(v.x, v.y); w.y = pk2(v.z, v.w); *(u32x2*)(O + (size_t)r * ldc + c) = w; } };
struct EpiBf16Halo { bf16_t* O; bf16_t* H;
    __device__ __forceinline__ void operator()(int r, int c, f32x4 v) const { u32x2 w; w.x = pk2(v.x, v.y); w.y = pk2(v.z, v.w); *(u32x2*)(O + (size_t)r * D + c) = w;
        const int rr = r & 63; if (rr >= 61) *(u32x2*)(H + ((size_t)(r >> 6) * 3 + (rr - 61)) * D + c) = w; } };
struct EpiGate { bf16_t* S0; const float* bias;
    __device__ __forceinline__ void operator()(int r, int c, f32x4 v) const { const f32x4 b = *(const f32x4*)(bias + c); const int s = c >> 10, cc = c & 1023; bf16_t* O = S0 + (size_t)(3 + s + (s > 0 ? 1 : 0)) * (SLOT_BYTES / 2);
        u32x2 w; w.x = pk2(sigmoidf_(v.x + b.x), sigmoidf_(v.y + b.y)); w.y = pk2(sigmoidf_(v.z + b.z), sigmoidf_(v.w + b.w)); *(u32x2*)(O + (size_t)r * D + cc) = w; } };
template <int MODE>
struct EpiMix { const bf16_t* G; float* Mx; bf16_t* O;
    __device__ __forceinline__ void operator()(int r, int c, f32x4 v) const { const size_t off = (size_t)r * D + c; const u32x2 gw = *(const u32x2*)(G + off);
        f32x4 m = (f32x4){bflo(gw.x) * v.x, bfhi(gw.x) * v.y, bflo(gw.y) * v.z, bfhi(gw.y) * v.w};
        if (MODE >= 1) m = m + *(const f32x4*)(Mx + off);
        if (MODE <= 1) *(f32x4*)(Mx + off) = m; else { u32x2 w; w.x = pk2(m.x, m.y); w.y = pk2(m.z, m.w); *(u32x2*)(O + off) = w; } } };
struct EpiResid { const float* base; float* out;
    __device__ __forceinline__ void operator()(int r, int c, f32x4 v) const { const size_t off = (size_t)r * D + c; *(f32x4*)(out + off) = *(const f32x4*)(base + off) + v; } };
struct EpiRelu2 { bf16_t* O; int ldc;
    __device__ __forceinline__ void operator()(int r, int c, f32x4 v) const { f32x4 t = (f32x4){fmaxf(v.x, 0.f), fmaxf(v.y, 0.f), fmaxf(v.z, 0.f), fmaxf(v.w, 0.f)}; t = t * t;
        u32x2 w; w.x = pk2(t.x, t.y); w.y = pk2(t.z, t.w); *(u32x2*)(O + (size_t)r * ldc + c) = w; } };

__device__ __forceinline__ void sb_naive(bf16_t* Q, const bf16_t* Kk, const bf16_t* VT, float* qs, int gw, int NGW, int lane) {
    const float scale = 0.08838834764831845f;
    for (int w = gw; w < 2048; w += NGW) {
        for (int i = 0; i < 128; ++i) {
            const int bh = i >> 1, t = (i & 1) ? (SEQ - 1 - w) : w, b = bh >> 3, h = bh & 7;
            const size_t row = (size_t)b * SEQ + t;
            bf16_t* qrow = Q + row * D + h * 128;
            { const unsigned qw = *(const unsigned*)(qrow + 2 * lane); qs[2 * lane] = bflo(qw) * scale; qs[2 * lane + 1] = bfhi(qw) * scale; }
            LDS_WAIT();
            float acc[128];
#pragma unroll
            for (int d = 0; d < 128; ++d) acc[d] = 0.f;
            float R = 0.f;
            const int nb = (t + 63) >> 6;
            for (int blk = nb - 1; blk >= 0; --blk) {
                const int s = blk * 64 + lane; const bool valid = s < t;
                const bf16_t* krow = Kk + ((size_t)b * SEQ + s) * D + h * 128;
                float z = 0.f;
#pragma unroll
                for (int c = 0; c < 16; ++c) { const u32x4 kw = *(const u32x4*)(krow + 8 * c); const f32x4 q0 = *(const f32x4*)(qs + 8 * c), q1 = *(const f32x4*)(qs + 8 * c + 4);
                    z += bflo(kw.x) * q0.x + bfhi(kw.x) * q0.y + bflo(kw.y) * q0.z + bfhi(kw.y) * q0.w + bflo(kw.z) * q1.x + bfhi(kw.z) * q1.y + bflo(kw.w) * q1.z + bfhi(kw.w) * q1.w; }
                const float e = __expf(-fabsf(z)); const float sp = fmaxf(z, 0.f) + __logf(1.f + e);
                const float lm = valid ? -sp : 0.f, ls = z - sp;
                float incl = lm;
#pragma unroll
                for (int off = 1; off < 64; off <<= 1) { const float tmp = __shfl_down(incl, off); if (lane + off < 64) incl += tmp; }
                const float later = R + incl - lm;
                const float p = valid ? __expf(ls + later) : 0.f;
                R += __shfl(incl, 0);
                const bf16_t* vcol = VT + (size_t)(h * 128) * T + (size_t)b * SEQ + s;
#pragma unroll
                for (int d0 = 0; d0 < 128; d0 += 16) {
#pragma unroll
                    for (int d = d0; d < d0 + 16; ++d) acc[d] += p * bf2f(vcol[(size_t)d * T]);
                    asm volatile("" ::: "memory"); }
            }
            float o0 = 0.f, o1 = 0.f;
#pragma unroll
            for (int d = 0; d < 128; ++d) { const float tot = wave_sum(acc[d]); if ((d & 63) == lane) { if (d < 64) o0 = tot; else o1 = tot; } }
            qrow[lane] = (bf16_t)f2bf(o0); qrow[64 + lane] = (bf16_t)f2bf(o1);
            LDS_WAIT();
        }
    }
}

template <class Epi>
__device__ __forceinline__ void gemm_simple(const bf16_t* A, const bf16_t* Bt, int M, int N, int K, int u0, const Epi& E) {
    const int tid = threadIdx.x, wid = tid >> 6, lane = tid & 63, wr = wid >> 2, wc = wid & 3, fr = lane & 15, fq = lane >> 4;
    const int nN = N / 128, nU = (M / 128) * nN;
    for (int uu = blockIdx.x; uu < u0 + nU; uu += gridDim.x) { if (uu < u0) continue; const int u = uu - u0;
        const int pm = u / nN, pn = u % nN, row0 = pm * 128 + wr * 64, col0 = pn * 128 + wc * 32;
        f32x4 acc[4][2];
#pragma unroll
        for (int m = 0; m < 4; ++m)
#pragma unroll
            for (int n = 0; n < 2; ++n) acc[m][n] = (f32x4){0.f, 0.f, 0.f, 0.f};
        const bf16_t* ap = A + (size_t)(row0 + fr) * K + fq * 8; const bf16_t* bp = Bt + (size_t)(col0 + fr) * K + fq * 8;
#pragma unroll 2
        for (int k0 = 0; k0 < K; k0 += 32) { bf16x8 a[4], b[2];
#pragma unroll
            for (int m = 0; m < 4; ++m) a[m] = *(const bf16x8*)(ap + (size_t)m * 16 * K + k0);
#pragma unroll
            for (int n = 0; n < 2; ++n) b[n] = *(const bf16x8*)(bp + (size_t)n * 16 * K + k0);
#pragma unroll
            for (int m = 0; m < 4; ++m)
#pragma unroll
                for (int n = 0; n < 2; ++n) acc[m][n] = __builtin_amdgcn_mfma_f32_16x16x32_bf16(b[n], a[m], acc[m][n], 0, 0, 0); }
#pragma unroll
        for (int m = 0; m < 4; ++m)
#pragma unroll
            for (int n = 0; n < 2; ++n) E(row0 + m * 16 + fr, col0 + n * 16 + 4 * fq, acc[m][n]); }
}

constexpr size_t SLOT_ELEMS = SLOT_BYTES / 2;
struct EpiSeg4 { bf16_t* S0; bf16_t* HQ;
    __device__ __forceinline__ void operator()(int r, int c, f32x4 v) const { const int seg = c >> 10, cc = c & 1023; bf16_t* O = S0 + (size_t)(seg + 1 + (seg >= 2 ? 1 : 0)) * SLOT_ELEMS;
        u32x2 w; w.x = pk2(v.x, v.y); w.y = pk2(v.z, v.w); *(u32x2*)(O + (size_t)r * D + cc) = w;
        const int rr = r & 63; if (seg >= 2 && rr >= 61) *(u32x2*)(HQ + (size_t)(seg - 2) * (3 * MiB / 2) + ((size_t)(r >> 6) * 3 + (rr - 61)) * D + cc) = w; }
    __device__ __forceinline__ void operator()(int r, int c, f32x4 v0, f32x4 v1) const { const int seg = c >> 10, cc = c & 1023; bf16_t* O = S0 + (size_t)(seg + 1 + (seg >= 2 ? 1 : 0)) * SLOT_ELEMS; u32x4 w; w.x = pk2(v0.x, v0.y); w.y = pk2(v0.z, v0.w); w.z = pk2(v1.x, v1.y); w.w = pk2(v1.z, v1.w); *(u32x4*)(O + (size_t)r * D + cc) = w;
        const int rr = r & 63; if (seg >= 2 && rr >= 61) *(u32x4*)(HQ + (size_t)(seg - 2) * (3 * MiB / 2) + ((size_t)(r >> 6) * 3 + (rr - 61)) * D + cc) = w; } };
struct EpiVT2 { bf16_t* S0;
    __device__ __forceinline__ void operator()(int r, int c, f32x4 v) const { bf16_t* O = S0 + (size_t)(3 + 3 * (r >> 10)) * SLOT_ELEMS;
        u32x2 w; w.x = pk2(v.x, v.y); w.y = pk2(v.z, v.w); *(u32x2*)(O + (size_t)(r & 1023) * T + c) = w; }
    __device__ __forceinline__ void operator()(int r, int c, f32x4 v0, f32x4 v1) const { bf16_t* O = S0 + (size_t)(3 + 3 * (r >> 10)) * SLOT_ELEMS; u32x4 w; w.x = pk2(v0.x, v0.y); w.y = pk2(v0.z, v0.w); w.z = pk2(v1.x, v1.y); w.w = pk2(v1.z, v1.w); *(u32x4*)(O + (size_t)(r & 1023) * T + c) = w; } };
struct EpiSeg2 { bf16_t* S0;
    __device__ __forceinline__ void operator()(int r, int c, f32x4 v) const { bf16_t* O = S0 + (size_t)(3 - (c >> 10)) * SLOT_ELEMS;
        u32x2 w; w.x = pk2(v.x, v.y); w.y = pk2(v.z, v.w); *(u32x2*)(O + (size_t)r * D + (c & 1023)) = w; }
    __device__ __forceinline__ void operator()(int r, int c, f32x4 v0, f32x4 v1) const { bf16_t* O = S0 + (size_t)(3 - (c >> 10)) * SLOT_ELEMS; u32x4 w; w.x = pk2(v0.x, v0.y); w.y = pk2(v0.z, v0.w); w.z = pk2(v1.x, v1.y); w.w = pk2(v1.z, v1.w); *(u32x4*)(O + (size_t)r * D + (c & 1023)) = w; } };
struct EpiRelu2RS { bf16_t* O; int ldc; const float* ssq;
    __device__ __forceinline__ void operator()(int r, int c, f32x4 v) const { const float rs = rsqrtf(ssq[r] * (1.f / D) + EPS);
        f32x4 t = (f32x4){fmaxf(v.x * rs, 0.f), fmaxf(v.y * rs, 0.f), fmaxf(v.z * rs, 0.f), fmaxf(v.w * rs, 0.f)}; t = t * t;
        u32x2 w; w.x = pk2(t.x, t.y); w.y = pk2(t.z, t.w); *(u32x2*)(O + (size_t)r * ldc + c) = w; }
    __device__ __forceinline__ void operator()(int r, int c, f32x4 v0, f32x4 v1) const { const float rs = rsqrtf(ssq[r] * (1.f / D) + EPS);
        v0 = (f32x4){fmaxf(v0.x * rs, 0.f), fmaxf(v0.y * rs, 0.f), fmaxf(v0.z * rs, 0.f), fmaxf(v0.w * rs, 0.f)}; v0 = v0 * v0; v1 = (f32x4){fmaxf(v1.x * rs, 0.f), fmaxf(v1.y * rs, 0.f), fmaxf(v1.z * rs, 0.f), fmaxf(v1.w * rs, 0.f)}; v1 = v1 * v1; u32x4 w; w.x = pk2(v0.x, v0.y); w.y = pk2(v0.z, v0.w); w.z = pk2(v1.x, v1.y); w.w = pk2(v1.z, v1.w); *(u32x4*)(O + (size_t)r * ldc + c) = w; } };
struct GateMixOrder { pg8::StaticOrder so;
    __device__ __forceinline__ bool next(int i, pg8::Unit& u) const { const int ti = i / 6, r = i - 6 * ti, br = r >> 1; pg8::Unit t; if (!so.next(ti, t)) return false;
        if ((r & 1) == 0) { u.pm = t.pm; u.pn = br * 4 + t.pn; } else { const int slot = 1 + (br == 1 ? 3 : 0) + (br == 2 ? 1 : 0); u.pm = slot * 128 + t.pm; u.pn = 20 + br * 4 + t.pn; }
        return true; }
    __device__ __forceinline__ void a_ready(const pg8::Unit&) const {}
    __device__ __forceinline__ void done(const pg8::Unit&) const {} };
struct EpiGateMix { static constexpr bool PERM = true, AFTER_DRAIN = false; bf16_t* S0; const float* bias; unsigned char* PS;
    __device__ __forceinline__ void operator()(const f32x4 (&acc)[2][2][4][2], const pg8::Unit& u, int wr, int wc, int fr, int fq) const {
        const bool mix = u.pn >= 20; const int q = mix ? u.pn - 20 : u.pn, br = q >> 2, pn = q & 3, pm = u.pm & 127;
        unsigned char* G8 = (unsigned char*)(S0 + (size_t)(br == 2 ? 6 : 5) * SLOT_ELEMS) + (br == 1 ? (size_t)T * D : 0);
        bf16_t* R = S0 + (size_t)3 * SLOT_ELEMS;
        if (!mix) {
#pragma unroll
            for (int bj = 0; bj < 2; ++bj) { const int col = pn * 256 + bj * 128 + wc * 32 + 8 * fq; const f32x4 b0 = *(const f32x4*)(bias + br * 1024 + col), b1 = *(const f32x4*)(bias + br * 1024 + col + 4);
#pragma unroll
                for (int ai = 0; ai < 2; ++ai)
#pragma unroll
                    for (int m = 0; m < 4; ++m) { const int row = pm * 256 + ai * 128 + wr * 64 + m * 16 + fr; const f32x4 v0 = acc[ai][bj][m][0] + b0, v1 = acc[ai][bj][m][1] + b1;
                        u32x2 g8;
                        g8.x = (unsigned)(sigmoidf_(v0.x) * 255.f + 0.5f) | ((unsigned)(sigmoidf_(v0.y) * 255.f + 0.5f) << 8) | ((unsigned)(sigmoidf_(v0.z) * 255.f + 0.5f) << 16) | ((unsigned)(sigmoidf_(v0.w) * 255.f + 0.5f) << 24);
                        g8.y = (unsigned)(sigmoidf_(v1.x) * 255.f + 0.5f) | ((unsigned)(sigmoidf_(v1.y) * 255.f + 0.5f) << 8) | ((unsigned)(sigmoidf_(v1.z) * 255.f + 0.5f) << 16) | ((unsigned)(sigmoidf_(v1.w) * 255.f + 0.5f) << 24);
                        *(u32x2*)(G8 + ((((size_t)(pm * 4 + pn) * 8 + (wr * 4 + wc)) * 8 + ai * 4 + m) * 2 + bj) * 512 + (fq * 16 + fr) * 8) = g8; } }
        } else {
            const float k255 = 1.f / 255.f;
#pragma unroll
            for (int ai = 0; ai < 2; ++ai) { u32x2 gw[4][2]; u32x4 pw[4][2];
#pragma unroll
                for (int m = 0; m < 4; ++m)
#pragma unroll
                    for (int bj = 0; bj < 2; ++bj) { const size_t off = (size_t)(pm * 256 + ai * 128 + wr * 64 + m * 16 + fr) * D + pn * 256 + bj * 128 + wc * 32 + 8 * fq; gw[m][bj] = *(const u32x2*)(G8 + ((((size_t)(pm * 4 + pn) * 8 + (wr * 4 + wc)) * 8 + ai * 4 + m) * 2 + bj) * 512 + (fq * 16 + fr) * 8); if (br >= 1) pw[m][bj] = *(const u32x4*)(PS + ((((size_t)(pm * 4 + pn) * 8 + (wr * 4 + wc)) * 8 + ai * 4 + m) * 2 + bj) * 1024 + (fq * 16 + fr) * 16); }
#pragma unroll
                for (int m = 0; m < 4; ++m)
#pragma unroll
                    for (int bj = 0; bj < 2; ++bj) { const size_t off = (size_t)(pm * 256 + ai * 128 + wr * 64 + m * 16 + fr) * D + pn * 256 + bj * 128 + wc * 32 + 8 * fq; const f32x4 v0 = acc[ai][bj][m][0], v1 = acc[ai][bj][m][1];
                        const unsigned ga = gw[m][bj].x, gb = gw[m][bj].y;
                        f32x4 m0 = (f32x4){(float)(ga & 255u) * k255 * v0.x, (float)((ga >> 8) & 255u) * k255 * v0.y, (float)((ga >> 16) & 255u) * k255 * v0.z, (float)(ga >> 24) * k255 * v0.w};
                        f32x4 m1 = (f32x4){(float)(gb & 255u) * k255 * v1.x, (float)((gb >> 8) & 255u) * k255 * v1.y, (float)((gb >> 16) & 255u) * k255 * v1.z, (float)(gb >> 24) * k255 * v1.w};
                        if (br >= 1) { const u32x4 p = pw[m][bj]; m0.x += bflo(p.x); m0.y += bfhi(p.x); m0.z += bflo(p.y); m0.w += bfhi(p.y); m1.x += bflo(p.z); m1.y += bfhi(p.z); m1.z += bflo(p.w); m1.w += bfhi(p.w); }
                        u32x4 w; w.x = pk2(m0.x, m0.y); w.y = pk2(m0.z, m0.w); w.z = pk2(m1.x, m1.y); w.w = pk2(m1.z, m1.w);
                        if (br < 2) *(u32x4*)(PS + ((((size_t)(pm * 4 + pn) * 8 + (wr * 4 + wc)) * 8 + ai * 4 + m) * 2 + bj) * 1024 + (fq * 16 + fr) * 16) = w; else *(u32x4*)(R + off) = w; } }
        } } };
struct EpiResidSS { static constexpr bool PERM = true, AFTER_DRAIN = false; const float* base; float* out; bf16_t* xb; float* ssq;
    __device__ __forceinline__ void operator()(const f32x4 (&acc)[2][2][4][2], const pg8::Unit& u, int wr, int wc, int fr, int fq) const {
#pragma unroll
        for (int ai = 0; ai < 2; ++ai) { f32x4 pre[4][2][2];
#pragma unroll
            for (int m = 0; m < 4; ++m)
#pragma unroll
                for (int bj = 0; bj < 2; ++bj) { const float* bp = base + (size_t)(u.pm * 256 + ai * 128 + wr * 64 + m * 16 + fr) * D + u.pn * 256 + bj * 128 + wc * 32 + 8 * fq; pre[m][bj][0] = *(const f32x4*)bp; pre[m][bj][1] = *(const f32x4*)(bp + 4); }
#pragma unroll
            for (int m = 0; m < 4; ++m) { const int row = u.pm * 256 + ai * 128 + wr * 64 + m * 16 + fr; float ss = 0.f;
#pragma unroll
                for (int bj = 0; bj < 2; ++bj) { const size_t off = (size_t)row * D + u.pn * 256 + bj * 128 + wc * 32 + 8 * fq;
                    const f32x4 o0 = pre[m][bj][0] + acc[ai][bj][m][0], o1 = pre[m][bj][1] + acc[ai][bj][m][1];
                    u32x4 w; w.x = pk2(o0.x, o0.y); w.y = pk2(o0.z, o0.w); w.z = pk2(o1.x, o1.y); w.w = pk2(o1.z, o1.w); *(u32x4*)(xb + off) = w;
                    ss += ((o0.x * o0.x + o0.y * o0.y) + (o0.z * o0.z + o0.w * o0.w)) + ((o1.x * o1.x + o1.y * o1.y) + (o1.z * o1.z + o1.w * o1.w)); }
                ss += __shfl_xor(ss, 16); ss += __shfl_xor(ss, 32);
                if (fq == 0) atomicAdd(ssq + row, ss); } } } };
struct EpiResidIn { static constexpr bool PERM = true, AFTER_DRAIN = false; const bf16_t* xb; float* out;
    __device__ __forceinline__ void operator()(const f32x4 (&acc)[2][2][4][2], const pg8::Unit& u, int wr, int wc, int fr, int fq) const {
#pragma unroll
        for (int ai = 0; ai < 2; ++ai) { u32x4 pre[4][2];
#pragma unroll
            for (int m = 0; m < 4; ++m)
#pragma unroll
                for (int bj = 0; bj < 2; ++bj) pre[m][bj] = *(const u32x4*)(xb + (size_t)(u.pm * 256 + ai * 128 + wr * 64 + m * 16 + fr) * D + u.pn * 256 + bj * 128 + wc * 32 + 8 * fq);
#pragma unroll
            for (int m = 0; m < 4; ++m)
#pragma unroll
                for (int bj = 0; bj < 2; ++bj) { const f32x4 a0 = acc[ai][bj][m][0], a1 = acc[ai][bj][m][1]; const u32x4 p = pre[m][bj];
                    float* op = out + (size_t)(u.pm * 256 + ai * 128 + wr * 64 + m * 16 + fr) * D + u.pn * 256 + bj * 128 + wc * 32 + 8 * fq;
                    *(f32x4*)op = (f32x4){bflo(p.x) + a0.x, bfhi(p.x) + a0.y, bflo(p.y) + a0.z, bfhi(p.y) + a0.w}; *(f32x4*)(op + 4) = (f32x4){bflo(p.z) + a1.x, bfhi(p.z) + a1.y, bflo(p.w) + a1.z, bfhi(p.w) + a1.w}; } } } };

#define LAS __attribute__((address_space(3)))
typedef float f32x16 __attribute__((ext_vector_type(16)));
constexpr int SB_KST = 272, SB_VST = 136, SB_KBYTES = 64 * SB_KST, SB_VBYTES = 128 * SB_VST, SB_BUF = SB_KBYTES + SB_VBYTES;
template <bool DIAG>
__device__ __forceinline__ void sb_subtile(LAS unsigned char* buf, int st, const bf16x8 (&qf)[8], f32x16 (&Y)[4], float& R, int k0, int qi, int r32, int hh) {
    f32x16 X;
#pragma unroll
    for (int r = 0; r < 16; ++r) X[r] = 0.f;
    LAS unsigned char* kp = buf + (32 * st + r32) * SB_KST + hh * 16;
#pragma unroll
    for (int s = 0; s < 8; ++s) { const bf16x8 kf = *(LAS bf16x8*)(kp + s * 32); X = __builtin_amdgcn_mfma_f32_32x32x16_bf16(kf, qf[s], X, 0, 0, 0); }
    float om[16];
#pragma unroll
    for (int r = 0; r < 16; ++r) { const float zz = __builtin_amdgcn_fmed3f(X[r] * (-0.08838834764831845f * 1.4426950408889634f), -80.f, 80.f);
        const float u = __builtin_amdgcn_exp2f(zz); const float be = __builtin_amdgcn_rcpf(1.f + u);
        const int key = k0 + (r & 3) + 8 * (r >> 2) + 4 * hh; const bool valid = !DIAG || key < qi;
        om[r] = valid ? u * be : 1.f; X[r] = valid ? be : 0.f; }
    float g[4], og[4], pr[4];
#pragma unroll
    for (int c = 0; c < 4; ++c) { g[c] = (om[4 * c] * om[4 * c + 1]) * (om[4 * c + 2] * om[4 * c + 3]); og[c] = __shfl_xor(g[c], 32); pr[c] = g[c] * og[c]; }
    float Tc[4]; Tc[3] = 1.f; Tc[2] = pr[3]; Tc[1] = pr[3] * pr[2]; Tc[0] = Tc[1] * pr[1];
    const float total = Tc[0] * pr[0];
#pragma unroll
    for (int c = 0; c < 4; ++c) { float later = R * Tc[c] * (hh == 0 ? og[c] : 1.f);
#pragma unroll
        for (int i = 3; i >= 0; --i) { const int r = 4 * c + i; const float pv = X[r] * later; later *= om[r]; X[r] = pv; } }
    R *= total;
    bf16x8 pf[2];
#pragma unroll
    for (int s2 = 0; s2 < 2; ++s2) { u32x4 w; w.x = pk2(X[8 * s2], X[8 * s2 + 1]); w.y = pk2(X[8 * s2 + 2], X[8 * s2 + 3]); w.z = pk2(X[8 * s2 + 4], X[8 * s2 + 5]); w.w = pk2(X[8 * s2 + 6], X[8 * s2 + 7]); pf[s2] = __builtin_bit_cast(bf16x8, w); }
#pragma unroll
    for (int dt = 0; dt < 4; ++dt) { LAS unsigned char* vp = buf + SB_KBYTES + (32 * dt + r32) * SB_VST + (32 * st + 4 * hh) * 2;
#pragma unroll
        for (int s2 = 0; s2 < 2; ++s2) { const u32x2 lo = *(LAS u32x2*)(vp + s2 * 32), hi = *(LAS u32x2*)(vp + s2 * 32 + 16);
            u32x4 w; w.x = lo.x; w.y = lo.y; w.z = hi.x; w.w = hi.y;
            Y[dt] = __builtin_amdgcn_mfma_f32_32x32x16_bf16(__builtin_bit_cast(bf16x8, w), pf[s2], Y[dt], 0, 0, 0); } }
}
__device__ __forceinline__ void sb_tile_full(LAS unsigned char* buf, const bf16x8 (&qf)[8], f32x16 (&Y)[4], float& R, int r32, int hh) {
    f32x16 X1, X0;
#pragma unroll
    for (int r = 0; r < 16; ++r) { X1[r] = 0.f; X0[r] = 0.f; }
    LAS unsigned char* kp = buf + r32 * SB_KST + hh * 16;
#pragma unroll
    for (int s = 0; s < 8; ++s) { const bf16x8 k1 = *(LAS bf16x8*)(kp + 32 * SB_KST + s * 32), k0_ = *(LAS bf16x8*)(kp + s * 32);
        X1 = __builtin_amdgcn_mfma_f32_32x32x16_bf16(k1, qf[s], X1, 0, 0, 0); X0 = __builtin_amdgcn_mfma_f32_32x32x16_bf16(k0_, qf[s], X0, 0, 0, 0); }
    float om1[16], om0[16];
#pragma unroll
    for (int r = 0; r < 16; ++r) { const float z1 = __builtin_amdgcn_fmed3f(X1[r] * (-0.08838834764831845f * 1.4426950408889634f), -80.f, 80.f), z0 = __builtin_amdgcn_fmed3f(X0[r] * (-0.08838834764831845f * 1.4426950408889634f), -80.f, 80.f);
        const float u1 = __builtin_amdgcn_exp2f(z1), u0 = __builtin_amdgcn_exp2f(z0); const float b1 = __builtin_amdgcn_rcpf(1.f + u1), b0 = __builtin_amdgcn_rcpf(1.f + u0);
        om1[r] = u1 * b1; om0[r] = u0 * b0; X1[r] = b1; X0[r] = b0; }
    float g1[4], g0[4], o1[4], o0[4];
#pragma unroll
    for (int c = 0; c < 4; ++c) { g1[c] = (om1[4 * c] * om1[4 * c + 1]) * (om1[4 * c + 2] * om1[4 * c + 3]); g0[c] = (om0[4 * c] * om0[4 * c + 1]) * (om0[4 * c + 2] * om0[4 * c + 3]); }
#pragma unroll
    for (int c = 0; c < 4; ++c) { o1[c] = __shfl_xor(g1[c], 32); o0[c] = __shfl_xor(g0[c], 32); }
    float T1[4], T0[4];
    { const float p3 = g1[3] * o1[3], p2 = g1[2] * o1[2], p1 = g1[1] * o1[1], p0 = g1[0] * o1[0]; T1[3] = R; T1[2] = R * p3; T1[1] = T1[2] * p2; T1[0] = T1[1] * p1; R = T1[0] * p0; }
    { const float p3 = g0[3] * o0[3], p2 = g0[2] * o0[2], p1 = g0[1] * o0[1], p0 = g0[0] * o0[0]; T0[3] = R; T0[2] = R * p3; T0[1] = T0[2] * p2; T0[0] = T0[1] * p1; R = T0[0] * p0; }
#pragma unroll
    for (int c = 0; c < 4; ++c) { float l1 = T1[c] * (hh == 0 ? o1[c] : 1.f), l0 = T0[c] * (hh == 0 ? o0[c] : 1.f);
#pragma unroll
        for (int i = 3; i >= 0; --i) { const int r = 4 * c + i; const float p1 = X1[r] * l1, p0 = X0[r] * l0; l1 *= om1[r]; l0 *= om0[r]; X1[r] = p1; X0[r] = p0; } }
    bf16x8 pf1[2], pf0[2];
#pragma unroll
    for (int s2 = 0; s2 < 2; ++s2) { u32x4 w; w.x = pk2(X1[8 * s2], X1[8 * s2 + 1]); w.y = pk2(X1[8 * s2 + 2], X1[8 * s2 + 3]); w.z = pk2(X1[8 * s2 + 4], X1[8 * s2 + 5]); w.w = pk2(X1[8 * s2 + 6], X1[8 * s2 + 7]); pf1[s2] = __builtin_bit_cast(bf16x8, w);
        w.x = pk2(X0[8 * s2], X0[8 * s2 + 1]); w.y = pk2(X0[8 * s2 + 2], X0[8 * s2 + 3]); w.z = pk2(X0[8 * s2 + 4], X0[8 * s2 + 5]); w.w = pk2(X0[8 * s2 + 6], X0[8 * s2 + 7]); pf0[s2] = __builtin_bit_cast(bf16x8, w); }
    LAS unsigned char* vp0 = buf + SB_KBYTES + r32 * SB_VST + (4 * hh) * 2;
    u32x4 va[8], vb[8];
#pragma unroll
    for (int i = 0; i < 8; ++i) { LAS unsigned char* vp = vp0 + (32 * (i >> 2)) * SB_VST + (i & 3) * 32; const u32x2 lo = *(LAS u32x2*)vp, hi = *(LAS u32x2*)(vp + 16); va[i].x = lo.x; va[i].y = lo.y; va[i].z = hi.x; va[i].w = hi.y; }
#pragma unroll
    for (int i = 0; i < 8; ++i) asm volatile("" : "+v"(va[i]));
#pragma unroll
    for (int i = 0; i < 8; ++i) { LAS unsigned char* vp = vp0 + (32 * (2 + (i >> 2))) * SB_VST + (i & 3) * 32; const u32x2 lo = *(LAS u32x2*)vp, hi = *(LAS u32x2*)(vp + 16); vb[i].x = lo.x; vb[i].y = lo.y; vb[i].z = hi.x; vb[i].w = hi.y; }
    __builtin_amdgcn_sched_barrier(0);
#pragma unroll
    for (int i = 0; i < 8; ++i) { const int q4 = i & 3; Y[i >> 2] = __builtin_amdgcn_mfma_f32_32x32x16_bf16(__builtin_bit_cast(bf16x8, va[i]), (q4 < 2) ? pf0[q4] : pf1[q4 - 2], Y[i >> 2], 0, 0, 0); }
#pragma unroll
    for (int i = 0; i < 8; ++i) asm volatile("" : "+v"(vb[i]));
#pragma unroll
    for (int i = 0; i < 8; ++i) { const int q4 = i & 3; Y[2 + (i >> 2)] = __builtin_amdgcn_mfma_f32_32x32x16_bf16(__builtin_bit_cast(bf16x8, vb[i]), (q4 < 2) ? pf0[q4] : pf1[q4 - 2], Y[2 + (i >> 2)], 0, 0, 0); }
}
__device__ __forceinline__ void sb_fast(bf16_t* Q, const bf16_t* Kk, const bf16_t* VT, LAS unsigned char* lds) {
    int tid_ = threadIdx.x; asm volatile("" : "+v"(tid_));
    const int tid = tid_, lane = tid & 63, wid = tid >> 6, r32 = lane & 31, hh = lane >> 5;
    const int vcu_ = (gridDim.x % 8 == 0) ? (int)((blockIdx.x % 8) * (gridDim.x / 8) + blockIdx.x / 8) : (int)blockIdx.x;
    for (int vw = vcu_; vw < 256; vw += gridDim.x) {
        const int bh = vw >> 2, jj = vw & 3, b = bh >> 3, h = bh & 7;
        const bf16_t* kg = Kk + ((size_t)b * SEQ) * D + h * 128;
        const bf16_t* vg = VT + (size_t)(h * 128) * T + (size_t)b * SEQ;
        for (int ui = 0; ui < 4; ++ui) {
            const int qb = ui == 0 ? 2 * jj : (ui == 1 ? 15 - 2 * jj : (ui == 2 ? 2 * jj + 1 : 14 - 2 * jj));
            const int q0w = qb * 256 + 32 * wid, qi = q0w + r32;
            bf16_t* qrow = Q + ((size_t)b * SEQ + qi) * D + h * 128;
            bf16x8 qf[8];
#pragma unroll
            for (int s = 0; s < 8; ++s) qf[s] = *(const bf16x8*)(qrow + 16 * s + 8 * hh);
            f32x16 Y[4];
#pragma unroll
            for (int dt = 0; dt < 4; ++dt)
#pragma unroll
                for (int r = 0; r < 16; ++r) Y[dt][r] = 0.f;
            float R = 1.f;
            const int ktmax = 4 * qb + 3;
            u32x4 kr[2], vr[2];
#define SB_LOADG(kt) do { _Pragma("unroll") for (int i_ = 0; i_ < 2; ++i_) { const int c_ = tid + 512 * i_; \
                kr[i_] = *(const u32x4*)(kg + (size_t)(64 * (kt) + (c_ >> 4)) * D + (c_ & 15) * 8); \
                vr[i_] = *(const u32x4*)(vg + (size_t)(c_ >> 3) * T + 64 * (kt) + (c_ & 7) * 8); } } while (0)
#define SB_STORES(bufp) do { _Pragma("unroll") for (int i_ = 0; i_ < 2; ++i_) { const int c_ = tid + 512 * i_; \
                *(LAS u32x4*)((bufp) + (c_ >> 4) * SB_KST + (c_ & 15) * 16) = kr[i_]; \
                LAS u32x2* vp_ = (LAS u32x2*)((bufp) + SB_KBYTES + (c_ >> 3) * SB_VST + (c_ & 7) * 16); \
                u32x2 a_; a_.x = vr[i_].x; a_.y = vr[i_].y; u32x2 b_; b_.x = vr[i_].z; b_.y = vr[i_].w; vp_[0] = a_; vp_[1] = b_; } } while (0)
            SB_LOADG(ktmax); SB_STORES(lds);
#pragma unroll
            for (int s_ = 0; s_ < 8; ++s_) asm volatile("" : "+v"(qf[s_]));
            __syncthreads();
            for (int kt = ktmax, it = 0; kt >= 0; --kt, ++it) {
                LAS unsigned char* cur = lds + (it & 1) * SB_BUF; LAS unsigned char* nxt = lds + ((it & 1) ^ 1) * SB_BUF;
                if (kt > 0) SB_LOADG(kt - 1);
                if (64 * kt + 63 < q0w) sb_tile_full(cur, qf, Y, R, r32, hh);
                else {
#pragma unroll
                for (int st = 1; st >= 0; --st) { const int k0 = 64 * kt + 32 * st;
                    if (k0 < q0w + 31) { if (k0 + 31 >= q0w) sb_subtile<true>(cur, st, qf, Y, R, k0, qi, r32, hh); else sb_subtile<false>(cur, st, qf, Y, R, k0, qi, r32, hh); } } }
                if (kt > 0) SB_STORES(nxt);
                __syncthreads();
            }
#undef SB_LOADG
#undef SB_STORES
            { LAS unsigned char* stg = lds + wid * 8704;
#pragma unroll
              for (int dt = 0; dt < 4; ++dt)
#pragma unroll
                  for (int c = 0; c < 4; ++c) { u32x2 w; w.x = pk2(Y[dt][4 * c], Y[dt][4 * c + 1]); w.y = pk2(Y[dt][4 * c + 2], Y[dt][4 * c + 3]); *(LAS u32x2*)(stg + r32 * 272 + (32 * dt + 8 * c + 4 * hh) * 2) = w; }
              LDS_WAIT();
              bf16_t* orow = Q + ((size_t)b * SEQ + q0w) * D + h * 128;
#pragma unroll 1
              for (int i = 0; i < 8; ++i) { const int row = 4 * i + (lane >> 4), ch = lane & 15; const u32x4 v = *(LAS u32x4*)(stg + row * 272 + ch * 16); *(u32x4*)(orow + (size_t)row * D + ch * 8) = v; }
              __syncthreads(); }
        }
    }
}

__device__ __forceinline__ void conv_pass(bf16_t* MQ, bf16_t* MK, const bf16_t* haloQ, const bf16_t* haloK, const float* conv_w, const float* conv_b, int gw, int NGW, int lane) {
    for (int it = gw; it < 2048; it += NGW) {
        const int blk = it >> 2, isk = (it >> 1) & 1, half = it & 1;
        const int ch0 = (half * 64 + lane) * 8;
        bf16_t* base = (isk ? MK : MQ) + (size_t)blk * 64 * D + ch0;
        const float* cw = conv_w + isk * 1024 + ch0;
        float w0[8], w1[8], w2[8], w3[8], cb[8], r0[8], r1[8], r2[8];
#pragma unroll
        for (int e = 0; e < 8; ++e) { w0[e] = cw[e]; w1[e] = cw[2048 + e]; w2[e] = cw[4096 + e]; w3[e] = cw[6144 + e]; cb[e] = conv_b[isk * 1024 + ch0 + e]; r0[e] = 0.f; r1[e] = 0.f; r2[e] = 0.f; }
        if ((blk & 63) != 0) { const bf16_t* hal = (isk ? haloK : haloQ) + (size_t)(blk - 1) * 3 * D + ch0;
            const u32x4 h0 = *(const u32x4*)hal, h1 = *(const u32x4*)(hal + D), h2 = *(const u32x4*)(hal + 2 * D);
#pragma unroll
            for (int e2 = 0; e2 < 4; ++e2) { r0[2 * e2] = bflo(h0[e2]); r0[2 * e2 + 1] = bfhi(h0[e2]); r1[2 * e2] = bflo(h1[e2]); r1[2 * e2 + 1] = bfhi(h1[e2]); r2[2 * e2] = bflo(h2[e2]); r2[2 * e2 + 1] = bfhi(h2[e2]); } }
        const float osc = isk ? 0.0625f : 1.f;
        u32x4 in[4];
#pragma unroll
        for (int i = 0; i < 4; ++i) in[i] = *(const u32x4*)(base + (size_t)i * D);
#pragma unroll 1
        for (int r4 = 0; r4 < 64; r4 += 4) {
            u32x4 nx[4]; const int rn = (r4 + 4 < 64) ? r4 + 4 : r4;
#pragma unroll
            for (int i = 0; i < 4; ++i) nx[i] = *(const u32x4*)(base + (size_t)(rn + i) * D);
#pragma unroll
            for (int i = 0; i < 4; ++i) { float y[8];
#pragma unroll
                for (int e = 0; e < 8; ++e) { const float xv = (e & 1) ? bfhi(in[i][e >> 1]) : bflo(in[i][e >> 1]);
                    const float u = w0[e] * r0[e] + w1[e] * r1[e] + w2[e] * r2[e] + w3[e] * xv + cb[e]; r0[e] = r1[e]; r1[e] = r2[e]; r2[e] = xv; y[e] = u * sigmoidf_(u) * osc; }
                u32x4 o; o.x = pk2(y[0], y[1]); o.y = pk2(y[2], y[3]); o.z = pk2(y[4], y[5]); o.w = pk2(y[6], y[7]); *(u32x4*)(base + (size_t)(r4 + i) * D) = o; }
#pragma unroll
            for (int i = 0; i < 4; ++i) in[i] = nx[i];
        }
    }
}

__device__ __forceinline__ void gate_pass(const float* ifp, float* GA, float* GP, float* GB, int gw, int NGW, int lane) {
    for (int it = gw; it < 2048; it += NGW) { const int bh = it >> 6, c = it & 63, b = bh >> 2, h = bh & 3;
        const size_t trow = (size_t)b * SEQ + 64 * c + lane; const float gi = ifp[trow * 8 + h], gf = ifp[trow * 8 + 4 + h];
        const float lf = -(fmaxf(-gf, 0.f) + __logf(1.f + __expf(-fabsf(gf))));
        float bc = lf;
#pragma unroll
        for (int o = 1; o < 64; o <<= 1) { const float t_ = __shfl_up(bc, o); if (lane >= o) bc += t_; }
        const float a = gi - bc; float pm = a;
#pragma unroll
        for (int o = 1; o < 64; o <<= 1) { const float t_ = __shfl_up(pm, o); if (lane >= o) pm = fmaxf(pm, t_); }
        const size_t o_ = (size_t)bh * SEQ + 64 * c + lane; GA[o_] = a; GP[o_] = pm; GB[o_] = bc; }
}

constexpr int ML_QS = 0, ML_KS = 33792, ML_KST = 67584, ML_VTS = 104448, ML_VWT = 109200, ML_SCB = 113952, ML_CB = 123168, ML_VEC = 140592, ML_RS = 528, ML_TS = 144;
__device__ __forceinline__ void mlstm_fast(const bf16_t* MQ, const bf16_t* MK, const bf16_t* MVT, const float* GA, const float* GP, const float* GB, bf16_t* HUN, LAS unsigned char* lds) {
    int tid_ = threadIdx.x; asm volatile("" : "+v"(tid_));
    const int tid = tid_, lane = tid & 63, w = tid >> 6, fr = lane & 15, fq = lane >> 4;
    LAS float* vA = (LAS float*)(lds + ML_VEC); LAS float* vM = vA + 64; LAS float* vSI = vA + 128; LAS float* vEM = vA + 192; LAS float* vWK = vA + 256; LAS float* vDEC = vA + 320;
    const int tt = w & 3, sp = w >> 2;
    const int vcu_ = (gridDim.x % 8 == 0) ? (int)((blockIdx.x % 8) * (gridDim.x / 8) + blockIdx.x / 8) : (int)blockIdx.x;
    for (int item = vcu_; item < 256; item += gridDim.x) {
        const int bh = item >> 3, vs = item & 7, b = bh >> 2, h = bh & 3;
        const bf16_t* qg = MQ + ((size_t)b * SEQ + (tid >> 5)) * D + h * 256 + (tid & 31) * 8;
        const bf16_t* kg = MK + ((size_t)b * SEQ + (tid >> 5)) * D + h * 256 + (tid & 31) * 8;
        const bf16_t* vg = MVT + (size_t)(h * 256 + vs * 32 + ((tid >> 3) & 31)) * T + (size_t)b * SEQ + (tid & 7) * 8;
        const size_t go = (size_t)bh * SEQ + lane;
        bf16_t* hg = HUN + ((size_t)b * SEQ + 16 * tt + fr) * D + h * 256 + vs * 32 + 16 * sp + 4 * fq;
        for (int i = tid; i < 17424 / 16; i += NTHREADS) *(LAS u32x4*)(lds + ML_CB + i * 16) = (u32x4){0u, 0u, 0u, 0u};
        if (tid < 32) *(LAS unsigned*)(lds + ML_VTS + 32 * ML_TS + 4 * tid) = 0x3F803F80u;
        u32x4 pq[4], pk[4], pv; float ga = 0.f, gp_ = 0.f, gb = 0.f, nga = 0.f, ngp = 0.f, ngb = 0.f;
#define ML_LOAD(c) do { _Pragma("unroll") for (int i_ = 0; i_ < 4; ++i_) { pq[i_] = *(const u32x4*)(qg + (size_t)(64 * (c) + 16 * i_) * D); pk[i_] = *(const u32x4*)(kg + (size_t)(64 * (c) + 16 * i_) * D); } \
            if (tid < 256) pv = *(const u32x4*)(vg + 64 * (c)); if (w == 0) { nga = GA[go + 64 * (c)]; ngp = GP[go + 64 * (c)]; ngb = GB[go + 64 * (c)]; } } while (0)
#define ML_STORE() do { _Pragma("unroll") for (int i_ = 0; i_ < 4; ++i_) { *(LAS u32x4*)(lds + ML_QS + ((tid >> 5) + 16 * i_) * ML_RS + (tid & 31) * 16) = pq[i_]; *(LAS u32x4*)(lds + ML_KS + ((tid >> 5) + 16 * i_) * ML_RS + (tid & 31) * 16) = pk[i_]; } \
            if (tid < 256) *(LAS u32x4*)(lds + ML_VTS + (tid >> 3) * ML_TS + (tid & 7) * 16) = pv; } while (0)
        ML_LOAD(0); ML_STORE(); ga = nga; gp_ = ngp; gb = ngb;
        __syncthreads();
        float m_prev = 0.f;
        f32x4 Cacc[2][3];
#pragma unroll
        for (int u = 0; u < 2; ++u)
#pragma unroll
            for (int v3 = 0; v3 < 3; ++v3) Cacc[u][v3] = (f32x4){0.f, 0.f, 0.f, 0.f};
#pragma unroll 1
        for (int c = 0; c < 64; ++c) {
            if (c < 63) ML_LOAD(c + 1);
#pragma unroll
            for (int i_ = 0; i_ < 4; ++i_) { const u32x4 kv = *(LAS u32x4*)(lds + ML_KS + lane * ML_RS + (4 * w + i_) * 16);
#pragma unroll
                for (int e_ = 0; e_ < 8; ++e_) { const unsigned wd_ = kv[e_ >> 1]; *(LAS bf16_t*)(lds + ML_KST + (32 * w + 8 * i_ + e_) * ML_TS + 2 * lane) = (bf16_t)((e_ & 1) ? (wd_ >> 16) : (wd_ & 0xffffu)); } }
            if (w == 0) {
                const float Mt = fmaxf(m_prev, gp_);
                const float Mend = __shfl(Mt, 63), bend = __shfl(gb, 63);
                vA[lane] = ga; vM[lane] = Mt; vSI[lane] = __expf(m_prev - Mt); vEM[lane] = __expf(-(gb + Mt)); vWK[lane] = __expf(ga - Mend);
                if (lane == 0) vDEC[0] = __expf(m_prev - Mend);
                m_prev = bend + Mend;
            }
            f32x4 S[2]; S[0] = (f32x4){0.f, 0.f, 0.f, 0.f}; S[1] = S[0];
#pragma unroll
            for (int ks = 0; ks < 8; ++ks) { const bf16x8 bq = *(LAS bf16x8*)(lds + ML_QS + (16 * tt + fr) * ML_RS + (32 * ks + 8 * fq) * 2);
                const bf16x8 a0 = *(LAS bf16x8*)(lds + ML_KS + (32 * sp + fr) * ML_RS + (32 * ks + 8 * fq) * 2); const bf16x8 a1 = *(LAS bf16x8*)(lds + ML_KS + (32 * sp + 16 + fr) * ML_RS + (32 * ks + 8 * fq) * 2);
                S[0] = __builtin_amdgcn_mfma_f32_16x16x32_bf16(a0, bq, S[0], 0, 0, 0); S[1] = __builtin_amdgcn_mfma_f32_16x16x32_bf16(a1, bq, S[1], 0, 0, 0); }
            LDS_BARRIER();
            { const float Mt = vM[16 * tt + fr]; const int t = 16 * tt + fr;
#pragma unroll
              for (int u = 0; u < 2; ++u) { const int st = 2 * sp + u; const f32x4 av = *(LAS f32x4*)(vA + 16 * st + 4 * fq); float sc[4];
#pragma unroll
                  for (int j = 0; j < 4; ++j) { const int s_ = 16 * st + 4 * fq + j; sc[j] = (s_ <= t) ? S[u][j] * __expf(av[j] - Mt) : 0.f; }
                  u32x2 o; o.x = pk2(sc[0], sc[1]); o.y = pk2(sc[2], sc[3]); *(LAS u32x2*)(lds + ML_SCB + t * ML_TS + (16 * st + 4 * fq) * 2) = o; }
              const int v_ = tid >> 4, s4 = (tid & 15) * 4; const f32x4 wk = *(LAS f32x4*)(vWK + s4);
              const u32x2 vv = *(LAS u32x2*)(lds + ML_VTS + v_ * ML_TS + s4 * 2);
              u32x2 o; o.x = pk2(bflo(vv.x) * wk.x, bfhi(vv.x) * wk.y); o.y = pk2(bflo(vv.y) * wk.z, bfhi(vv.y) * wk.w); *(LAS u32x2*)(lds + ML_VWT + v_ * ML_TS + s4 * 2) = o;
              if (tid < 16) { u32x2 o2; o2.x = pk2(wk.x, wk.y); o2.y = pk2(wk.z, wk.w); *(LAS u32x2*)(lds + ML_VWT + 32 * ML_TS + s4 * 2) = o2; } }
            LDS_BARRIER();
            { f32x4 a1 = (f32x4){0.f, 0.f, 0.f, 0.f}, a1n = a1, a2 = a1, a2n = a1;
#pragma unroll
              for (int ks = 0; ks < 8; ++ks) { const bf16x8 bq = *(LAS bf16x8*)(lds + ML_QS + (16 * tt + fr) * ML_RS + (32 * ks + 8 * fq) * 2);
                  const bf16x8 ac = *(LAS bf16x8*)(lds + ML_CB + (16 * sp + fr) * ML_RS + (32 * ks + 8 * fq) * 2); const bf16x8 an = *(LAS bf16x8*)(lds + ML_CB + 32 * ML_RS + (32 * ks + 8 * fq) * 2);
                  a1 = __builtin_amdgcn_mfma_f32_16x16x32_bf16(ac, bq, a1, 0, 0, 0); a1n = __builtin_amdgcn_mfma_f32_16x16x32_bf16(an, bq, a1n, 0, 0, 0); }
#pragma unroll
              for (int ks = 0; ks < 2; ++ks) { const bf16x8 bs = *(LAS bf16x8*)(lds + ML_SCB + (16 * tt + fr) * ML_TS + (32 * ks + 8 * fq) * 2);
                  const bf16x8 av = *(LAS bf16x8*)(lds + ML_VTS + (16 * sp + fr) * ML_TS + (32 * ks + 8 * fq) * 2); const bf16x8 an = *(LAS bf16x8*)(lds + ML_VTS + 32 * ML_TS + (32 * ks + 8 * fq) * 2);
                  a2 = __builtin_amdgcn_mfma_f32_16x16x32_bf16(av, bs, a2, 0, 0, 0); a2n = __builtin_amdgcn_mfma_f32_16x16x32_bf16(an, bs, a2n, 0, 0, 0); }
              const float si = vSI[16 * tt + fr], em = vEM[16 * tt + fr];
              const float den = a2n[0] + si * a1n[0]; const float rd = 1.f / fmaxf(fabsf(den), em);
              u32x2 o; o.x = pk2((a2[0] + si * a1[0]) * rd, (a2[1] + si * a1[1]) * rd); o.y = pk2((a2[2] + si * a1[2]) * rd, (a2[3] + si * a1[3]) * rd);
              *(u32x2*)(hg + (size_t)(64 * c) * D) = o; }
            { const float dec = vDEC[0];
#pragma unroll
              for (int u = 0; u < 2; ++u)
#pragma unroll
                  for (int v3 = 0; v3 < 3; ++v3) Cacc[u][v3] = Cacc[u][v3] * dec;
#pragma unroll
              for (int ks = 0; ks < 2; ++ks) { bf16x8 bv[3];
#pragma unroll
                  for (int v3 = 0; v3 < 3; ++v3) { const int vr = (v3 < 2) ? 16 * v3 + fr : 32; bv[v3] = *(LAS bf16x8*)(lds + ML_VWT + vr * ML_TS + (32 * ks + 8 * fq) * 2); }
#pragma unroll
                  for (int u = 0; u < 2; ++u) { const bf16x8 ak = *(LAS bf16x8*)(lds + ML_KST + (16 * (2 * w + u) + fr) * ML_TS + (32 * ks + 8 * fq) * 2);
#pragma unroll
                      for (int v3 = 0; v3 < 3; ++v3) Cacc[u][v3] = __builtin_amdgcn_mfma_f32_16x16x32_bf16(ak, bv[v3], Cacc[u][v3], 0, 0, 0); } } }
            LDS_BARRIER();
#pragma unroll
            for (int u = 0; u < 2; ++u)
#pragma unroll
                for (int v3 = 0; v3 < 3; ++v3) { if (v3 < 2 || fr == 0) { const int vr = (v3 < 2) ? 16 * v3 + fr : 32; const f32x4 cv = Cacc[u][v3];
                    u32x2 o; o.x = pk2(cv.x, cv.y); o.y = pk2(cv.z, cv.w); *(LAS u32x2*)(lds + ML_CB + vr * ML_RS + (16 * (2 * w + u) + 4 * fq) * 2) = o; } }
            if (c < 63) { ML_STORE(); ga = nga; gp_ = ngp; gb = ngb; }
            LDS_BARRIER();
        }
#undef ML_LOAD
#undef ML_STORE
    }
}

__device__ __forceinline__ void memk_norm(bf16_t* MK, const float* gk, const float* gq, int gw, int NGW, int lane) {
    for (int r = gw; r < TMEM * 4; r += NGW) { const int bm = r >> 2, h = r & 3; bf16_t* p = MK + (size_t)bm * D + h * 256 + 4 * lane;
        const u32x2 w = *(const u32x2*)p; f32x4 v = (f32x4){bflo(w.x), bfhi(w.x), bflo(w.y), bfhi(w.y)};
        const float rs = rsqrtf(wave_sum(v.x * v.x + v.y * v.y + v.z * v.z + v.w * v.w) * (1.f / 256.f) + EPS);
        const f32x4 g = *(const f32x4*)(gk + 4 * lane); const f32x4 g2 = *(const f32x4*)(gq + 4 * lane); v = v * rs * g * g2 * 0.0625f;
        u32x2 o; o.x = pk2(v.x, v.y); o.y = pk2(v.z, v.w); *(u32x2*)p = o; }
}
constexpr int CX_RS = 528;
__device__ __forceinline__ void cross_lds(bf16_t* XQ, const bf16_t* MK, const bf16_t* MVT, LAS unsigned char* lds) {
    int tid_ = threadIdx.x; asm volatile("" : "+v"(tid_));
    const int tid = tid_, lane = tid & 63, w = tid >> 6, fr = lane & 15, fq = lane >> 4;
    for (int un = blockIdx.x; un < (T / 128) * 4; un += gridDim.x) {
        const int h = un & 3, t0 = (un >> 2) * 128, b = t0 >> 12;
        { const bf16_t* src = MK + (size_t)(b * NMEM) * D + h * 256 + (size_t)(tid >> 5) * D + (tid & 31) * 8; LAS unsigned char* dst = lds + (tid >> 5) * CX_RS + (tid & 31) * 16;
#pragma unroll 1
          for (int i0 = 0; i0 < 16; i0 += 8) { u32x4 tmp[8];
#pragma unroll
              for (int i = 0; i < 8; ++i) tmp[i] = *(const u32x4*)(src + (size_t)(16 * (i0 + i)) * D);
#pragma unroll
              for (int i = 0; i < 8; ++i) *(LAS u32x4*)(dst + 16 * (i0 + i) * CX_RS) = tmp[i]; } }
        asm volatile("" ::: "memory");
        bf16_t* qrow = XQ + (size_t)(t0 + 16 * w + fr) * D + h * 256;
        bf16x8 qf[8]; float ss = 0.f;
#pragma unroll
        for (int s_ = 0; s_ < 8; ++s_) { const u32x4 wq = *(const u32x4*)(qrow + 32 * s_ + 8 * fq); qf[s_] = __builtin_bit_cast(bf16x8, wq);
            ss += bflo(wq.x) * bflo(wq.x) + bfhi(wq.x) * bfhi(wq.x) + bflo(wq.y) * bflo(wq.y) + bfhi(wq.y) * bfhi(wq.y) + bflo(wq.z) * bflo(wq.z) + bfhi(wq.z) * bfhi(wq.z) + bflo(wq.w) * bflo(wq.w) + bfhi(wq.w) * bfhi(wq.w); }
        ss += __shfl_xor(ss, 16); ss += __shfl_xor(ss, 32);
        const float rs = rsqrtf(ss * (1.f / 256.f) + EPS);
        __syncthreads();
        f32x4 X[16];
#pragma unroll
        for (int kt = 0; kt < 16; ++kt) { X[kt] = (f32x4){0.f, 0.f, 0.f, 0.f};
#pragma unroll
            for (int s_ = 0; s_ < 8; ++s_) { const bf16x8 kf = *(LAS bf16x8*)(lds + (16 * kt + fr) * CX_RS + (32 * s_ + 8 * fq) * 2); X[kt] = __builtin_amdgcn_mfma_f32_16x16x32_bf16(kf, qf[s_], X[kt], 0, 0, 0); }
            asm volatile("" : "+v"(X[kt]) : : "memory"); }
        __syncthreads();
        asm volatile("" ::: "memory");
        { const bf16_t* src = MVT + (size_t)(h * 256) * TMEM + b * NMEM + (size_t)(tid >> 5) * TMEM + (tid & 31) * 8; LAS unsigned char* dst = lds + (tid >> 5) * CX_RS + (tid & 31) * 16;
#pragma unroll 1
          for (int i0 = 0; i0 < 16; i0 += 8) { u32x4 tmp[8];
#pragma unroll
              for (int i = 0; i < 8; ++i) tmp[i] = *(const u32x4*)(src + (size_t)(16 * (i0 + i)) * TMEM);
#pragma unroll
              for (int i = 0; i < 8; ++i) *(LAS u32x4*)(dst + 16 * (i0 + i) * CX_RS) = tmp[i]; } }
        asm volatile("" ::: "memory");
        float mx = -3.0e38f;
#pragma unroll
        for (int kt = 0; kt < 16; ++kt) { X[kt] = X[kt] * rs; mx = fmaxf(mx, fmaxf(fmaxf(X[kt].x, X[kt].y), fmaxf(X[kt].z, X[kt].w))); }
        mx = fmaxf(mx, __shfl_xor(mx, 16)); mx = fmaxf(mx, __shfl_xor(mx, 32));
        float sum = 0.f;
#pragma unroll
        for (int kt = 0; kt < 16; ++kt) { X[kt].x = __expf(X[kt].x - mx); X[kt].y = __expf(X[kt].y - mx); X[kt].z = __expf(X[kt].z - mx); X[kt].w = __expf(X[kt].w - mx); sum += (X[kt].x + X[kt].y) + (X[kt].z + X[kt].w); }
        sum += __shfl_xor(sum, 16); sum += __shfl_xor(sum, 32);
        const float inv = 1.f / sum;
        bf16x8 pf[8];
#pragma unroll
        for (int kp = 0; kp < 8; ++kp) { u32x4 wp; wp.x = pk2(X[2 * kp].x, X[2 * kp].y); wp.y = pk2(X[2 * kp].z, X[2 * kp].w); wp.z = pk2(X[2 * kp + 1].x, X[2 * kp + 1].y); wp.w = pk2(X[2 * kp + 1].z, X[2 * kp + 1].w); pf[kp] = __builtin_bit_cast(bf16x8, wp); }
        __syncthreads();
#pragma unroll 2
        for (int dt = 0; dt < 16; ++dt) { f32x4 Y = (f32x4){0.f, 0.f, 0.f, 0.f};
#pragma unroll
            for (int kp = 0; kp < 8; ++kp) { LAS unsigned char* vp = lds + (16 * dt + fr) * CX_RS + (32 * kp + 4 * fq) * 2; const u32x2 lo = *(LAS u32x2*)vp, hi = *(LAS u32x2*)(vp + 32);
                u32x4 wv; wv.x = lo.x; wv.y = lo.y; wv.z = hi.x; wv.w = hi.y; Y = __builtin_amdgcn_mfma_f32_16x16x32_bf16(__builtin_bit_cast(bf16x8, wv), pf[kp], Y, 0, 0, 0); }
            Y = Y * inv; u32x2 o; o.x = pk2(Y.x, Y.y); o.y = pk2(Y.z, Y.w); *(u32x2*)(qrow + 16 * dt + 4 * fq) = o; }
        __syncthreads();
    }
}
__device__ __forceinline__ void ml_finalize(const bf16_t* HUN, const bf16_t* MO, const float* g, bf16_t* Y, int gw, int NGW, int lane) {
    const f32x4 g0 = *(const f32x4*)(g + 4 * lane), g1 = *(const f32x4*)(g + 256 + 4 * lane), g2 = *(const f32x4*)(g + 512 + 4 * lane), g3 = *(const f32x4*)(g + 768 + 4 * lane);
    u32x2 hw[4], ow[4];
#pragma unroll
    for (int i = 0; i < 4; ++i) { const size_t off = (size_t)gw * D + i * 256 + 4 * lane; hw[i] = *(const u32x2*)(HUN + off); ow[i] = *(const u32x2*)(MO + off); }
    for (int t = gw; t < T; t += NGW) {
        const int tn = (t + NGW < T) ? t + NGW : t; u32x2 nh[4], no[4];
#pragma unroll
        for (int i = 0; i < 4; ++i) { const size_t off = (size_t)tn * D + i * 256 + 4 * lane; nh[i] = *(const u32x2*)(HUN + off); no[i] = *(const u32x2*)(MO + off); }
        float ssv[4]; f32x4 v[4];
#pragma unroll
        for (int i = 0; i < 4; ++i) { v[i] = (f32x4){bflo(hw[i].x), bfhi(hw[i].x), bflo(hw[i].y), bfhi(hw[i].y)}; ssv[i] = (v[i].x * v[i].x + v[i].y * v[i].y) + (v[i].z * v[i].z + v[i].w * v[i].w); }
#pragma unroll
        for (int o = 1; o < 64; o <<= 1) {
#pragma unroll
            for (int i = 0; i < 4; ++i) ssv[i] += __shfl_xor(ssv[i], o); }
#pragma unroll
        for (int i = 0; i < 4; ++i) { const size_t off = (size_t)t * D + i * 256 + 4 * lane; const float rs = rsqrtf(ssv[i] * (1.f / 256.f) + EPS);
            const f32x4 gg = i == 0 ? g0 : (i == 1 ? g1 : (i == 2 ? g2 : g3));
            f32x4 r = v[i] * rs * gg; r.x *= sigmoidf_(bflo(ow[i].x)); r.y *= sigmoidf_(bfhi(ow[i].x)); r.z *= sigmoidf_(bflo(ow[i].y)); r.w *= sigmoidf_(bfhi(ow[i].y));
            u32x2 o; o.x = pk2(r.x, r.y); o.y = pk2(r.z, r.w); *(u32x2*)(Y + off) = o; }
#pragma unroll
        for (int i = 0; i < 4; ++i) { hw[i] = nh[i]; ow[i] = no[i]; }
    }
}

__global__ void __launch_bounds__(NTHREADS) fwd_megakernel(Params p) {
    extern __shared__ __attribute__((aligned(16))) unsigned char lds[];
    cg::grid_group grid = cg::this_grid();
#define LANE() ({ int l_ = threadIdx.x & 63; asm volatile("" : "+v"(l_)); l_; })
    int tid0_ = threadIdx.x; asm volatile("" : "+v"(tid0_));
    const int tid = tid0_, wave = __builtin_amdgcn_readfirstlane(threadIdx.x >> 6);
    const int gw = blockIdx.x * NWAVES + wave, NGW = gridDim.x * NWAVES;
    unsigned char* ws = p.ws; unsigned char* dob = (unsigned char*)p.out;
    const float* x = p.in[0]; const float* mem = p.in[1]; const float* g_mix = p.in[2]; const float* w_in = p.in[3]; const float* b_if = p.in[4]; const float* b_gate = p.in[5];
    const float* conv_w = p.in[6]; const float* conv_b = p.in[7]; const float* ml_norm_g = p.in[8]; const float* g_mem = p.in[9]; const float* w_mem_kv = p.in[10];
    const float* q_norm_g = p.in[11]; const float* k_norm_g = p.in[12]; const float* w_sb = p.in[13]; const float* w_ml = p.in[14]; const float* w_x = p.in[15]; const float* w_out = p.in[16];
    const float* g_mlp = p.in[17]; const float* w_ff1 = p.in[18]; const float* w_ff2 = p.in[19];
    bf16_t* Wt_in = (bf16_t*)(ws + WS_WIN); bf16_t* Wt_mkv = (bf16_t*)(ws + WS_WMKV); bf16_t* Wt_sb = (bf16_t*)(ws + WS_WSB); bf16_t* Wt_ml = (bf16_t*)(ws + WS_WML);
    bf16_t* Wt_x = (bf16_t*)(ws + WS_WX); bf16_t* Wt_out = (bf16_t*)(ws + WS_WOUT); bf16_t* Wt_ff1 = (bf16_t*)(ws + WS_WFF1); bf16_t* Wt_ff2 = (bf16_t*)(ws + WS_WFF2);
    float* ifp = (float*)(ws + WS_IF);
#define SLOT(i) ((bf16_t*)(ws + WS_SLOT0 + (size_t)(i) * SLOT_BYTES))
    bf16_t* memn = (bf16_t*)(dob + DO_MEMN); bf16_t* memk = (bf16_t*)(dob + DO_MEMK); bf16_t* memvt = (bf16_t*)(dob + DO_MEMVT); bf16_t* hun = (bf16_t*)(dob + DO_HUN);

    unsigned long long probe_t0 = 0, probe_dur = 0;
    PROBE_BEGIN(3);
    float* wscr = (float*)(lds + wave * 8448);
    float* wif = (float*)(lds + 69632);
    float* ssq = (float*)(ws + WS_SSQ);
    for (int i = tid; i < 8192; i += NTHREADS) { const int e = i >> 10, k = i & 1023; wif[i] = w_in[(size_t)k * NIN + IF_COL + e]; }
    for (int i = blockIdx.x * NTHREADS + tid; i < T; i += gridDim.x * NTHREADS) ssq[i] = 0.f;
    __syncthreads();
    transpose_matrix(w_in, NIN, D, 2048, Wt_in, wscr, gw, NGW, LANE());
    transpose_matrix(w_in + 3072, NIN, D, 2048, Wt_in + (size_t)2048 * D, wscr, gw, NGW, LANE());
    transpose_matrix(w_in + 2048, NIN, D, 1024, Wt_in + (size_t)4096 * D, wscr, gw, NGW, LANE());
    transpose_matrix(w_in + 5120, NIN, D, 2048, Wt_in + (size_t)5120 * D, wscr, gw, NGW, LANE());
    transpose_matrix(w_in + 7176, NIN, D, 4096, Wt_in + (size_t)7168 * D, wscr, gw, NGW, LANE());
    transpose_matrix(w_mem_kv, 2048, D, 2048, Wt_mkv, wscr, gw, NGW, LANE());
    transpose_matrix(w_sb, D, D, D, Wt_sb, wscr, gw, NGW, LANE());
    transpose_matrix(w_ml, D, D, D, Wt_ml, wscr, gw, NGW, LANE());
    transpose_matrix(w_x, D, D, D, Wt_x, wscr, gw, NGW, LANE());
    transpose_matrix(w_out, D, D, D, Wt_out, wscr, gw, NGW, LANE());
    transpose_matrix(w_ff1, FF, D, FF, Wt_ff1, wscr, gw, NGW, LANE(), g_mlp);
    transpose_matrix(w_ff2, D, FF, D, Wt_ff2, wscr, gw, NGW, LANE());
    { const int lane = LANE(); f32x4 cur[4];
#pragma unroll
      for (int j = 0; j < 4; ++j) cur[j] = ((const f32x4*)(x + (size_t)gw * D) + lane)[64 * j];
      for (int m = gw; m < T; m += NGW) { f32x4 nxt[4]; const int mn = (m + NGW < T) ? m + NGW : m;
#pragma unroll
          for (int j = 0; j < 4; ++j) nxt[j] = ((const f32x4*)(x + (size_t)mn * D) + lane)[64 * j];
          rms_row_regs(cur, g_mix, SLOT(0) + (size_t)m * D, wif, b_if, ifp + (size_t)m * 8, lane);
#pragma unroll
          for (int j = 0; j < 4; ++j) cur[j] = nxt[j]; } }
    for (int m = gw; m < TMEM; m += NGW) rms_row<false>(mem + (size_t)m * D, g_mem, memn + (size_t)m * D, nullptr, nullptr, nullptr, LANE());
    PROBE_END(3);
    grid.sync();

    PROBE_BEGIN(7);
    { const bf16_t* hN = SLOT(0);
      gemm_fast8(lds, hN, Wt_in, T, 4096, D, EpiSeg4{SLOT(0), (bf16_t*)(ws + WS_HALOQ)});
      gemm_fast8(lds, Wt_in + (size_t)4096 * D, hN, 2048, T, D, EpiVT2{SLOT(0)});
      gemm_simple(memn, Wt_mkv, TMEM, 1024, D, 0, EpiBf16{memk, D});
      gemm_simple(Wt_mkv + (size_t)1024 * D, memn, 1024, TMEM, D, 128, EpiBf16{memvt, TMEM}); }
    PROBE_END(7);
    grid.sync();

    PROBE_BEGIN(4);
    memk_norm(memk, k_norm_g, q_norm_g, gw, NGW, LANE());
    conv_pass(SLOT(4), SLOT(5), (const bf16_t*)(ws + WS_HALOQ), (const bf16_t*)(ws + WS_HALOK), conv_w, conv_b, gw, NGW, LANE());
    PROBE_END(4);
    PROBE_BEGIN(1);
    gate_pass(ifp, (float*)(ws + WS_GATE), (float*)(ws + WS_GATE) + 32 * SEQ, (float*)(ws + WS_GATE) + 64 * SEQ, gw, NGW, LANE());
    sb_fast(SLOT(1), SLOT(2), SLOT(3), (LAS unsigned char*)lds);
    PROBE_END(1);
    grid.sync();

    PROBE_BEGIN(2);
    mlstm_fast(SLOT(4), SLOT(5), SLOT(6), (const float*)(ws + WS_GATE), (const float*)(ws + WS_GATE) + 32 * SEQ, (const float*)(ws + WS_GATE) + 64 * SEQ, hun, (LAS unsigned char*)lds);
    PROBE_END(2);
    __syncthreads();
    PROBE_BEGIN(8);
    gemm_fast8(lds, SLOT(0), Wt_in + (size_t)6144 * D, T, 2048, D, EpiSeg2{SLOT(0)});
    PROBE_END(8);
    grid.sync();

    PROBE_BEGIN(5);
    cross_lds(SLOT(2), memk, memvt, (LAS unsigned char*)lds);
    PROBE_END(5);
    PROBE_BEGIN(6);
    ml_finalize(hun, SLOT(3), ml_norm_g, SLOT(4), gw, NGW, LANE());
    PROBE_END(6);
    grid.sync();

    PROBE_BEGIN(9);
    { pg8::Gemm g{SLOT(0), Wt_in + (size_t)8192 * D, T, D, D}; GateMixOrder S; S.so.init(T, D, (int)gridDim.x, (int)blockIdx.x); EpiGateMix E{SLOT(0), b_gate, (unsigned char*)p.out};
      pg8::gemm_phase<EpiGateMix, GateMixOrder, true, true>((PG8_LAS unsigned char*)lds, g, S, E); }
    PROBE_END(9);
    grid.sync();

    PROBE_BEGIN(11);
    { pg8::Gemm g{SLOT(3), Wt_out, T, D, D}; pg8::StaticOrder S; S.init(T, D, (int)gridDim.x, (int)blockIdx.x); EpiResidSS E{x, p.out, SLOT(1), ssq};
      pg8::gemm_phase<EpiResidSS, pg8::StaticOrder, true, true>((PG8_LAS unsigned char*)lds, g, S, E); }
    PROBE_END(11);
    grid.sync();

    PROBE_BEGIN(12);
    gemm_fast8(lds, SLOT(1), Wt_ff1, T, FF, D, EpiRelu2RS{SLOT(2), FF, ssq});
    PROBE_END(12);
    grid.sync();

    PROBE_BEGIN(13);
    { pg8::Gemm g{SLOT(2), Wt_ff2, T, D, FF}; pg8::StaticOrder S; S.init(T, D, (int)gridDim.x, (int)blockIdx.x); EpiResidIn E{SLOT(1), p.out};
      pg8::gemm_phase<EpiResidIn, pg8::StaticOrder, true, true>((PG8_LAS unsigned char*)lds, g, S, E); }
    PROBE_END(13);
    if (PROBE_PHASE != 0) { const unsigned long long te = __builtin_amdgcn_s_memrealtime(); while (__builtin_amdgcn_s_memrealtime() - te < probe_dur) __builtin_amdgcn_s_sleep(8); }
}

extern "C" void kernel_launch(void* const* d_in, const int* in_sizes, int n_in, void* d_out, int out_size, void* d_ws, size_t ws_size, hipStream_t stream) {
    static int grid_blocks = 0;
    if (grid_blocks == 0) {
        if (n_in != 20 || out_size != T * D || ws_size < WS_NEED) { fprintf(stderr, "kernel_launch: unexpected shapes (n_in %d out %d ws %zu)\n", n_in, out_size, ws_size); grid_blocks = -1; return; }
        int dev = 0, cus = 0, per_cu = 0;
        hipGetDevice(&dev);
        hipDeviceGetAttribute(&cus, hipDeviceAttributeMultiprocessorCount, dev);
        hipFuncSetAttribute((const void*)fwd_megakernel, hipFuncAttributeMaxDynamicSharedMemorySize, LDS_BYTES);
        hipOccupancyMaxActiveBlocksPerMultiprocessor(&per_cu, (const void*)fwd_megakernel, NTHREADS, LDS_BYTES);
        if (per_cu < 1) per_cu = 1;
        grid_blocks = cus * per_cu;
    }
    if (grid_blocks < 0) return;
    Params p{};
    for (int i = 0; i < 20; ++i) p.in[i] = (const float*)d_in[i];
    p.out = (float*)d_out; p.ws = (unsigned char*)d_ws;
    void* args[] = {&p};
    hipError_t e = hipLaunchCooperativeKernel((const void*)fwd_megakernel, dim3(grid_blocks), dim3(NTHREADS), args, LDS_BYTES, stream);
    if (e != hipSuccess) fprintf(stderr, "cooperative launch failed: %s (grid %d)\n", hipGetErrorString(e), grid_blocks);
}
```

```cpp
#include <hip/hip_runtime.h>
#include <hip/hip_cooperative_groups.h>
#include <cstdint>
#include <cstdio>
namespace cg = cooperative_groups;

typedef unsigned short bf16_t;
typedef short bf16x8 __attribute__((ext_vector_type(8)));
typedef float f32x4 __attribute__((ext_vector_type(4)));
typedef unsigned u32x2 __attribute__((ext_vector_type(2)));
typedef unsigned u32x4 __attribute__((ext_vector_type(4)));

constexpr int D = 1024, BATCH = 8, SEQ = 4096, T = BATCH * SEQ, NMEM = 256, TMEM = BATCH * NMEM, FF = 4096;
constexpr int NIN = 11272;
constexpr int IF_COL = 7168;
constexpr float EPS = 1e-6f;
constexpr int NTHREADS = 512, NWAVES = 8;
constexpr int LDS_BYTES = 144 * 1024;
#ifndef PROBE_PHASE
#define PROBE_PHASE 0
#endif
#define PROBE_BEGIN(k) do { if (PROBE_PHASE & (1 << (k))) probe_t0 = __builtin_amdgcn_s_memrealtime(); } while (0)
#define PROBE_END(k) do { if (PROBE_PHASE & (1 << (k))) probe_dur += __builtin_amdgcn_s_memrealtime() - probe_t0; } while (0)

constexpr size_t MiB = (size_t)1 << 20;
constexpr size_t WS_WIN = 0;
constexpr size_t WS_WMKV = 22 * MiB;
constexpr size_t WS_WSB = 26 * MiB, WS_WML = 28 * MiB, WS_WX = 30 * MiB, WS_WOUT = 32 * MiB;
constexpr size_t WS_WFF1 = 34 * MiB;
constexpr size_t WS_WFF2 = 42 * MiB;
constexpr size_t WS_IF = 50 * MiB;
constexpr size_t WS_GATE = 58 * MiB;
constexpr size_t WS_SSQ = 57 * MiB;
constexpr size_t WS_HALOQ = 51 * MiB, WS_HALOK = 54 * MiB;
constexpr size_t WS_SLOT0 = 64 * MiB, SLOT_BYTES = 64 * MiB;
constexpr size_t WS_NEED = WS_SLOT0 + 7 * SLOT_BYTES;
constexpr size_t DO_MEMN = 0;
constexpr size_t DO_MEMK = 4 * MiB;
constexpr size_t DO_MEMVT = 8 * MiB;
constexpr size_t DO_HUN = 64 * MiB;

struct Params { const float* in[20]; float* out; unsigned char* ws; };

__device__ __forceinline__ unsigned f2bf(float f) { unsigned u = __builtin_bit_cast(unsigned, f); return (u + 0x7fffu + ((u >> 16) & 1u)) >> 16; }
typedef float f32x2_t __attribute__((ext_vector_type(2))); typedef __bf16 bf16x2_t __attribute__((ext_vector_type(2)));
__device__ __forceinline__ unsigned pk2(float lo, float hi) { f32x2_t v = {lo, hi}; bf16x2_t b = __builtin_convertvector(v, bf16x2_t); return __builtin_bit_cast(unsigned, b); }
__device__ __forceinline__ float bf2f(bf16_t v) { return __builtin_bit_cast(float, (unsigned)v << 16); }
__device__ __forceinline__ float bflo(unsigned w) { return __builtin_bit_cast(float, w << 16); }
__device__ __forceinline__ float bfhi(unsigned w) { return __builtin_bit_cast(float, w & 0xffff0000u); }
__device__ __forceinline__ float row16_sum(float v) {
    v += __builtin_bit_cast(float, __builtin_amdgcn_update_dpp(0, __builtin_bit_cast(int, v), 0xB1, 0xF, 0xF, true));
    v += __builtin_bit_cast(float, __builtin_amdgcn_update_dpp(0, __builtin_bit_cast(int, v), 0x4E, 0xF, 0xF, true));
    v += __builtin_bit_cast(float, __builtin_amdgcn_update_dpp(0, __builtin_bit_cast(int, v), 0x141, 0xF, 0xF, true));
    v += __builtin_bit_cast(float, __builtin_amdgcn_update_dpp(0, __builtin_bit_cast(int, v), 0x140, 0xF, 0xF, true));
    return v;
}
__device__ __forceinline__ float wave_sum(float v) { v = row16_sum(v); v += __shfl_xor(v, 16); v += __shfl_xor(v, 32); return v; }
__device__ __forceinline__ float wave_max(float v) {
#pragma unroll
    for (int o = 1; o < 64; o <<= 1) v = fmaxf(v, __shfl_xor(v, o));
    return v;
}
__device__ __forceinline__ float sigmoidf_(float x) { return __builtin_amdgcn_rcpf(1.f + __builtin_amdgcn_exp2f(x * -1.4426950408889634f)); }
#define LDS_WAIT() asm volatile("s_waitcnt lgkmcnt(0)" ::: "memory")
#define LDS_BARRIER() do { asm volatile("s_waitcnt lgkmcnt(0)" ::: "memory"); __builtin_amdgcn_s_barrier(); asm volatile("" ::: "memory"); } while (0)

__device__ __forceinline__ void transpose_item(const float* W, int ldw, int K, bf16_t* WT, int k0, int n0, float* scr, int lane, const float* kscale) {
#pragma unroll 8
    for (int i = 0; i < 32; ++i) { const int kk = 2 * i + (lane >> 5); float v = W[(size_t)(k0 + kk) * ldw + n0 + (lane & 31)]; if (kscale) v *= kscale[k0 + kk]; scr[kk * 33 + (lane & 31)] = v; }
    LDS_WAIT();
    const int c = lane & 7;
#pragma unroll
    for (int j = 0; j < 4; ++j) { const int n = (lane >> 3) + 8 * j; const float* s = scr + (8 * c) * 33 + n;
        u32x4 o; o.x = pk2(s[0 * 33], s[1 * 33]); o.y = pk2(s[2 * 33], s[3 * 33]); o.z = pk2(s[4 * 33], s[5 * 33]); o.w = pk2(s[6 * 33], s[7 * 33]);
        *(u32x4*)(WT + (size_t)(n0 + n) * K + k0 + 8 * c) = o; }
    LDS_WAIT();
}
__device__ __forceinline__ void transpose_matrix(const float* W, int ldw, int K, int N, bf16_t* WT, float* scr, int gw, int NGW, int lane, const float* kscale = nullptr) {
    const int nblk = N / 32, items = (K / 64) * nblk;
    for (int it = gw; it < items; it += NGW) { const int kb = it / nblk, nb = it % nblk; transpose_item(W, ldw, K, WT, 64 * kb, 32 * nb, scr, lane, kscale); }
}

template <bool WITH_IF>
__device__ __forceinline__ void rms_row(const float* xrow, const float* g, bf16_t* orow, const float* wif  , const float* b_if, float* ifout, int lane) {
    const f32x4* xr = (const f32x4*)xrow + lane; const f32x4* gr = (const f32x4*)g + lane;
    f32x4 v[4]; float s = 0.f;
#pragma unroll
    for (int j = 0; j < 4; ++j) { v[j] = xr[64 * j]; s += (v[j].x * v[j].x + v[j].y * v[j].y) + (v[j].z * v[j].z + v[j].w * v[j].w); }
    const float r = rsqrtf(wave_sum(s) * (1.f / D) + EPS);
#pragma unroll
    for (int j = 0; j < 4; ++j) v[j] = v[j] * r * gr[64 * j];
    u32x2* o8 = (u32x2*)orow + lane;
#pragma unroll
    for (int j = 0; j < 4; ++j) { u32x2 w; w.x = pk2(v[j].x, v[j].y); w.y = pk2(v[j].z, v[j].w); o8[64 * j] = w; }
    if (WITH_IF) {
        float a[8];
#pragma unroll
        for (int e = 0; e < 8; ++e) { a[e] = 0.f;
#pragma unroll
            for (int j = 0; j < 4; ++j) { const f32x4 w = *(const f32x4*)(wif + e * 1024 + 256 * j + 4 * lane); a[e] += (v[j].x * w.x + v[j].y * w.y) + (v[j].z * w.z + v[j].w * w.w); }
            a[e] = wave_sum(a[e]); }
        if (lane == 0) {
#pragma unroll
            for (int e = 0; e < 8; ++e) ifout[e] = a[e] + b_if[e]; }
    }
}

__device__ __forceinline__ void rms_row_regs(const f32x4 (&vin)[4], const f32x4 (&gv)[4], bf16_t* orow, const float* wif  , const float (&bif)[8], float* ifout, int lane) {
    f32x4 v[4]; float s = 0.f;
#pragma unroll
    for (int j = 0; j < 4; ++j) { v[j] = vin[j]; s += (v[j].x * v[j].x + v[j].y * v[j].y) + (v[j].z * v[j].z + v[j].w * v[j].w); }
    const float r = rsqrtf(wave_sum(s) * (1.f / D) + EPS);
#pragma unroll
    for (int j = 0; j < 4; ++j) v[j] = v[j] * r * gv[j];
    u32x2* o8 = (u32x2*)orow + lane;
#pragma unroll
    for (int j = 0; j < 4; ++j) { u32x2 w; w.x = pk2(v[j].x, v[j].y); w.y = pk2(v[j].z, v[j].w); o8[64 * j] = w; }
    float a[8];
#pragma unroll
    for (int e = 0; e < 8; ++e) { a[e] = 0.f;
#pragma unroll
        for (int j = 0; j < 4; ++j) { const f32x4 w = *(const f32x4*)(wif + e * 1024 + 256 * j + 4 * lane); a[e] += (v[j].x * w.x + v[j].y * w.y) + (v[j].z * w.z + v[j].w * w.w); } }
#pragma unroll
    for (int e = 0; e < 8; ++e) a[e] = row16_sum(a[e]);
#pragma unroll
    for (int e = 0; e < 8; ++e) a[e] += __shfl_xor(a[e], 16);
#pragma unroll
    for (int e = 0; e < 8; ++e) a[e] += __shfl_xor(a[e], 32);
    if (lane == 0) { f32x4 o0 = (f32x4){a[0] + bif[0], a[1] + bif[1], a[2] + bif[2], a[3] + bif[3]}, o1 = (f32x4){a[4] + bif[4], a[5] + bif[5], a[6] + bif[6], a[7] + bif[7]}; *(f32x4*)ifout = o0; *(f32x4*)(ifout + 4) = o1; }
}

namespace pg8 {
#define PG8_LAS __attribute__((address_space(3)))
typedef unsigned short bf16_t;
typedef short bf16x8 __attribute__((ext_vector_type(8)));
typedef float f32x4 __attribute__((ext_vector_type(4)));
typedef unsigned u32x4 __attribute__((ext_vector_type(4)));
constexpr int BM = 256, BK = 64, HALF = 128, HTB = HALF * BK * 2  , STAGE_BYTES = 8 * HTB, NXCD = 8, WGM = 8;

__host__ __device__ __forceinline__ int lds_byte(int r, int c) { const int st = (r >> 4) * 2 + (c >> 5), rr = r & 15, cc = c & 31, ob = rr * 64 + cc * 2; return st * 1024 + (ob ^ (((ob >> 9) & 1) << 5)); }
__host__ __device__ __forceinline__ void stage_rc(int b, int& R, int& C) { const int st = b / 1024, sb = b % 1024, swz = sb ^ (((sb >> 9) & 1) << 5); R = (st >> 1) * 16 + swz / 64; C = (st & 1) * 32 + (swz % 64) / 2; }
__host__ __device__ __forceinline__ int perm32(int rho) { const int n = rho >> 4, i = rho & 15; return 8 * (i >> 2) + 4 * n + (i & 3); }

struct Unit { int pm, pn; };
struct Gemm { const bf16_t* A; const bf16_t* Bt; int M, N, K; };

struct StaticOrder {
    int nM, nN, nwg, G, c;
    __host__ __device__ void init(int M, int N, int G_, int c_) { nM = M / BM; nN = N / BM; nwg = nM * nN; G = G_; c = c_; }
    __host__ __device__ bool next(int i, Unit& u) const {
        const long L = (long)i * G + c; if (L >= nwg) return false;
        int wgid = (int)L; { const int q = nwg / NXCD, r = nwg % NXCD, xcd = wgid % NXCD, off = wgid / NXCD; wgid = (xcd < r ? xcd * (q + 1) : r * (q + 1) + (xcd - r) * q) + off; }
        const int nig = WGM * nN, gid = wgid / nig, fm = gid * WGM, gsz = (nM - fm) < WGM ? (nM - fm) : WGM;
        u.pm = fm + ((wgid % nig) % gsz); u.pn = (wgid % nig) / gsz; return true;
    }
    __device__ __forceinline__ void a_ready(const Unit&) const {}
    __device__ __forceinline__ void done(const Unit&) const {}
};
template <class Epi, class Sched, bool ALIGN_EPI = false, bool SP2 = false>
__device__ __forceinline__ void gemm_phase(PG8_LAS unsigned char* lds, const Gemm g, const Sched& S, const Epi& E) {
    int tid_ = threadIdx.x; asm volatile("" : "+v"(tid_));
    const int tid = tid_, wid = __builtin_amdgcn_readfirstlane(tid >> 6), lane = tid & 63, wr = wid >> 2, wc = wid & 3, fr = lane & 15, fq = lane >> 4;
    const int K = g.K, nt = K / BK;
    unsigned voffA[2], voffB[2];
#pragma unroll
    for (int i = 0; i < 2; ++i) { int R, C; stage_rc(tid * 16 + i * 8192, R, C); const int Rb = Epi::PERM ? ((R & ~31) + perm32(R & 31)) : R;
        voffA[i] = (unsigned)(R * K + C) * 2u; voffB[i] = (unsigned)(Rb * K + C) * 2u; }
    const size_t kstep = (size_t)(BK * 2);
    const size_t hstep = (size_t)HALF * K * 2;
    const size_t tstep = 2 * hstep;
    const unsigned ldsw = (unsigned)wid * 1024u;
    const int aoff = lds_byte(wr * 64 + fr, fq * 8), boff = lds_byte(wc * 32 + fr, fq * 8);
#define PG8_SA(b, h) (((b) * 2 + (h)) * HTB)
#define PG8_SB(b, h) ((4 + (b) * 2 + (h)) * HTB)
#define PG8_STAGE(bufoff, gbase, voff) do { _Pragma("unroll") for (int _i = 0; _i < 2; ++_i) \
        __builtin_amdgcn_global_load_lds((const unsigned*)((const char*)(gbase) + (voff)[_i]), (PG8_LAS unsigned*)(lds + (bufoff) + ldsw + _i * 8192), 16, 0, 0); } while (0)
#define PG8_LDA(dst, b, h) do { _Pragma("unroll") for (int m = 0; m < 4; ++m) _Pragma("unroll") for (int k = 0; k < 2; ++k) dst[m][k] = *(const PG8_LAS bf16x8*)(lds + PG8_SA(b, h) + aoff + m * 2048 + k * 1024); } while (0)
#define PG8_LDB(dst, b, h) do { _Pragma("unroll") for (int n = 0; n < 2; ++n) _Pragma("unroll") for (int k = 0; k < 2; ++k) dst[n][k] = *(const PG8_LAS bf16x8*)(lds + PG8_SB(b, h) + boff + n * 2048 + k * 1024); } while (0)
#define PG8_MMA(ai, bj, At, Bt) do { __builtin_amdgcn_s_setprio(1); _Pragma("unroll") for (int m = 0; m < 4; ++m) _Pragma("unroll") for (int n = 0; n < 2; ++n) _Pragma("unroll") for (int k = 0; k < 2; ++k) \
        acc[ai][bj][m][n] = __builtin_amdgcn_mfma_f32_16x16x32_bf16(Bt[n][k], At[m][k], acc[ai][bj][m][n], 0, 0, 0); __builtin_amdgcn_s_setprio(0); } while (0)
#define PG8_WAIT_V(n) asm volatile("s_waitcnt vmcnt(" #n ")" ::: "memory")
#define PG8_WAIT_L(n) asm volatile("s_waitcnt lgkmcnt(" #n ")" ::: "memory")
#define PG8_BAR __builtin_amdgcn_s_barrier()
#define PG8_SCHED __builtin_amdgcn_sched_barrier(0)
    Unit cur, nxt; int ui = 0;
    if (!S.next(0, cur)) return;
    f32x4 acc[2][2][4][2];
#pragma unroll
    for (int a = 0; a < 2; ++a)
#pragma unroll
        for (int b = 0; b < 2; ++b)
#pragma unroll
            for (int m = 0; m < 4; ++m)
#pragma unroll
                for (int n = 0; n < 2; ++n) acc[a][b][m][n] = (f32x4){0.f, 0.f, 0.f, 0.f};
    bf16x8 At[4][2], B0[2][2], B1[2][2];
    const char* cA = (const char*)g.A + (size_t)cur.pm * tstep; const char* cB = (const char*)g.Bt + (size_t)cur.pn * tstep;
    S.a_ready(cur);
    if constexpr (SP2) {
        PG8_STAGE(PG8_SB(0, 0), cB, voffB); PG8_STAGE(PG8_SB(0, 1), cB + hstep, voffB); PG8_STAGE(PG8_SA(0, 0), cA, voffA); PG8_STAGE(PG8_SA(0, 1), cA + hstep, voffA);
        if (wr == 1) PG8_BAR;
        PG8_WAIT_V(2); PG8_BAR;
        PG8_STAGE(PG8_SB(1, 0), cB + kstep, voffB); PG8_STAGE(PG8_SA(1, 0), cA + kstep, voffA); PG8_STAGE(PG8_SB(1, 1), cB + hstep + kstep, voffB);
        PG8_WAIT_V(6); PG8_BAR;
    } else {
        PG8_STAGE(PG8_SB(0, 0), cB, voffB); PG8_STAGE(PG8_SA(0, 0), cA, voffA); PG8_STAGE(PG8_SB(0, 1), cB + hstep, voffB); PG8_STAGE(PG8_SA(0, 1), cA + hstep, voffA);
        if (wr == 1) PG8_BAR;
        PG8_WAIT_V(4); PG8_BAR;
        PG8_STAGE(PG8_SB(1, 0), cB + kstep, voffB); PG8_STAGE(PG8_SA(1, 0), cA + kstep, voffA); PG8_STAGE(PG8_SB(1, 1), cB + hstep + kstep, voffB);
        PG8_WAIT_V(6); PG8_BAR;
    }
    for (;;) {
        const bool has_next = S.next(ui + 1, nxt);
        const char* nA = has_next ? (const char*)g.A + (size_t)nxt.pm * tstep : cA; const char* nB = has_next ? (const char*)g.Bt + (size_t)nxt.pn * tstep : cB;
        for (int t = 0; t < nt; t += 2) {
            const bool last = (t == nt - 2);
            const char* a1 = cA + (size_t)(t + 1) * kstep;
            const char* a2 = last ? nA : cA + (size_t)(t + 2) * kstep; const char* b2 = last ? nB : cB + (size_t)(t + 2) * kstep;
            const char* a3 = a2 + kstep; const char* b3 = b2 + kstep;
            if (last && has_next) S.a_ready(nxt);
            if constexpr (SP2) {
            PG8_LDB(B0, 0, 0); PG8_LDB(B1, 0, 1); PG8_SCHED; PG8_LDA(At, 0, 0); PG8_STAGE(PG8_SA(1, 1), a1 + hstep, voffA);
            PG8_WAIT_V(8); PG8_WAIT_L(0); PG8_BAR; PG8_MMA(0, 0, At, B0); PG8_MMA(0, 1, At, B1); PG8_BAR; PG8_SCHED;
            PG8_LDA(At, 0, 1); PG8_STAGE(PG8_SB(0, 0), b2, voffB); PG8_STAGE(PG8_SB(0, 1), b2 + hstep, voffB); PG8_STAGE(PG8_SA(0, 0), a2, voffA);
            PG8_WAIT_V(8); PG8_WAIT_L(0); PG8_BAR; PG8_MMA(1, 0, At, B0); PG8_MMA(1, 1, At, B1); PG8_BAR; PG8_SCHED;
            PG8_LDB(B0, 1, 0); PG8_LDB(B1, 1, 1); PG8_SCHED; PG8_LDA(At, 1, 0); PG8_STAGE(PG8_SA(0, 1), a2 + hstep, voffA);
            PG8_WAIT_V(8); PG8_WAIT_L(0); PG8_BAR; PG8_MMA(0, 0, At, B0); PG8_MMA(0, 1, At, B1); PG8_BAR; PG8_SCHED;
            PG8_LDA(At, 1, 1); PG8_STAGE(PG8_SB(1, 0), b3, voffB); PG8_STAGE(PG8_SB(1, 1), b3 + hstep, voffB); PG8_STAGE(PG8_SA(1, 0), a3, voffA);
            PG8_WAIT_V(8); PG8_WAIT_L(0); PG8_BAR; PG8_MMA(1, 0, At, B0); PG8_MMA(1, 1, At, B1); PG8_BAR; PG8_SCHED;
            } else {
            PG8_LDB(B0, 0, 0); PG8_SCHED; PG8_LDA(At, 0, 0); PG8_STAGE(PG8_SA(1, 1), a1 + hstep, voffA);
            PG8_WAIT_L(8); PG8_BAR; PG8_WAIT_L(0); PG8_MMA(0, 0, At, B0); PG8_BAR; PG8_SCHED;
            PG8_LDB(B1, 0, 1); PG8_STAGE(PG8_SB(0, 0), b2, voffB);
            PG8_BAR; PG8_WAIT_L(0); PG8_MMA(0, 1, At, B1); PG8_BAR;
            PG8_LDA(At, 0, 1); PG8_STAGE(PG8_SA(0, 0), a2, voffA);
            PG8_BAR; PG8_WAIT_L(0); PG8_MMA(1, 0, At, B0); PG8_BAR; PG8_SCHED;
            PG8_STAGE(PG8_SB(0, 1), b2 + hstep, voffB);
            PG8_WAIT_V(6); PG8_BAR; PG8_MMA(1, 1, At, B1); PG8_BAR;
            PG8_LDB(B0, 1, 0); PG8_SCHED; PG8_LDA(At, 1, 0); PG8_STAGE(PG8_SA(0, 1), a2 + hstep, voffA);
            PG8_WAIT_L(8); PG8_BAR; PG8_WAIT_L(0); PG8_MMA(0, 0, At, B0); PG8_BAR; PG8_SCHED;
            PG8_LDB(B1, 1, 1); PG8_STAGE(PG8_SB(1, 0), b3, voffB);
            PG8_BAR; PG8_WAIT_L(0); PG8_MMA(0, 1, At, B1); PG8_BAR;
            PG8_LDA(At, 1, 1); PG8_STAGE(PG8_SA(1, 0), a3, voffA);
            PG8_BAR; PG8_WAIT_L(0); PG8_MMA(1, 0, At, B0); PG8_BAR; PG8_SCHED;
            PG8_STAGE(PG8_SB(1, 1), b3 + hstep, voffB);
            PG8_WAIT_V(6); PG8_BAR; PG8_MMA(1, 1, At, B1); PG8_BAR;
            }
        }
        if constexpr (ALIGN_EPI) { if (wr == 0) PG8_BAR; }
        if constexpr (!Epi::AFTER_DRAIN) { E(acc, cur, wr, wc, fr, fq); S.done(cur); }
        if (!has_next) break;
#pragma unroll
        for (int a = 0; a < 2; ++a)
#pragma unroll
            for (int b = 0; b < 2; ++b)
#pragma unroll
                for (int m = 0; m < 4; ++m)
#pragma unroll
                    for (int n = 0; n < 2; ++n) acc[a][b][m][n] = (f32x4){0.f, 0.f, 0.f, 0.f};
        cur = nxt; cA = nA; cB = nB; ++ui;
        if constexpr (ALIGN_EPI) { if (wr == 1) PG8_BAR; }
    }
    PG8_WAIT_V(0);
    if constexpr (!ALIGN_EPI) { if (wr == 0) PG8_BAR; }
    PG8_BAR;
    if constexpr (Epi::AFTER_DRAIN) { E.fused(acc, cur, wr, wc, fr, fq, lds, wid, lane); S.done(cur); }
#undef PG8_SA
#undef PG8_SB
#undef PG8_STAGE
#undef PG8_LDA
#undef PG8_LDB
#undef PG8_MMA
#undef PG8_WAIT_V
#undef PG8_WAIT_L
#undef PG8_BAR
#undef PG8_SCHED
}
}

template <class EW> struct EpiAdapt { static constexpr bool PERM = false, AFTER_DRAIN = false; EW e;
    __device__ __forceinline__ void operator()(const f32x4 (&acc)[2][2][4][2], const pg8::Unit& u, int wr, int wc, int fr, int fq) const {
#pragma unroll
        for (int ai = 0; ai < 2; ++ai)
#pragma unroll
            for (int m = 0; m < 4; ++m) { const int row = u.pm * 256 + ai * 128 + wr * 64 + m * 16 + fr;
#pragma unroll
                for (int bj = 0; bj < 2; ++bj)
#pragma unroll
                    for (int n = 0; n < 2; ++n) e(row, u.pn * 256 + bj * 128 + wc * 32 + n * 16 + 4 * fq, acc[ai][bj][m][n]); } } };
template <class EW> struct EpiAdapt8 { static constexpr bool PERM = true, AFTER_DRAIN = false; EW e;
    __device__ __forceinline__ void operator()(const f32x4 (&acc)[2][2][4][2], const pg8::Unit& u, int wr, int wc, int fr, int fq) const {
#pragma unroll
        for (int ai = 0; ai < 2; ++ai)
#pragma unroll
            for (int m = 0; m < 4; ++m) { const int row = u.pm * 256 + ai * 128 + wr * 64 + m * 16 + fr;
#pragma unroll
                for (int bj = 0; bj < 2; ++bj) e(row, u.pn * 256 + bj * 128 + wc * 32 + 8 * fq, acc[ai][bj][m][0], acc[ai][bj][m][1]); } } };
template <class EW>
__device__ __forceinline__ void gemm_fast8(unsigned char* lds, const bf16_t* A, const bf16_t* Bt, int M, int N, int K, const EW& e) {
    pg8::Gemm g{A, Bt, M, N, K}; pg8::StaticOrder S; S.init(M, N, (int)gridDim.x, (int)blockIdx.x);
    EpiAdapt8<EW> E{e};
    pg8::gemm_phase<EpiAdapt8<EW>, pg8::StaticOrder, true, true>((PG8_LAS unsigned char*)lds, g, S, E);
}
template <class EW>
__device__ __forceinline__ void gemm_fast(unsigned char* lds, const bf16_t* A, const bf16_t* Bt, int M, int N, int K, const EW& e) {
    pg8::Gemm g{A, Bt, M, N, K}; pg8::StaticOrder S; S.init(M, N, (int)gridDim.x, (int)blockIdx.x);
    EpiAdapt<EW> E{e};
    pg8::gemm_phase<EpiAdapt<EW>, pg8::StaticOrder, true, true>((PG8_LAS unsigned char*)lds, g, S, E);
}

struct EpiBf16 { bf16_t* O; int ldc;
    __device__ __forceinline__ void operator()(int r, int c, f32x4 v) const { u32x2 w; w.x = pk2(v.x, v.y); w.y = pk2(v.z, v.w); *(u32x2*)(O + (size_t)r * ldc + c) = w; } };
struct EpiBf16Halo { bf16_t* O; bf16_t* H;
    __device__ __forceinline__ void operator()(int r, int c, f32x4 v) const { u32x2 w; w.x = pk2(v.x, v.y); w.y = pk2(v.z, v.w); *(u32x2*)(O + (size_t)r * D + c) = w;
        const int rr = r & 63; if (rr >= 61) *(u32x2*)(H + ((size_t)(r >> 6) * 3 + (rr - 61)) * D + c) = w; } };
struct EpiGate { bf16_t* S0; const float* bias;
    __device__ __forceinline__ void operator()(int r, int c, f32x4 v) const { const f32x4 b = *(const f32x4*)(bias + c); const int s = c >> 10, cc = c & 1023; bf16_t* O = S0 + (size_t)(3 + s + (s > 0 ? 1 : 0)) * (SLOT_BYTES / 2);
        u32x2 w; w.x = pk2(sigmoidf_(v.x + b.x), sigmoidf_(v.y + b.y)); w.y = pk2(sigmoidf_(v.z + b.z), sigmoidf_(v.w + b.w)); *(u32x2*)(O + (size_t)r * D + cc) = w; } };
template <int MODE>
struct EpiMix { const bf16_t* G; float* Mx; bf16_t* O;
    __device__ __forceinline__ void operator()(int r, int c, f32x4 v) const { const size_t off = (size_t)r * D + c; const u32x2 gw = *(const u32x2*)(G + off);
        f32x4 m = (f32x4){bflo(gw.x) * v.x, bfhi(gw.x) * v.y, bflo(gw.y) * v.z, bfhi(gw.y) * v.w};
        if (MODE >= 1) m = m + *(const f32x4*)(Mx + off);
        if (MODE <= 1) *(f32x4*)(Mx + off) = m; else { u32x2 w; w.x = pk2(m.x, m.y); w.y = pk2(m.z, m.w); *(u32x2*)(O + off) = w; } } };
struct EpiResid { const float* base; float* out;
    __device__ __forceinline__ void operator()(int r, int c, f32x4 v) const { const size_t off = (size_t)r * D + c; *(f32x4*)(out + off) = *(const f32x4*)(base + off) + v; } };
struct EpiRelu2 { bf16_t* O; int ldc;
    __device__ __forceinline__ void operator()(int r, int c, f32x4 v) const { f32x4 t = (f32x4){fmaxf(v.x, 0.f), fmaxf(v.y, 0.f), fmaxf(v.z, 0.f), fmaxf(v.w, 0.f)}; t = t * t;
        u32x2 w; w.x = pk2(t.x, t.y); w.y = pk2(t.z, t.w); *(u32x2*)(O + (size_t)r * ldc + c) = w; } };

__device__ __forceinline__ void sb_naive(bf16_t* Q, const bf16_t* Kk, const bf16_t* VT, float* qs, int gw, int NGW, int lane) {
    const float scale = 0.08838834764831845f;
    for (int w = gw; w < 2048; w += NGW) {
        for (int i = 0; i < 128; ++i) {
            const int bh = i >> 1, t = (i & 1) ? (SEQ - 1 - w) : w, b = bh >> 3, h = bh & 7;
            const size_t row = (size_t)b * SEQ + t;
            bf16_t* qrow = Q + row * D + h * 128;
            { const unsigned qw = *(const unsigned*)(qrow + 2 * lane); qs[2 * lane] = bflo(qw) * scale; qs[2 * lane + 1] = bfhi(qw) * scale; }
            LDS_WAIT();
            float acc[128];
#pragma unroll
            for (int d = 0; d < 128; ++d) acc[d] = 0.f;
            float R = 0.f;
            const int nb = (t + 63) >> 6;
            for (int blk = nb - 1; blk >= 0; --blk) {
                const int s = blk * 64 + lane; const bool valid = s < t;
                const bf16_t* krow = Kk + ((size_t)b * SEQ + s) * D + h * 128;
                float z = 0.f;
#pragma unroll
                for (int c = 0; c < 16; ++c) { const u32x4 kw = *(const u32x4*)(krow + 8 * c); const f32x4 q0 = *(const f32x4*)(qs + 8 * c), q1 = *(const f32x4*)(qs + 8 * c + 4);
                    z += bflo(kw.x) * q0.x + bfhi(kw.x) * q0.y + bflo(kw.y) * q0.z + bfhi(kw.y) * q0.w + bflo(kw.z) * q1.x + bfhi(kw.z) * q1.y + bflo(kw.w) * q1.z + bfhi(kw.w) * q1.w; }
                const float e = __expf(-fabsf(z)); const float sp = fmaxf(z, 0.f) + __logf(1.f + e);
                const float lm = valid ? -sp : 0.f, ls = z - sp;
                float incl = lm;
#pragma unroll
                for (int off = 1; off < 64; off <<= 1) { const float tmp = __shfl_down(incl, off); if (lane + off < 64) incl += tmp; }
                const float later = R + incl - lm;
                const float p = valid ? __expf(ls + later) : 0.f;
                R += __shfl(incl, 0);
                const bf16_t* vcol = VT + (size_t)(h * 128) * T + (size_t)b * SEQ + s;
#pragma unroll
                for (int d0 = 0; d0 < 128; d0 += 16) {
#pragma unroll
                    for (int d = d0; d < d0 + 16; ++d) acc[d] += p * bf2f(vcol[(size_t)d * T]);
                    asm volatile("" ::: "memory"); }
            }
            float o0 = 0.f, o1 = 0.f;
#pragma unroll
            for (int d = 0; d < 128; ++d) { const float tot = wave_sum(acc[d]); if ((d & 63) == lane) { if (d < 64) o0 = tot; else o1 = tot; } }
            qrow[lane] = (bf16_t)f2bf(o0); qrow[64 + lane] = (bf16_t)f2bf(o1);
            LDS_WAIT();
        }
    }
}

template <class Epi>
__device__ __forceinline__ void gemm_simple(const bf16_t* A, const bf16_t* Bt, int M, int N, int K, int u0, const Epi& E) {
    const int tid = threadIdx.x, wid = tid >> 6, lane = tid & 63, wr = wid >> 2, wc = wid & 3, fr = lane & 15, fq = lane >> 4;
    const int nN = N / 128, nU = (M / 128) * nN;
    for (int uu = blockIdx.x; uu < u0 + nU; uu += gridDim.x) { if (uu < u0) continue; const int u = uu - u0;
        const int pm = u / nN, pn = u % nN, row0 = pm * 128 + wr * 64, col0 = pn * 128 + wc * 32;
        f32x4 acc[4][2];
#pragma unroll
        for (int m = 0; m < 4; ++m)
#pragma unroll
            for (int n = 0; n < 2; ++n) acc[m][n] = (f32x4){0.f, 0.f, 0.f, 0.f};
        const bf16_t* ap = A + (size_t)(row0 + fr) * K + fq * 8; const bf16_t* bp = Bt + (size_t)(col0 + fr) * K + fq * 8;
#pragma unroll 2
        for (int k0 = 0; k0 < K; k0 += 32) { bf16x8 a[4], b[2];
#pragma unroll
            for (int m = 0; m < 4; ++m) a[m] = *(const bf16x8*)(ap + (size_t)m * 16 * K + k0);
#pragma unroll
            for (int n = 0; n < 2; ++n) b[n] = *(const bf16x8*)(bp + (size_t)n * 16 * K + k0);
#pragma unroll
            for (int m = 0; m < 4; ++m)
#pragma unroll
                for (int n = 0; n < 2; ++n) acc[m][n] = __builtin_amdgcn_mfma_f32_16x16x32_bf16(b[n], a[m], acc[m][n], 0, 0, 0); }
#pragma unroll
        for (int m = 0; m < 4; ++m)
#pragma unroll
            for (int n = 0; n < 2; ++n) E(row0 + m * 16 + fr, col0 + n * 16 + 4 * fq, acc[m][n]); }
}

constexpr size_t SLOT_ELEMS = SLOT_BYTES / 2;
struct EpiSeg4 { bf16_t* S0; bf16_t* HQ;
    __device__ __forceinline__ void operator()(int r, int c, f32x4 v) const { const int seg = c >> 10, cc = c & 1023; bf16_t* O = S0 + (size_t)(seg + 1 + (seg >= 2 ? 1 : 0)) * SLOT_ELEMS;
        u32x2 w; w.x = pk2(v.x, v.y); w.y = pk2(v.z, v.w); *(u32x2*)(O + (size_t)r * D + cc) = w;
        const int rr = r & 63; if (seg >= 2 && rr >= 61) *(u32x2*)(HQ + (size_t)(seg - 2) * (3 * MiB / 2) + ((size_t)(r >> 6) * 3 + (rr - 61)) * D + cc) = w; }
    __device__ __forceinline__ void operator()(int r, int c, f32x4 v0, f32x4 v1) const { const int seg = c >> 10, cc = c & 1023; bf16_t* O = S0 + (size_t)(seg + 1 + (seg >= 2 ? 1 : 0)) * SLOT_ELEMS; u32x4 w; w.x = pk2(v0.x, v0.y); w.y = pk2(v0.z, v0.w); w.z = pk2(v1.x, v1.y); w.w = pk2(v1.z, v1.w); *(u32x4*)(O + (size_t)r * D + cc) = w;
        const int rr = r & 63; if (seg >= 2 && rr >= 61) *(u32x4*)(HQ + (size_t)(seg - 2) * (3 * MiB / 2) + ((size_t)(r >> 6) * 3 + (rr - 61)) * D + cc) = w; } };
struct EpiVT2 { bf16_t* S0;
    __device__ __forceinline__ void operator()(int r, int c, f32x4 v) const { bf16_t* O = S0 + (size_t)(3 + 3 * (r >> 10)) * SLOT_ELEMS;
        u32x2 w; w.x = pk2(v.x, v.y); w.y = pk2(v.z, v.w); *(u32x2*)(O + (size_t)(r & 1023) * T + c) = w; }
    __device__ __forceinline__ void operator()(int r, int c, f32x4 v0, f32x4 v1) const { bf16_t* O = S0 + (size_t)(3 + 3 * (r >> 10)) * SLOT_ELEMS; u32x4 w; w.x = pk2(v0.x, v0.y); w.y = pk2(v0.z, v0.w); w.z = pk2(v1.x, v1.y); w.w = pk2(v1.z, v1.w); *(u32x4*)(O + (size_t)(r & 1023) * T + c) = w; } };
struct EpiSeg2 { bf16_t* S0;
    __device__ __forceinline__ void operator()(int r, int c, f32x4 v) const { bf16_t* O = S0 + (size_t)(3 - (c >> 10)) * SLOT_ELEMS;
        u32x2 w; w.x = pk2(v.x, v.y); w.y = pk2(v.z, v.w); *(u32x2*)(O + (size_t)r * D + (c & 1023)) = w; }
    __device__ __forceinline__ void operator()(int r, int c, f32x4 v0, f32x4 v1) const { bf16_t* O = S0 + (size_t)(3 - (c >> 10)) * SLOT_ELEMS; u32x4 w; w.x = pk2(v0.x, v0.y); w.y = pk2(v0.z, v0.w); w.z = pk2(v1.x, v1.y); w.w = pk2(v1.z, v1.w); *(u32x4*)(O + (size_t)r * D + (c & 1023)) = w; } };
struct EpiRelu2RS { bf16_t* O; int ldc; const float* ssq;
    __device__ __forceinline__ void operator()(int r, int c, f32x4 v) const { const float rs = rsqrtf(ssq[r] * (1.f / D) + EPS);
        f32x4 t = (f32x4){fmaxf(v.x * rs, 0.f), fmaxf(v.y * rs, 0.f), fmaxf(v.z * rs, 0.f), fmaxf(v.w * rs, 0.f)}; t = t * t;
        u32x2 w; w.x = pk2(t.x, t.y); w.y = pk2(t.z, t.w); *(u32x2*)(O + (size_t)r * ldc + c) = w; }
    __device__ __forceinline__ void operator()(int r, int c, f32x4 v0, f32x4 v1) const { const float rs = rsqrtf(ssq[r] * (1.f / D) + EPS);
        v0 = (f32x4){fmaxf(v0.x * rs, 0.f), fmaxf(v0.y * rs, 0.f), fmaxf(v0.z * rs, 0.f), fmaxf(v0.w * rs, 0.f)}; v0 = v0 * v0; v1 = (f32x4){fmaxf(v1.x * rs, 0.f), fmaxf(v1.y * rs, 0.f), fmaxf(v1.z * rs, 0.f), fmaxf(v1.w * rs, 0.f)}; v1 = v1 * v1; u32x4 w; w.x = pk2(v0.x, v0.y); w.y = pk2(v0.z, v0.w); w.z = pk2(v1.x, v1.y); w.w = pk2(v1.z, v1.w); *(u32x4*)(O + (size_t)r * ldc + c) = w; } };
struct GateMixOrder { pg8::StaticOrder so;
    __device__ __forceinline__ bool next(int i, pg8::Unit& u) const { const int ti = i / 6, r = i - 6 * ti, br = r >> 1; pg8::Unit t; if (!so.next(ti, t)) return false;
        if ((r & 1) == 0) { u.pm = t.pm; u.pn = br * 4 + t.pn; } else { const int slot = 1 + (br == 1 ? 3 : 0) + (br == 2 ? 1 : 0); u.pm = slot * 128 + t.pm; u.pn = 20 + br * 4 + t.pn; }
        return true; }
    __device__ __forceinline__ void a_ready(const pg8::Unit&) const {}
    __device__ __forceinline__ void done(const pg8::Unit&) const {} };
struct EpiGateMix { static constexpr bool PERM = true, AFTER_DRAIN = false; bf16_t* S0; const float* bias;
    __device__ __forceinline__ void operator()(const f32x4 (&acc)[2][2][4][2], const pg8::Unit& u, int wr, int wc, int fr, int fq) const {
        const bool mix = u.pn >= 20; const int q = mix ? u.pn - 20 : u.pn, br = q >> 2, pn = q & 3, pm = u.pm & 127;
        unsigned char* G8 = (unsigned char*)(S0 + (size_t)(br == 2 ? 6 : 5) * SLOT_ELEMS) + (br == 1 ? (size_t)T * D : 0);
        bf16_t* R = S0 + (size_t)3 * SLOT_ELEMS;
        if (!mix) {
#pragma unroll
            for (int bj = 0; bj < 2; ++bj) { const int col = pn * 256 + bj * 128 + wc * 32 + 8 * fq; const f32x4 b0 = *(const f32x4*)(bias + br * 1024 + col), b1 = *(const f32x4*)(bias + br * 1024 + col + 4);
#pragma unroll
                for (int ai = 0; ai < 2; ++ai)
#pragma unroll
                    for (int m = 0; m < 4; ++m) { const int row = pm * 256 + ai * 128 + wr * 64 + m * 16 + fr; const f32x4 v0 = acc[ai][bj][m][0] + b0, v1 = acc[ai][bj][m][1] + b1;
                        u32x2 g8;
                        g8.x = (unsigned)(sigmoidf_(v0.x) * 255.f + 0.5f) | ((unsigned)(sigmoidf_(v0.y) * 255.f + 0.5f) << 8) | ((unsigned)(sigmoidf_(v0.z) * 255.f + 0.5f) << 16) | ((unsigned)(sigmoidf_(v0.w) * 255.f + 0.5f) << 24);
                        g8.y = (unsigned)(sigmoidf_(v1.x) * 255.f + 0.5f) | ((unsigned)(sigmoidf_(v1.y) * 255.f + 0.5f) << 8) | ((unsigned)(sigmoidf_(v1.z) * 255.f + 0.5f) << 16) | ((unsigned)(sigmoidf_(v1.w) * 255.f + 0.5f) << 24);
                        *(u32x2*)(G8 + ((((size_t)(pm * 4 + pn) * 8 + (wr * 4 + wc)) * 8 + ai * 4 + m) * 2 + bj) * 512 + (fq * 16 + fr) * 8) = g8; } }
        } else {
            const float k255 = 1.f / 255.f;
#pragma unroll
            for (int ai = 0; ai < 2; ++ai) { u32x2 gw[4][2]; u32x4 pw[4][2];
#pragma unroll
                for (int m = 0; m < 4; ++m)
#pragma unroll
                    for (int bj = 0; bj < 2; ++bj) { const size_t off = (size_t)(pm * 256 + ai * 128 + wr * 64 + m * 16 + fr) * D + pn * 256 + bj * 128 + wc * 32 + 8 * fq; gw[m][bj] = *(const u32x2*)(G8 + ((((size_t)(pm * 4 + pn) * 8 + (wr * 4 + wc)) * 8 + ai * 4 + m) * 2 + bj) * 512 + (fq * 16 + fr) * 8); if (br >= 1) pw[m][bj] = *(const u32x4*)(R + off); }
#pragma unroll
                for (int m = 0; m < 4; ++m)
#pragma unroll
                    for (int bj = 0; bj < 2; ++bj) { const size_t off = (size_t)(pm * 256 + ai * 128 + wr * 64 + m * 16 + fr) * D + pn * 256 + bj * 128 + wc * 32 + 8 * fq; const f32x4 v0 = acc[ai][bj][m][0], v1 = acc[ai][bj][m][1];
                        const unsigned ga = gw[m][bj].x, gb = gw[m][bj].y;
                        f32x4 m0 = (f32x4){(float)(ga & 255u) * k255 * v0.x, (float)((ga >> 8) & 255u) * k255 * v0.y, (float)((ga >> 16) & 255u) * k255 * v0.z, (float)(ga >> 24) * k255 * v0.w};
                        f32x4 m1 = (f32x4){(float)(gb & 255u) * k255 * v1.x, (float)((gb >> 8) & 255u) * k255 * v1.y, (float)((gb >> 16) & 255u) * k255 * v1.z, (float)(gb >> 24) * k255 * v1.w};
                        if (br >= 1) { const u32x4 p = pw[m][bj]; m0.x += bflo(p.x); m0.y += bfhi(p.x); m0.z += bflo(p.y); m0.w += bfhi(p.y); m1.x += bflo(p.z); m1.y += bfhi(p.z); m1.z += bflo(p.w); m1.w += bfhi(p.w); }
                        u32x4 w; w.x = pk2(m0.x, m0.y); w.y = pk2(m0.z, m0.w); w.z = pk2(m1.x, m1.y); w.w = pk2(m1.z, m1.w); *(u32x4*)(R + off) = w; } }
        } } };
struct EpiResidSS { static constexpr bool PERM = true, AFTER_DRAIN = false; const float* base; float* out; bf16_t* xb; float* ssq;
    __device__ __forceinline__ void operator()(const f32x4 (&acc)[2][2][4][2], const pg8::Unit& u, int wr, int wc, int fr, int fq) const {
#pragma unroll
        for (int ai = 0; ai < 2; ++ai) { f32x4 pre[4][2][2];
#pragma unroll
            for (int m = 0; m < 4; ++m)
#pragma unroll
                for (int bj = 0; bj < 2; ++bj) { const float* bp = base + (size_t)(u.pm * 256 + ai * 128 + wr * 64 + m * 16 + fr) * D + u.pn * 256 + bj * 128 + wc * 32 + 8 * fq; pre[m][bj][0] = *(const f32x4*)bp; pre[m][bj][1] = *(const f32x4*)(bp + 4); }
#pragma unroll
            for (int m = 0; m < 4; ++m) { const int row = u.pm * 256 + ai * 128 + wr * 64 + m * 16 + fr; float ss = 0.f;
#pragma unroll
                for (int bj = 0; bj < 2; ++bj) { const size_t off = (size_t)row * D + u.pn * 256 + bj * 128 + wc * 32 + 8 * fq;
                    const f32x4 o0 = pre[m][bj][0] + acc[ai][bj][m][0], o1 = pre[m][bj][1] + acc[ai][bj][m][1];
                    u32x4 w; w.x = pk2(o0.x, o0.y); w.y = pk2(o0.z, o0.w); w.z = pk2(o1.x, o1.y); w.w = pk2(o1.z, o1.w); *(u32x4*)(xb + off) = w;
                    ss += ((o0.x * o0.x + o0.y * o0.y) + (o0.z * o0.z + o0.w * o0.w)) + ((o1.x * o1.x + o1.y * o1.y) + (o1.z * o1.z + o1.w * o1.w)); }
                ss += __shfl_xor(ss, 16); ss += __shfl_xor(ss, 32);
                if (fq == 0) atomicAdd(ssq + row, ss); } } } };
struct EpiResidIn { static constexpr bool PERM = true, AFTER_DRAIN = false; const bf16_t* xb; float* out;
    __device__ __forceinline__ void operator()(const f32x4 (&acc)[2][2][4][2], const pg8::Unit& u, int wr, int wc, int fr, int fq) const {
#pragma unroll
        for (int ai = 0; ai < 2; ++ai) { u32x4 pre[4][2];
#pragma unroll
            for (int m = 0; m < 4; ++m)
#pragma unroll
                for (int bj = 0; bj < 2; ++bj) pre[m][bj] = *(const u32x4*)(xb + (size_t)(u.pm * 256 + ai * 128 + wr * 64 + m * 16 + fr) * D + u.pn * 256 + bj * 128 + wc * 32 + 8 * fq);
#pragma unroll
            for (int m = 0; m < 4; ++m)
#pragma unroll
                for (int bj = 0; bj < 2; ++bj) { const f32x4 a0 = acc[ai][bj][m][0], a1 = acc[ai][bj][m][1]; const u32x4 p = pre[m][bj];
                    float* op = out + (size_t)(u.pm * 256 + ai * 128 + wr * 64 + m * 16 + fr) * D + u.pn * 256 + bj * 128 + wc * 32 + 8 * fq;
                    *(f32x4*)op = (f32x4){bflo(p.x) + a0.x, bfhi(p.x) + a0.y, bflo(p.y) + a0.z, bfhi(p.y) + a0.w}; *(f32x4*)(op + 4) = (f32x4){bflo(p.z) + a1.x, bfhi(p.z) + a1.y, bflo(p.w) + a1.z, bfhi(p.w) + a1.w}; } } } };

#define LAS __attribute__((address_space(3)))
typedef float f32x16 __attribute__((ext_vector_type(16)));
constexpr int SB_KST = 272, SB_VST = 136, SB_KBYTES = 64 * SB_KST, SB_VBYTES = 128 * SB_VST, SB_BUF = SB_KBYTES + SB_VBYTES;
template <bool DIAG>
__device__ __forceinline__ void sb_subtile(LAS unsigned char* buf, int st, const bf16x8 (&qf)[8], f32x16 (&Y)[4], float& R, int k0, int qi, int r32, int hh) {
    f32x16 X;
#pragma unroll
    for (int r = 0; r < 16; ++r) X[r] = 0.f;
    LAS unsigned char* kp = buf + (32 * st + r32) * SB_KST + hh * 16;
#pragma unroll
    for (int s = 0; s < 8; ++s) { const bf16x8 kf = *(LAS bf16x8*)(kp + s * 32); X = __builtin_amdgcn_mfma_f32_32x32x16_bf16(kf, qf[s], X, 0, 0, 0); }
    float om[16];
#pragma unroll
    for (int r = 0; r < 16; ++r) { const float zz = __builtin_amdgcn_fmed3f(X[r] * (-0.08838834764831845f * 1.4426950408889634f), -80.f, 80.f);
        const float u = __builtin_amdgcn_exp2f(zz); const float be = __builtin_amdgcn_rcpf(1.f + u);
        const int key = k0 + (r & 3) + 8 * (r >> 2) + 4 * hh; const bool valid = !DIAG || key < qi;
        om[r] = valid ? u * be : 1.f; X[r] = valid ? be : 0.f; }
    float g[4], og[4], pr[4];
#pragma unroll
    for (int c = 0; c < 4; ++c) { g[c] = (om[4 * c] * om[4 * c + 1]) * (om[4 * c + 2] * om[4 * c + 3]); og[c] = __shfl_xor(g[c], 32); pr[c] = g[c] * og[c]; }
    float Tc[4]; Tc[3] = 1.f; Tc[2] = pr[3]; Tc[1] = pr[3] * pr[2]; Tc[0] = Tc[1] * pr[1];
    const float total = Tc[0] * pr[0];
#pragma unroll
    for (int c = 0; c < 4; ++c) { float later = R * Tc[c] * (hh == 0 ? og[c] : 1.f);
#pragma unroll
        for (int i = 3; i >= 0; --i) { const int r = 4 * c + i; const float pv = X[r] * later; later *= om[r]; X[r] = pv; } }
    R *= total;
    bf16x8 pf[2];
#pragma unroll
    for (int s2 = 0; s2 < 2; ++s2) { u32x4 w; w.x = pk2(X[8 * s2], X[8 * s2 + 1]); w.y = pk2(X[8 * s2 + 2], X[8 * s2 + 3]); w.z = pk2(X[8 * s2 + 4], X[8 * s2 + 5]); w.w = pk2(X[8 * s2 + 6], X[8 * s2 + 7]); pf[s2] = __builtin_bit_cast(bf16x8, w); }
#pragma unroll
    for (int dt = 0; dt < 4; ++dt) { LAS unsigned char* vp = buf + SB_KBYTES + (32 * dt + r32) * SB_VST + (32 * st + 4 * hh) * 2;
#pragma unroll
        for (int s2 = 0; s2 < 2; ++s2) { const u32x2 lo = *(LAS u32x2*)(vp + s2 * 32), hi = *(LAS u32x2*)(vp + s2 * 32 + 16);
            u32x4 w; w.x = lo.x; w.y = lo.y; w.z = hi.x; w.w = hi.y;
            Y[dt] = __builtin_amdgcn_mfma_f32_32x32x16_bf16(__builtin_bit_cast(bf16x8, w), pf[s2], Y[dt], 0, 0, 0); } }
}
__device__ __forceinline__ void sb_tile_full(LAS unsigned char* buf, const bf16x8 (&qf)[8], f32x16 (&Y)[4], float& R, int r32, int hh) {
    f32x16 X1, X0;
#pragma unroll
    for (int r = 0; r < 16; ++r) { X1[r] = 0.f; X0[r] = 0.f; }
    LAS unsigned char* kp = buf + r32 * SB_KST + hh * 16;
#pragma unroll
    for (int s = 0; s < 8; ++s) { const bf16x8 k1 = *(LAS bf16x8*)(kp + 32 * SB_KST + s * 32), k0_ = *(LAS bf16x8*)(kp + s * 32);
        X1 = __builtin_amdgcn_mfma_f32_32x32x16_bf16(k1, qf[s], X1, 0, 0, 0); X0 = __builtin_amdgcn_mfma_f32_32x32x16_bf16(k0_, qf[s], X0, 0, 0, 0); }
    float om1[16], om0[16];
#pragma unroll
    for (int r = 0; r < 16; ++r) { const float z1 = __builtin_amdgcn_fmed3f(X1[r] * (-0.08838834764831845f * 1.4426950408889634f), -80.f, 80.f), z0 = __builtin_amdgcn_fmed3f(X0[r] * (-0.08838834764831845f * 1.4426950408889634f), -80.f, 80.f);
        const float u1 = __builtin_amdgcn_exp2f(z1), u0 = __builtin_amdgcn_exp2f(z0); const float b1 = __builtin_amdgcn_rcpf(1.f + u1), b0 = __builtin_amdgcn_rcpf(1.f + u0);
        om1[r] = u1 * b1; om0[r] = u0 * b0; X1[r] = b1; X0[r] = b0; }
    float g1[4], g0[4], o1[4], o0[4];
#pragma unroll
    for (int c = 0; c < 4; ++c) { g1[c] = (om1[4 * c] * om1[4 * c + 1]) * (om1[4 * c + 2] * om1[4 * c + 3]); g0[c] = (om0[4 * c] * om0[4 * c + 1]) * (om0[4 * c + 2] * om0[4 * c + 3]); }
#pragma unroll
    for (int c = 0; c < 4; ++c) { o1[c] = __shfl_xor(g1[c], 32); o0[c] = __shfl_xor(g0[c], 32); }
    float T1[4], T0[4];
    { const float p3 = g1[3] * o1[3], p2 = g1[2] * o1[2], p1 = g1[1] * o1[1], p0 = g1[0] * o1[0]; T1[3] = R; T1[2] = R * p3; T1[1] = T1[2] * p2; T1[0] = T1[1] * p1; R = T1[0] * p0; }
    { const float p3 = g0[3] * o0[3], p2 = g0[2] * o0[2], p1 = g0[1] * o0[1], p0 = g0[0] * o0[0]; T0[3] = R; T0[2] = R * p3; T0[1] = T0[2] * p2; T0[0] = T0[1] * p1; R = T0[0] * p0; }
#pragma unroll
    for (int c = 0; c < 4; ++c) { float l1 = T1[c] * (hh == 0 ? o1[c] : 1.f), l0 = T0[c] * (hh == 0 ? o0[c] : 1.f);
#pragma unroll
        for (int i = 3; i >= 0; --i) { const int r = 4 * c + i; const float p1 = X1[r] * l1, p0 = X0[r] * l0; l1 *= om1[r]; l0 *= om0[r]; X1[r] = p1; X0[r] = p0; } }
    bf16x8 pf1[2], pf0[2];
#pragma unroll
    for (int s2 = 0; s2 < 2; ++s2) { u32x4 w; w.x = pk2(X1[8 * s2], X1[8 * s2 + 1]); w.y = pk2(X1[8 * s2 + 2], X1[8 * s2 + 3]); w.z = pk2(X1[8 * s2 + 4], X1[8 * s2 + 5]); w.w = pk2(X1[8 * s2 + 6], X1[8 * s2 + 7]); pf1[s2] = __builtin_bit_cast(bf16x8, w);
        w.x = pk2(X0[8 * s2], X0[8 * s2 + 1]); w.y = pk2(X0[8 * s2 + 2], X0[8 * s2 + 3]); w.z = pk2(X0[8 * s2 + 4], X0[8 * s2 + 5]); w.w = pk2(X0[8 * s2 + 6], X0[8 * s2 + 7]); pf0[s2] = __builtin_bit_cast(bf16x8, w); }
    LAS unsigned char* vp0 = buf + SB_KBYTES + r32 * SB_VST + (4 * hh) * 2;
    u32x4 va[8], vb[8];
#pragma unroll
    for (int i = 0; i < 8; ++i) { LAS unsigned char* vp = vp0 + (32 * (i >> 2)) * SB_VST + (i & 3) * 32; const u32x2 lo = *(LAS u32x2*)vp, hi = *(LAS u32x2*)(vp + 16); va[i].x = lo.x; va[i].y = lo.y; va[i].z = hi.x; va[i].w = hi.y; }
#pragma unroll
    for (int i = 0; i < 8; ++i) asm volatile("" : "+v"(va[i]));
#pragma unroll
    for (int i = 0; i < 8; ++i) { LAS unsigned char* vp = vp0 + (32 * (2 + (i >> 2))) * SB_VST + (i & 3) * 32; const u32x2 lo = *(LAS u32x2*)vp, hi = *(LAS u32x2*)(vp + 16); vb[i].x = lo.x; vb[i].y = lo.y; vb[i].z = hi.x; vb[i].w = hi.y; }
    __builtin_amdgcn_sched_barrier(0);
#pragma unroll
    for (int i = 0; i < 8; ++i) { const int q4 = i & 3; Y[i >> 2] = __builtin_amdgcn_mfma_f32_32x32x16_bf16(__builtin_bit_cast(bf16x8, va[i]), (q4 < 2) ? pf0[q4] : pf1[q4 - 2], Y[i >> 2], 0, 0, 0); }
#pragma unroll
    for (int i = 0; i < 8; ++i) asm volatile("" : "+v"(vb[i]));
#pragma unroll
    for (int i = 0; i < 8; ++i) { const int q4 = i & 3; Y[2 + (i >> 2)] = __builtin_amdgcn_mfma_f32_32x32x16_bf16(__builtin_bit_cast(bf16x8, vb[i]), (q4 < 2) ? pf0[q4] : pf1[q4 - 2], Y[2 + (i >> 2)], 0, 0, 0); }
}
__device__ __forceinline__ void sb_fast(bf16_t* Q, const bf16_t* Kk, const bf16_t* VT, LAS unsigned char* lds) {
    int tid_ = threadIdx.x; asm volatile("" : "+v"(tid_));
    const int tid = tid_, lane = tid & 63, wid = tid >> 6, r32 = lane & 31, hh = lane >> 5;
    const int vcu_ = (gridDim.x % 8 == 0) ? (int)((blockIdx.x % 8) * (gridDim.x / 8) + blockIdx.x / 8) : (int)blockIdx.x;
    for (int vw = vcu_; vw < 256; vw += gridDim.x) {
        const int bh = vw >> 2, jj = vw & 3, b = bh >> 3, h = bh & 7;
        const bf16_t* kg = Kk + ((size_t)b * SEQ) * D + h * 128;
        const bf16_t* vg = VT + (size_t)(h * 128) * T + (size_t)b * SEQ;
        for (int ui = 0; ui < 4; ++ui) {
            const int qb = ui == 0 ? 2 * jj : (ui == 1 ? 15 - 2 * jj : (ui == 2 ? 2 * jj + 1 : 14 - 2 * jj));
            const int q0w = qb * 256 + 32 * wid, qi = q0w + r32;
            bf16_t* qrow = Q + ((size_t)b * SEQ + qi) * D + h * 128;
            bf16x8 qf[8];
#pragma unroll
            for (int s = 0; s < 8; ++s) qf[s] = *(const bf16x8*)(qrow + 16 * s + 8 * hh);
            f32x16 Y[4];
#pragma unroll
            for (int dt = 0; dt < 4; ++dt)
#pragma unroll
                for (int r = 0; r < 16; ++r) Y[dt][r] = 0.f;
            float R = 1.f;
            const int ktmax = 4 * qb + 3;
            u32x4 kr[2], vr[2];
#define SB_LOADG(kt) do { _Pragma("unroll") for (int i_ = 0; i_ < 2; ++i_) { const int c_ = tid + 512 * i_; \
                kr[i_] = *(const u32x4*)(kg + (size_t)(64 * (kt) + (c_ >> 4)) * D + (c_ & 15) * 8); \
                vr[i_] = *(const u32x4*)(vg + (size_t)(c_ >> 3) * T + 64 * (kt) + (c_ & 7) * 8); } } while (0)
#define SB_STORES(bufp) do { _Pragma("unroll") for (int i_ = 0; i_ < 2; ++i_) { const int c_ = tid + 512 * i_; \
                *(LAS u32x4*)((bufp) + (c_ >> 4) * SB_KST + (c_ & 15) * 16) = kr[i_]; \
                LAS u32x2* vp_ = (LAS u32x2*)((bufp) + SB_KBYTES + (c_ >> 3) * SB_VST + (c_ & 7) * 16); \
                u32x2 a_; a_.x = vr[i_].x; a_.y = vr[i_].y; u32x2 b_; b_.x = vr[i_].z; b_.y = vr[i_].w; vp_[0] = a_; vp_[1] = b_; } } while (0)
            SB_LOADG(ktmax); SB_STORES(lds);
#pragma unroll
            for (int s_ = 0; s_ < 8; ++s_) asm volatile("" : "+v"(qf[s_]));
            __syncthreads();
            for (int kt = ktmax, it = 0; kt >= 0; --kt, ++it) {
                LAS unsigned char* cur = lds + (it & 1) * SB_BUF; LAS unsigned char* nxt = lds + ((it & 1) ^ 1) * SB_BUF;
                if (kt > 0) SB_LOADG(kt - 1);
                if (64 * kt + 63 < q0w) sb_tile_full(cur, qf, Y, R, r32, hh);
                else {
#pragma unroll
                for (int st = 1; st >= 0; --st) { const int k0 = 64 * kt + 32 * st;
                    if (k0 < q0w + 31) { if (k0 + 31 >= q0w) sb_subtile<true>(cur, st, qf, Y, R, k0, qi, r32, hh); else sb_subtile<false>(cur, st, qf, Y, R, k0, qi, r32, hh); } } }
                if (kt > 0) SB_STORES(nxt);
                __syncthreads();
            }
#undef SB_LOADG
#undef SB_STORES
            { LAS unsigned char* stg = lds + wid * 8704;
#pragma unroll
              for (int dt = 0; dt < 4; ++dt)
#pragma unroll
                  for (int c = 0; c < 4; ++c) { u32x2 w; w.x = pk2(Y[dt][4 * c], Y[dt][4 * c + 1]); w.y = pk2(Y[dt][4 * c + 2], Y[dt][4 * c + 3]); *(LAS u32x2*)(stg + r32 * 272 + (32 * dt + 8 * c + 4 * hh) * 2) = w; }
              LDS_WAIT();
              bf16_t* orow = Q + ((size_t)b * SEQ + q0w) * D + h * 128;
#pragma unroll 1
              for (int i = 0; i < 8; ++i) { const int row = 4 * i + (lane >> 4), ch = lane & 15; const u32x4 v = *(LAS u32x4*)(stg + row * 272 + ch * 16); *(u32x4*)(orow + (size_t)row * D + ch * 8) = v; }
              __syncthreads(); }
        }
    }
}

__device__ __forceinline__ void conv_pass(bf16_t* MQ, bf16_t* MK, const bf16_t* haloQ, const bf16_t* haloK, const float* conv_w, const float* conv_b, int gw, int NGW, int lane) {
    for (int it = gw; it < 2048; it += NGW) {
        const int blk = it >> 2, isk = (it >> 1) & 1, half = it & 1;
        const int ch0 = (half * 64 + lane) * 8;
        bf16_t* base = (isk ? MK : MQ) + (size_t)blk * 64 * D + ch0;
        const float* cw = conv_w + isk * 1024 + ch0;
        float w0[8], w1[8], w2[8], w3[8], cb[8], r0[8], r1[8], r2[8];
#pragma unroll
        for (int e = 0; e < 8; ++e) { w0[e] = cw[e]; w1[e] = cw[2048 + e]; w2[e] = cw[4096 + e]; w3[e] = cw[6144 + e]; cb[e] = conv_b[isk * 1024 + ch0 + e]; r0[e] = 0.f; r1[e] = 0.f; r2[e] = 0.f; }
        if ((blk & 63) != 0) { const bf16_t* hal = (isk ? haloK : haloQ) + (size_t)(blk - 1) * 3 * D + ch0;
            const u32x4 h0 = *(const u32x4*)hal, h1 = *(const u32x4*)(hal + D), h2 = *(const u32x4*)(hal + 2 * D);
#pragma unroll
            for (int e2 = 0; e2 < 4; ++e2) { r0[2 * e2] = bflo(h0[e2]); r0[2 * e2 + 1] = bfhi(h0[e2]); r1[2 * e2] = bflo(h1[e2]); r1[2 * e2 + 1] = bfhi(h1[e2]); r2[2 * e2] = bflo(h2[e2]); r2[2 * e2 + 1] = bfhi(h2[e2]); } }
        const float osc = isk ? 0.0625f : 1.f;
        u32x4 in[4];
#pragma unroll
        for (int i = 0; i < 4; ++i) in[i] = *(const u32x4*)(base + (size_t)i * D);
#pragma unroll 1
        for (int r4 = 0; r4 < 64; r4 += 4) {
            u32x4 nx[4]; const int rn = (r4 + 4 < 64) ? r4 + 4 : r4;
#pragma unroll
            for (int i = 0; i < 4; ++i) nx[i] = *(const u32x4*)(base + (size_t)(rn + i) * D);
#pragma unroll
            for (int i = 0; i < 4; ++i) { float y[8];
#pragma unroll
                for (int e = 0; e < 8; ++e) { const float xv = (e & 1) ? bfhi(in[i][e >> 1]) : bflo(in[i][e >> 1]);
                    const float u = w0[e] * r0[e] + w1[e] * r1[e] + w2[e] * r2[e] + w3[e] * xv + cb[e]; r0[e] = r1[e]; r1[e] = r2[e]; r2[e] = xv; y[e] = u * sigmoidf_(u) * osc; }
                u32x4 o; o.x = pk2(y[0], y[1]); o.y = pk2(y[2], y[3]); o.z = pk2(y[4], y[5]); o.w = pk2(y[6], y[7]); *(u32x4*)(base + (size_t)(r4 + i) * D) = o; }
#pragma unroll
            for (int i = 0; i < 4; ++i) in[i] = nx[i];
        }
    }
}

__device__ __forceinline__ void gate_pass(const float* ifp, float* GA, float* GP, float* GB, int gw, int NGW, int lane) {
    for (int it = gw; it < 2048; it += NGW) { const int bh = it >> 6, c = it & 63, b = bh >> 2, h = bh & 3;
        const size_t trow = (size_t)b * SEQ + 64 * c + lane; const float gi = ifp[trow * 8 + h], gf = ifp[trow * 8 + 4 + h];
        const float lf = -(fmaxf(-gf, 0.f) + __logf(1.f + __expf(-fabsf(gf))));
        float bc = lf;
#pragma unroll
        for (int o = 1; o < 64; o <<= 1) { const float t_ = __shfl_up(bc, o); if (lane >= o) bc += t_; }
        const float a = gi - bc; float pm = a;
#pragma unroll
        for (int o = 1; o < 64; o <<= 1) { const float t_ = __shfl_up(pm, o); if (lane >= o) pm = fmaxf(pm, t_); }
        const size_t o_ = (size_t)bh * SEQ + 64 * c + lane; GA[o_] = a; GP[o_] = pm; GB[o_] = bc; }
}

constexpr int ML_QS = 0, ML_KS = 33792, ML_KST = 67584, ML_VTS = 104448, ML_VWT = 109200, ML_SCB = 113952, ML_CB = 123168, ML_VEC = 140592, ML_RS = 528, ML_TS = 144;
__device__ __forceinline__ void mlstm_fast(const bf16_t* MQ, const bf16_t* MK, const bf16_t* MVT, const float* GA, const float* GP, const float* GB, bf16_t* HUN, LAS unsigned char* lds) {
    int tid_ = threadIdx.x; asm volatile("" : "+v"(tid_));
    const int tid = tid_, lane = tid & 63, w = tid >> 6, fr = lane & 15, fq = lane >> 4;
    LAS float* vA = (LAS float*)(lds + ML_VEC); LAS float* vM = vA + 64; LAS float* vSI = vA + 128; LAS float* vEM = vA + 192; LAS float* vWK = vA + 256; LAS float* vDEC = vA + 320;
    const int tt = w & 3, sp = w >> 2;
    const int vcu_ = (gridDim.x % 8 == 0) ? (int)((blockIdx.x % 8) * (gridDim.x / 8) + blockIdx.x / 8) : (int)blockIdx.x;
    for (int item = vcu_; item < 256; item += gridDim.x) {
        const int bh = item >> 3, vs = item & 7, b = bh >> 2, h = bh & 3;
        const bf16_t* qg = MQ + ((size_t)b * SEQ + (tid >> 5)) * D + h * 256 + (tid & 31) * 8;
        const bf16_t* kg = MK + ((size_t)b * SEQ + (tid >> 5)) * D + h * 256 + (tid & 31) * 8;
        const bf16_t* vg = MVT + (size_t)(h * 256 + vs * 32 + ((tid >> 3) & 31)) * T + (size_t)b * SEQ + (tid & 7) * 8;
        const size_t go = (size_t)bh * SEQ + lane;
        bf16_t* hg = HUN + ((size_t)b * SEQ + 16 * tt + fr) * D + h * 256 + vs * 32 + 16 * sp + 4 * fq;
        for (int i = tid; i < 17424 / 16; i += NTHREADS) *(LAS u32x4*)(lds + ML_CB + i * 16) = (u32x4){0u, 0u, 0u, 0u};
        if (tid < 32) *(LAS unsigned*)(lds + ML_VTS + 32 * ML_TS + 4 * tid) = 0x3F803F80u;
        u32x4 pq[4], pk[4], pv; float ga = 0.f, gp_ = 0.f, gb = 0.f, nga = 0.f, ngp = 0.f, ngb = 0.f;
#define ML_LOAD(c) do { _Pragma("unroll") for (int i_ = 0; i_ < 4; ++i_) { pq[i_] = *(const u32x4*)(qg + (size_t)(64 * (c) + 16 * i_) * D); pk[i_] = *(const u32x4*)(kg + (size_t)(64 * (c) + 16 * i_) * D); } \
            if (tid < 256) pv = *(const u32x4*)(vg + 64 * (c)); if (w == 0) { nga = GA[go + 64 * (c)]; ngp = GP[go + 64 * (c)]; ngb = GB[go + 64 * (c)]; } } while (0)
#define ML_STORE() do { _Pragma("unroll") for (int i_ = 0; i_ < 4; ++i_) { *(LAS u32x4*)(lds + ML_QS + ((tid >> 5) + 16 * i_) * ML_RS + (tid & 31) * 16) = pq[i_]; *(LAS u32x4*)(lds + ML_KS + ((tid >> 5) + 16 * i_) * ML_RS + (tid & 31) * 16) = pk[i_]; } \
            if (tid < 256) *(LAS u32x4*)(lds + ML_VTS + (tid >> 3) * ML_TS + (tid & 7) * 16) = pv; } while (0)
        ML_LOAD(0); ML_STORE(); ga = nga; gp_ = ngp; gb = ngb;
        __syncthreads();
        float m_prev = 0.f;
        f32x4 Cacc[2][3];
#pragma unroll
        for (int u = 0; u < 2; ++u)
#pragma unroll
            for (int v3 = 0; v3 < 3; ++v3) Cacc[u][v3] = (f32x4){0.f, 0.f, 0.f, 0.f};
#pragma unroll 1
        for (int c = 0; c < 64; ++c) {
            if (c < 63) ML_LOAD(c + 1);
#pragma unroll
            for (int i_ = 0; i_ < 4; ++i_) { const u32x4 kv = *(LAS u32x4*)(lds + ML_KS + lane * ML_RS + (4 * w + i_) * 16);
#pragma unroll
                for (int e_ = 0; e_ < 8; ++e_) { const unsigned wd_ = kv[e_ >> 1]; *(LAS bf16_t*)(lds + ML_KST + (32 * w + 8 * i_ + e_) * ML_TS + 2 * lane) = (bf16_t)((e_ & 1) ? (wd_ >> 16) : (wd_ & 0xffffu)); } }
            if (w == 0) {
                const float Mt = fmaxf(m_prev, gp_);
                const float Mend = __shfl(Mt, 63), bend = __shfl(gb, 63);
                vA[lane] = ga; vM[lane] = Mt; vSI[lane] = __expf(m_prev - Mt); vEM[lane] = __expf(-(gb + Mt)); vWK[lane] = __expf(ga - Mend);
                if (lane == 0) vDEC[0] = __expf(m_prev - Mend);
                m_prev = bend + Mend;
            }
            f32x4 S[2]; S[0] = (f32x4){0.f, 0.f, 0.f, 0.f}; S[1] = S[0];
#pragma unroll
            for (int ks = 0; ks < 8; ++ks) { const bf16x8 bq = *(LAS bf16x8*)(lds + ML_QS + (16 * tt + fr) * ML_RS + (32 * ks + 8 * fq) * 2);
                const bf16x8 a0 = *(LAS bf16x8*)(lds + ML_KS + (32 * sp + fr) * ML_RS + (32 * ks + 8 * fq) * 2); const bf16x8 a1 = *(LAS bf16x8*)(lds + ML_KS + (32 * sp + 16 + fr) * ML_RS + (32 * ks + 8 * fq) * 2);
                S[0] = __builtin_amdgcn_mfma_f32_16x16x32_bf16(a0, bq, S[0], 0, 0, 0); S[1] = __builtin_amdgcn_mfma_f32_16x16x32_bf16(a1, bq, S[1], 0, 0, 0); }
            LDS_BARRIER();
            { const float Mt = vM[16 * tt + fr]; const int t = 16 * tt + fr;
#pragma unroll
              for (int u = 0; u < 2; ++u) { const int st = 2 * sp + u; const f32x4 av = *(LAS f32x4*)(vA + 16 * st + 4 * fq); float sc[4];
#pragma unroll
                  for (int j = 0; j < 4; ++j) { const int s_ = 16 * st + 4 * fq + j; sc[j] = (s_ <= t) ? S[u][j] * __expf(av[j] - Mt) : 0.f; }
                  u32x2 o; o.x = pk2(sc[0], sc[1]); o.y = pk2(sc[2], sc[3]); *(LAS u32x2*)(lds + ML_SCB + t * ML_TS + (16 * st + 4 * fq) * 2) = o; }
              const int v_ = tid >> 4, s4 = (tid & 15) * 4; const f32x4 wk = *(LAS f32x4*)(vWK + s4);
              const u32x2 vv = *(LAS u32x2*)(lds + ML_VTS + v_ * ML_TS + s4 * 2);
              u32x2 o; o.x = pk2(bflo(vv.x) * wk.x, bfhi(vv.x) * wk.y); o.y = pk2(bflo(vv.y) * wk.z, bfhi(vv.y) * wk.w); *(LAS u32x2*)(lds + ML_VWT + v_ * ML_TS + s4 * 2) = o;
              if (tid < 16) { u32x2 o2; o2.x = pk2(wk.x, wk.y); o2.y = pk2(wk.z, wk.w); *(LAS u32x2*)(lds + ML_VWT + 32 * ML_TS + s4 * 2) = o2; } }
            LDS_BARRIER();
            { f32x4 a1 = (f32x4){0.f, 0.f, 0.f, 0.f}, a1n = a1, a2 = a1, a2n = a1;
#pragma unroll
              for (int ks = 0; ks < 8; ++ks) { const bf16x8 bq = *(LAS bf16x8*)(lds + ML_QS + (16 * tt + fr) * ML_RS + (32 * ks + 8 * fq) * 2);
                  const bf16x8 ac = *(LAS bf16x8*)(lds + ML_CB + (16 * sp + fr) * ML_RS + (32 * ks + 8 * fq) * 2); const bf16x8 an = *(LAS bf16x8*)(lds + ML_CB + 32 * ML_RS + (32 * ks + 8 * fq) * 2);
                  a1 = __builtin_amdgcn_mfma_f32_16x16x32_bf16(ac, bq, a1, 0, 0, 0); a1n = __builtin_amdgcn_mfma_f32_16x16x32_bf16(an, bq, a1n, 0, 0, 0); }
#pragma unroll
              for (int ks = 0; ks < 2; ++ks) { const bf16x8 bs = *(LAS bf16x8*)(lds + ML_SCB + (16 * tt + fr) * ML_TS + (32 * ks + 8 * fq) * 2);
                  const bf16x8 av = *(LAS bf16x8*)(lds + ML_VTS + (16 * sp + fr) * ML_TS + (32 * ks + 8 * fq) * 2); const bf16x8 an = *(LAS bf16x8*)(lds + ML_VTS + 32 * ML_TS + (32 * ks + 8 * fq) * 2);
                  a2 = __builtin_amdgcn_mfma_f32_16x16x32_bf16(av, bs, a2, 0, 0, 0); a2n = __builtin_amdgcn_mfma_f32_16x16x32_bf16(an, bs, a2n, 0, 0, 0); }
              const float si = vSI[16 * tt + fr], em = vEM[16 * tt + fr];
              const float den = a2n[0] + si * a1n[0]; const float rd = 1.f / fmaxf(fabsf(den), em);
              u32x2 o; o.x = pk2((a2[0] + si * a1[0]) * rd, (a2[1] + si * a1[1]) * rd); o.y = pk2((a2[2] + si * a1[2]) * rd, (a2[3] + si * a1[3]) * rd);
              *(u32x2*)(hg + (size_t)(64 * c) * D) = o; }
            { const float dec = vDEC[0];
#pragma unroll
              for (int u = 0; u < 2; ++u)
#pragma unroll
                  for (int v3 = 0; v3 < 3; ++v3) Cacc[u][v3] = Cacc[u][v3] * dec;
#pragma unroll
              for (int ks = 0; ks < 2; ++ks) { bf16x8 bv[3];
#pragma unroll
                  for (int v3 = 0; v3 < 3; ++v3) { const int vr = (v3 < 2) ? 16 * v3 + fr : 32; bv[v3] = *(LAS bf16x8*)(lds + ML_VWT + vr * ML_TS + (32 * ks + 8 * fq) * 2); }
#pragma unroll
                  for (int u = 0; u < 2; ++u) { const bf16x8 ak = *(LAS bf16x8*)(lds + ML_KST + (16 * (2 * w + u) + fr) * ML_TS + (32 * ks + 8 * fq) * 2);
#pragma unroll
                      for (int v3 = 0; v3 < 3; ++v3) Cacc[u][v3] = __builtin_amdgcn_mfma_f32_16x16x32_bf16(ak, bv[v3], Cacc[u][v3], 0, 0, 0); } } }
            LDS_BARRIER();
#pragma unroll
            for (int u = 0; u < 2; ++u)
#pragma unroll
                for (int v3 = 0; v3 < 3; ++v3) { if (v3 < 2 || fr == 0) { const int vr = (v3 < 2) ? 16 * v3 + fr : 32; const f32x4 cv = Cacc[u][v3];
                    u32x2 o; o.x = pk2(cv.x, cv.y); o.y = pk2(cv.z, cv.w); *(LAS u32x2*)(lds + ML_CB + vr * ML_RS + (16 * (2 * w + u) + 4 * fq) * 2) = o; } }
            if (c < 63) { ML_STORE(); ga = nga; gp_ = ngp; gb = ngb; }
            LDS_BARRIER();
        }
#undef ML_LOAD
#undef ML_STORE
    }
}

__device__ __forceinline__ void memk_norm(bf16_t* MK, const float* gk, const float* gq, int gw, int NGW, int lane) {
    for (int r = gw; r < TMEM * 4; r += NGW) { const int bm = r >> 2, h = r & 3; bf16_t* p = MK + (size_t)bm * D + h * 256 + 4 * lane;
        const u32x2 w = *(const u32x2*)p; f32x4 v = (f32x4){bflo(w.x), bfhi(w.x), bflo(w.y), bfhi(w.y)};
        const float rs = rsqrtf(wave_sum(v.x * v.x + v.y * v.y + v.z * v.z + v.w * v.w) * (1.f / 256.f) + EPS);
        const f32x4 g = *(const f32x4*)(gk + 4 * lane); const f32x4 g2 = *(const f32x4*)(gq + 4 * lane); v = v * rs * g * g2 * 0.0625f;
        u32x2 o; o.x = pk2(v.x, v.y); o.y = pk2(v.z, v.w); *(u32x2*)p = o; }
}
constexpr int CX_RS = 528;
__device__ __forceinline__ void cross_lds(bf16_t* XQ, const bf16_t* MK, const bf16_t* MVT, LAS unsigned char* lds) {
    int tid_ = threadIdx.x; asm volatile("" : "+v"(tid_));
    const int tid = tid_, lane = tid & 63, w = tid >> 6, fr = lane & 15, fq = lane >> 4;
    for (int un = blockIdx.x; un < (T / 128) * 4; un += gridDim.x) {
        const int h = un & 3, t0 = (un >> 2) * 128, b = t0 >> 12;
        { const bf16_t* src = MK + (size_t)(b * NMEM) * D + h * 256 + (size_t)(tid >> 5) * D + (tid & 31) * 8; LAS unsigned char* dst = lds + (tid >> 5) * CX_RS + (tid & 31) * 16;
#pragma unroll 1
          for (int i0 = 0; i0 < 16; i0 += 8) { u32x4 tmp[8];
#pragma unroll
              for (int i = 0; i < 8; ++i) tmp[i] = *(const u32x4*)(src + (size_t)(16 * (i0 + i)) * D);
#pragma unroll
              for (int i = 0; i < 8; ++i) *(LAS u32x4*)(dst + 16 * (i0 + i) * CX_RS) = tmp[i]; } }
        asm volatile("" ::: "memory");
        bf16_t* qrow = XQ + (size_t)(t0 + 16 * w + fr) * D + h * 256;
        bf16x8 qf[8]; float ss = 0.f;
#pragma unroll
        for (int s_ = 0; s_ < 8; ++s_) { const u32x4 wq = *(const u32x4*)(qrow + 32 * s_ + 8 * fq); qf[s_] = __builtin_bit_cast(bf16x8, wq);
            ss += bflo(wq.x) * bflo(wq.x) + bfhi(wq.x) * bfhi(wq.x) + bflo(wq.y) * bflo(wq.y) + bfhi(wq.y) * bfhi(wq.y) + bflo(wq.z) * bflo(wq.z) + bfhi(wq.z) * bfhi(wq.z) + bflo(wq.w) * bflo(wq.w) + bfhi(wq.w) * bfhi(wq.w); }
        ss += __shfl_xor(ss, 16); ss += __shfl_xor(ss, 32);
        const float rs = rsqrtf(ss * (1.f / 256.f) + EPS);
        __syncthreads();
        f32x4 X[16];
#pragma unroll
        for (int kt = 0; kt < 16; ++kt) { X[kt] = (f32x4){0.f, 0.f, 0.f, 0.f};
#pragma unroll
            for (int s_ = 0; s_ < 8; ++s_) { const bf16x8 kf = *(LAS bf16x8*)(lds + (16 * kt + fr) * CX_RS + (32 * s_ + 8 * fq) * 2); X[kt] = __builtin_amdgcn_mfma_f32_16x16x32_bf16(kf, qf[s_], X[kt], 0, 0, 0); }
            asm volatile("" : "+v"(X[kt]) : : "memory"); }
        __syncthreads();
        asm volatile("" ::: "memory");
        { const bf16_t* src = MVT + (size_t)(h * 256) * TMEM + b * NMEM + (size_t)(tid >> 5) * TMEM + (tid & 31) * 8; LAS unsigned char* dst = lds + (tid >> 5) * CX_RS + (tid & 31) * 16;
#pragma unroll 1
          for (int i0 = 0; i0 < 16; i0 += 8) { u32x4 tmp[8];
#pragma unroll
              for (int i = 0; i < 8; ++i) tmp[i] = *(const u32x4*)(src + (size_t)(16 * (i0 + i)) * TMEM);
#pragma unroll
              for (int i = 0; i < 8; ++i) *(LAS u32x4*)(dst + 16 * (i0 + i) * CX_RS) = tmp[i]; } }
        asm volatile("" ::: "memory");
        float mx = -3.0e38f;
#pragma unroll
        for (int kt = 0; kt < 16; ++kt) { X[kt] = X[kt] * rs; mx = fmaxf(mx, fmaxf(fmaxf(X[kt].x, X[kt].y), fmaxf(X[kt].z, X[kt].w))); }
        mx = fmaxf(mx, __shfl_xor(mx, 16)); mx = fmaxf(mx, __shfl_xor(mx, 32));
        float sum = 0.f;
#pragma unroll
        for (int kt = 0; kt < 16; ++kt) { X[kt].x = __expf(X[kt].x - mx); X[kt].y = __expf(X[kt].y - mx); X[kt].z = __expf(X[kt].z - mx); X[kt].w = __expf(X[kt].w - mx); sum += (X[kt].x + X[kt].y) + (X[kt].z + X[kt].w); }
        sum += __shfl_xor(sum, 16); sum += __shfl_xor(sum, 32);
        const float inv = 1.f / sum;
        bf16x8 pf[8];
#pragma unroll
        for (int kp = 0; kp < 8; ++kp) { u32x4 wp; wp.x = pk2(X[2 * kp].x, X[2 * kp].y); wp.y = pk2(X[2 * kp].z, X[2 * kp].w); wp.z = pk2(X[2 * kp + 1].x, X[2 * kp + 1].y); wp.w = pk2(X[2 * kp + 1].z, X[2 * kp + 1].w); pf[kp] = __builtin_bit_cast(bf16x8, wp); }
        __syncthreads();
#pragma unroll 2
        for (int dt = 0; dt < 16; ++dt) { f32x4 Y = (f32x4){0.f, 0.f, 0.f, 0.f};
#pragma unroll
            for (int kp = 0; kp < 8; ++kp) { LAS unsigned char* vp = lds + (16 * dt + fr) * CX_RS + (32 * kp + 4 * fq) * 2; const u32x2 lo = *(LAS u32x2*)vp, hi = *(LAS u32x2*)(vp + 32);
                u32x4 wv; wv.x = lo.x; wv.y = lo.y; wv.z = hi.x; wv.w = hi.y; Y = __builtin_amdgcn_mfma_f32_16x16x32_bf16(__builtin_bit_cast(bf16x8, wv), pf[kp], Y, 0, 0, 0); }
            Y = Y * inv; u32x2 o; o.x = pk2(Y.x, Y.y); o.y = pk2(Y.z, Y.w); *(u32x2*)(qrow + 16 * dt + 4 * fq) = o; }
        __syncthreads();
    }
}
__device__ __forceinline__ void ml_finalize(const bf16_t* HUN, const bf16_t* MO, const float* g, bf16_t* Y, int gw, int NGW, int lane) {
    const f32x4 g0 = *(const f32x4*)(g + 4 * lane), g1 = *(const f32x4*)(g + 256 + 4 * lane), g2 = *(const f32x4*)(g + 512 + 4 * lane), g3 = *(const f32x4*)(g + 768 + 4 * lane);
    u32x2 hw[4], ow[4];
#pragma unroll
    for (int i = 0; i < 4; ++i) { const size_t off = (size_t)gw * D + i * 256 + 4 * lane; hw[i] = *(const u32x2*)(HUN + off); ow[i] = *(const u32x2*)(MO + off); }
    for (int t = gw; t < T; t += NGW) {
        const int tn = (t + NGW < T) ? t + NGW : t; u32x2 nh[4], no[4];
#pragma unroll
        for (int i = 0; i < 4; ++i) { const size_t off = (size_t)tn * D + i * 256 + 4 * lane; nh[i] = *(const u32x2*)(HUN + off); no[i] = *(const u32x2*)(MO + off); }
        float ssv[4]; f32x4 v[4];
#pragma unroll
        for (int i = 0; i < 4; ++i) { v[i] = (f32x4){bflo(hw[i].x), bfhi(hw[i].x), bflo(hw[i].y), bfhi(hw[i].y)}; ssv[i] = (v[i].x * v[i].x + v[i].y * v[i].y) + (v[i].z * v[i].z + v[i].w * v[i].w); }
#pragma unroll
        for (int i = 0; i < 4; ++i) ssv[i] = row16_sum(ssv[i]);
#pragma unroll
        for (int i = 0; i < 4; ++i) ssv[i] += __shfl_xor(ssv[i], 16);
#pragma unroll
        for (int i = 0; i < 4; ++i) ssv[i] += __shfl_xor(ssv[i], 32);
#pragma unroll
        for (int i = 0; i < 4; ++i) { const size_t off = (size_t)t * D + i * 256 + 4 * lane; const float rs = rsqrtf(ssv[i] * (1.f / 256.f) + EPS);
            const f32x4 gg = i == 0 ? g0 : (i == 1 ? g1 : (i == 2 ? g2 : g3));
            f32x4 r = v[i] * rs * gg; r.x *= sigmoidf_(bflo(ow[i].x)); r.y *= sigmoidf_(bfhi(ow[i].x)); r.z *= sigmoidf_(bflo(ow[i].y)); r.w *= sigmoidf_(bfhi(ow[i].y));
            u32x2 o; o.x = pk2(r.x, r.y); o.y = pk2(r.z, r.w); *(u32x2*)(Y + off) = o; }
#pragma unroll
        for (int i = 0; i < 4; ++i) { hw[i] = nh[i]; ow[i] = no[i]; }
    }
}

__global__ void __launch_bounds__(NTHREADS) fwd_megakernel(Params p) {
    extern __shared__ __attribute__((aligned(16))) unsigned char lds[];
    cg::grid_group grid = cg::this_grid();
#define LANE() ({ int l_ = threadIdx.x & 63; asm volatile("" : "+v"(l_)); l_; })
    int tid0_ = threadIdx.x; asm volatile("" : "+v"(tid0_));
    const int tid = tid0_, wave = __builtin_amdgcn_readfirstlane(threadIdx.x >> 6);
    const int gw = blockIdx.x * NWAVES + wave, NGW = gridDim.x * NWAVES;
    unsigned char* ws = p.ws; unsigned char* dob = (unsigned char*)p.out;
    const float* x = p.in[0]; const float* mem = p.in[1]; const float* g_mix = p.in[2]; const float* w_in = p.in[3]; const float* b_if = p.in[4]; const float* b_gate = p.in[5];
    const float* conv_w = p.in[6]; const float* conv_b = p.in[7]; const float* ml_norm_g = p.in[8]; const float* g_mem = p.in[9]; const float* w_mem_kv = p.in[10];
    const float* q_norm_g = p.in[11]; const float* k_norm_g = p.in[12]; const float* w_sb = p.in[13]; const float* w_ml = p.in[14]; const float* w_x = p.in[15]; const float* w_out = p.in[16];
    const float* g_mlp = p.in[17]; const float* w_ff1 = p.in[18]; const float* w_ff2 = p.in[19];
    bf16_t* Wt_in = (bf16_t*)(ws + WS_WIN); bf16_t* Wt_mkv = (bf16_t*)(ws + WS_WMKV); bf16_t* Wt_sb = (bf16_t*)(ws + WS_WSB); bf16_t* Wt_ml = (bf16_t*)(ws + WS_WML);
    bf16_t* Wt_x = (bf16_t*)(ws + WS_WX); bf16_t* Wt_out = (bf16_t*)(ws + WS_WOUT); bf16_t* Wt_ff1 = (bf16_t*)(ws + WS_WFF1); bf16_t* Wt_ff2 = (bf16_t*)(ws + WS_WFF2);
    float* ifp = (float*)(ws + WS_IF);
#define SLOT(i) ((bf16_t*)(ws + WS_SLOT0 + (size_t)(i) * SLOT_BYTES))
    bf16_t* memn = (bf16_t*)(dob + DO_MEMN); bf16_t* memk = (bf16_t*)(dob + DO_MEMK); bf16_t* memvt = (bf16_t*)(dob + DO_MEMVT); bf16_t* hun = (bf16_t*)(dob + DO_HUN);

    unsigned long long probe_t0 = 0, probe_dur = 0;
    PROBE_BEGIN(3);
    float* wscr = (float*)(lds + wave * 8448);
    float* wif = (float*)(lds + 69632);
    float* ssq = (float*)(ws + WS_SSQ);
    for (int i = tid; i < 8192; i += NTHREADS) { const int e = i >> 10, k = i & 1023; wif[i] = w_in[(size_t)k * NIN + IF_COL + e]; }
    for (int i = blockIdx.x * NTHREADS + tid; i < T; i += gridDim.x * NTHREADS) ssq[i] = 0.f;
    __syncthreads();
    transpose_matrix(w_in, NIN, D, 2048, Wt_in, wscr, gw, NGW, LANE());
    transpose_matrix(w_in + 3072, NIN, D, 2048, Wt_in + (size_t)2048 * D, wscr, gw, NGW, LANE());
    transpose_matrix(w_in + 2048, NIN, D, 1024, Wt_in + (size_t)4096 * D, wscr, gw, NGW, LANE());
    transpose_matrix(w_in + 5120, NIN, D, 2048, Wt_in + (size_t)5120 * D, wscr, gw, NGW, LANE());
    transpose_matrix(w_in + 7176, NIN, D, 4096, Wt_in + (size_t)7168 * D, wscr, gw, NGW, LANE());
    transpose_matrix(w_mem_kv, 2048, D, 2048, Wt_mkv, wscr, gw, NGW, LANE());
    transpose_matrix(w_sb, D, D, D, Wt_sb, wscr, gw, NGW, LANE());
    transpose_matrix(w_ml, D, D, D, Wt_ml, wscr, gw, NGW, LANE());
    transpose_matrix(w_x, D, D, D, Wt_x, wscr, gw, NGW, LANE());
    transpose_matrix(w_out, D, D, D, Wt_out, wscr, gw, NGW, LANE());
    transpose_matrix(w_ff1, FF, D, FF, Wt_ff1, wscr, gw, NGW, LANE(), g_mlp);
    transpose_matrix(w_ff2, D, FF, D, Wt_ff2, wscr, gw, NGW, LANE());
    { const int lane = LANE(); f32x4 cur[4];
      f32x4 gv[4]; float bif[8];
#pragma unroll
      for (int j = 0; j < 4; ++j) gv[j] = ((const f32x4*)g_mix + lane)[64 * j];
#pragma unroll
      for (int e = 0; e < 8; ++e) bif[e] = b_if[e];
#pragma unroll
      for (int j = 0; j < 4; ++j) cur[j] = ((const f32x4*)(x + (size_t)gw * D) + lane)[64 * j];
      for (int m = gw; m < T; m += NGW) { f32x4 nxt[4]; const int mn = (m + NGW < T) ? m + NGW : m;
#pragma unroll
          for (int j = 0; j < 4; ++j) nxt[j] = ((const f32x4*)(x + (size_t)mn * D) + lane)[64 * j];
          rms_row_regs(cur, gv, SLOT(0) + (size_t)m * D, wif, bif, ifp + (size_t)m * 8, lane);
#pragma unroll
          for (int j = 0; j < 4; ++j) cur[j] = nxt[j]; } }
    for (int m = gw; m < TMEM; m += NGW) rms_row<false>(mem + (size_t)m * D, g_mem, memn + (size_t)m * D, nullptr, nullptr, nullptr, LANE());
    PROBE_END(3);
    grid.sync();

    PROBE_BEGIN(7);
    { const bf16_t* hN = SLOT(0);
      gemm_fast8(lds, hN, Wt_in, T, 4096, D, EpiSeg4{SLOT(0), (bf16_t*)(ws + WS_HALOQ)});
      gemm_fast8(lds, Wt_in + (size_t)4096 * D, hN, 2048, T, D, EpiVT2{SLOT(0)});
      gemm_simple(memn, Wt_mkv, TMEM, 1024, D, 0, EpiBf16{memk, D});
      gemm_simple(Wt_mkv + (size_t)1024 * D, memn, 1024, TMEM, D, 128, EpiBf16{memvt, TMEM}); }
    PROBE_END(7);
    grid.sync();

    PROBE_BEGIN(4);
    memk_norm(memk, k_norm_g, q_norm_g, gw, NGW, LANE());
    conv_pass(SLOT(4), SLOT(5), (const bf16_t*)(ws + WS_HALOQ), (const bf16_t*)(ws + WS_HALOK), conv_w, conv_b, gw, NGW, LANE());
    PROBE_END(4);
    PROBE_BEGIN(1);
    gate_pass(ifp, (float*)(ws + WS_GATE), (float*)(ws + WS_GATE) + 32 * SEQ, (float*)(ws + WS_GATE) + 64 * SEQ, gw, NGW, LANE());
    sb_fast(SLOT(1), SLOT(2), SLOT(3), (LAS unsigned char*)lds);
    PROBE_END(1);
    grid.sync();

    PROBE_BEGIN(2);
    mlstm_fast(SLOT(4), SLOT(5), SLOT(6), (const float*)(ws + WS_GATE), (const float*)(ws + WS_GATE) + 32 * SEQ, (const float*)(ws + WS_GATE) + 64 * SEQ, hun, (LAS unsigned char*)lds);
    PROBE_END(2);
    __syncthreads();
    PROBE_BEGIN(8);
    gemm_fast8(lds, SLOT(0), Wt_in + (size_t)6144 * D, T, 2048, D, EpiSeg2{SLOT(0)});
    PROBE_END(8);
    grid.sync();

    PROBE_BEGIN(5);
    cross_lds(SLOT(2), memk, memvt, (LAS unsigned char*)lds);
    PROBE_END(5);
    PROBE_BEGIN(6);
    ml_finalize(hun, SLOT(3), ml_norm_g, SLOT(4), gw, NGW, LANE());
    PROBE_END(6);
    grid.sync();

    PROBE_BEGIN(9);
    { pg8::Gemm g{SLOT(0), Wt_in + (size_t)8192 * D, T, D, D}; GateMixOrder S; S.so.init(T, D, (int)gridDim.x, (int)blockIdx.x); EpiGateMix E{SLOT(0), b_gate};
      pg8::gemm_phase<EpiGateMix, GateMixOrder, true, true>((PG8_LAS unsigned char*)lds, g, S, E); }
    PROBE_END(9);
    grid.sync();

    PROBE_BEGIN(11);
    { pg8::Gemm g{SLOT(3), Wt_out, T, D, D}; pg8::StaticOrder S; S.init(T, D, (int)gridDim.x, (int)blockIdx.x); EpiResidSS E{x, p.out, SLOT(1), ssq};
      pg8::gemm_phase<EpiResidSS, pg8::StaticOrder, true, true>((PG8_LAS unsigned char*)lds, g, S, E); }
    PROBE_END(11);
    grid.sync();

    PROBE_BEGIN(12);
    gemm_fast8(lds, SLOT(1), Wt_ff1, T, FF, D, EpiRelu2RS{SLOT(2), FF, ssq});
    PROBE_END(12);
    grid.sync();

    PROBE_BEGIN(13);
    { pg8::Gemm g{SLOT(2), Wt_ff2, T, D, FF}; pg8::StaticOrder S; S.init(T, D, (int)gridDim.x, (int)blockIdx.x); EpiResidIn E{SLOT(1), p.out};
      pg8::gemm_phase<EpiResidIn, pg8::StaticOrder, true, true>((PG8_LAS unsigned char*)lds, g, S, E); }
    PROBE_END(13);
    if (PROBE_PHASE != 0) { const unsigned long long te = __builtin_amdgcn_s_memrealtime(); while (__builtin_amdgcn_s_memrealtime() - te < probe_dur) __builtin_amdgcn_s_sleep(8); }
}

extern "C" void kernel_launch(void* const* d_in, const int* in_sizes, int n_in, void* d_out, int out_size, void* d_ws, size_t ws_size, hipStream_t stream) {
    static int grid_blocks = 0;
    if (grid_blocks == 0) {
        if (n_in != 20 || out_size != T * D || ws_size < WS_NEED) { fprintf(stderr, "kernel_launch: unexpected shapes (n_in %d out %d ws %zu)\n", n_in, out_size, ws_size); grid_blocks = -1; return; }
        int dev = 0, cus = 0, per_cu = 0;
        hipGetDevice(&dev);
        hipDeviceGetAttribute(&cus, hipDeviceAttributeMultiprocessorCount, dev);
        hipFuncSetAttribute((const void*)fwd_megakernel, hipFuncAttributeMaxDynamicSharedMemorySize, LDS_BYTES);
        hipOccupancyMaxActiveBlocksPerMultiprocessor(&per_cu, (const void*)fwd_megakernel, NTHREADS, LDS_BYTES);
        if (per_cu < 1) per_cu = 1;
        grid_blocks = cus * per_cu;
    }
    if (grid_blocks < 0) return;
    Params p{};
    for (int i = 0; i < 20; ++i) p.in[i] = (const float*)d_in[i];
    p.out = (float*)d_out; p.ws = (unsigned char*)d_ws;
    void* args[] = {&p};
    hipError_t e = hipLaunchCooperativeKernel((const void*)fwd_megakernel, dim3(grid_blocks), dim3(NTHREADS), args, LDS_BYTES, stream);
    if (e != hipSuccess) fprintf(stderr, "cooperative launch failed: %s (grid %d)\n", hipGetErrorString(e), grid_blocks);
}
```

```cpp
#include <hip/hip_runtime.h>
#include <hip/hip_cooperative_groups.h>
#include <cstdint>
#include <cstdio>
namespace cg = cooperative_groups;

typedef unsigned short bf16_t;
typedef short bf16x8 __attribute__((ext_vector_type(8)));
typedef float f32x4 __attribute__((ext_vector_type(4)));
typedef unsigned u32x2 __attribute__((ext_vector_type(2)));
typedef unsigned u32x4 __attribute__((ext_vector_type(4)));

constexpr int D = 1024, BATCH = 8, SEQ = 4096, T = BATCH * SEQ, NMEM = 256, TMEM = BATCH * NMEM, FF = 4096;
constexpr int NIN = 11272;
constexpr int IF_COL = 7168;
constexpr float EPS = 1e-6f;
constexpr int NTHREADS = 512, NWAVES = 8;
constexpr int LDS_BYTES = 144 * 1024;
#ifndef PROBE_PHASE
#define PROBE_PHASE 0
#endif
#define PROBE_BEGIN(k) do { if (PROBE_PHASE & (1 << (k))) probe_t0 = __builtin_amdgcn_s_memrealtime(); } while (0)
#define PROBE_END(k) do { if (PROBE_PHASE & (1 << (k))) probe_dur += __builtin_amdgcn_s_memrealtime() - probe_t0; } while (0)

constexpr size_t MiB = (size_t)1 << 20;
constexpr size_t WS_WIN = 0;
constexpr size_t WS_WMKV = 22 * MiB;
constexpr size_t WS_WSB = 26 * MiB, WS_WML = 28 * MiB, WS_WX = 30 * MiB, WS_WOUT = 32 * MiB;
constexpr size_t WS_WFF1 = 34 * MiB;
constexpr size_t WS_WFF2 = 42 * MiB;
constexpr size_t WS_IF = 50 * MiB;
constexpr size_t WS_GATE = 58 * MiB;
constexpr size_t WS_SSQ = 57 * MiB;
constexpr size_t WS_HALOQ = 51 * MiB, WS_HALOK = 54 * MiB;
constexpr size_t WS_SLOT0 = 64 * MiB, SLOT_BYTES = 64 * MiB;
constexpr size_t WS_NEED = WS_SLOT0 + 7 * SLOT_BYTES;
constexpr size_t DO_MEMN = 0;
constexpr size_t DO_MEMK = 4 * MiB;
constexpr size_t DO_MEMVT = 8 * MiB;
constexpr size_t DO_HUN = 64 * MiB;

struct Params { const float* in[20]; float* out; unsigned char* ws; };

__device__ __forceinline__ unsigned f2bf(float f) { unsigned u = __builtin_bit_cast(unsigned, f); return (u + 0x7fffu + ((u >> 16) & 1u)) >> 16; }
typedef float f32x2_t __attribute__((ext_vector_type(2))); typedef __bf16 bf16x2_t __attribute__((ext_vector_type(2)));
__device__ __forceinline__ unsigned pk2(float lo, float hi) { f32x2_t v = {lo, hi}; bf16x2_t b = __builtin_convertvector(v, bf16x2_t); return __builtin_bit_cast(unsigned, b); }
__device__ __forceinline__ float bf2f(bf16_t v) { return __builtin_bit_cast(float, (unsigned)v << 16); }
__device__ __forceinline__ float bflo(unsigned w) { return __builtin_bit_cast(float, w << 16); }
__device__ __forceinline__ float bfhi(unsigned w) { return __builtin_bit_cast(float, w & 0xffff0000u); }
__device__ __forceinline__ float row16_sum(float v) {
    v += __builtin_bit_cast(float, __builtin_amdgcn_update_dpp(0, __builtin_bit_cast(int, v), 0xB1, 0xF, 0xF, true));
    v += __builtin_bit_cast(float, __builtin_amdgcn_update_dpp(0, __builtin_bit_cast(int, v), 0x4E, 0xF, 0xF, true));
    v += __builtin_bit_cast(float, __builtin_amdgcn_update_dpp(0, __builtin_bit_cast(int, v), 0x141, 0xF, 0xF, true));
    v += __builtin_bit_cast(float, __builtin_amdgcn_update_dpp(0, __builtin_bit_cast(int, v), 0x140, 0xF, 0xF, true));
    return v;
}
__device__ __forceinline__ float wave_sum(float v) { v = row16_sum(v); v += __shfl_xor(v, 16); v += __shfl_xor(v, 32); return v; }
__device__ __forceinline__ float wave_max(float v) {
#pragma unroll
    for (int o = 1; o < 64; o <<= 1) v = fmaxf(v, __shfl_xor(v, o));
    return v;
}
__device__ __forceinline__ float sigmoidf_(float x) { return __builtin_amdgcn_rcpf(1.f + __builtin_amdgcn_exp2f(x * -1.4426950408889634f)); }
#define LDS_WAIT() asm volatile("s_waitcnt lgkmcnt(0)" ::: "memory")
#define LDS_BARRIER() do { asm volatile("s_waitcnt lgkmcnt(0)" ::: "memory"); __builtin_amdgcn_s_barrier(); asm volatile("" ::: "memory"); } while (0)

__device__ __forceinline__ void transpose_item(const float* W, int ldw, int K, bf16_t* WT, int k0, int n0, float* scr, int lane, const float* kscale, float cs = 1.f) {
#pragma unroll 8
    for (int i = 0; i < 32; ++i) { const int kk = 2 * i + (lane >> 5); float v = W[(size_t)(k0 + kk) * ldw + n0 + (lane & 31)] * cs; if (kscale) v *= kscale[k0 + kk]; scr[kk * 33 + (lane & 31)] = v; }
    LDS_WAIT();
    const int c = lane & 7;
#pragma unroll
    for (int j = 0; j < 4; ++j) { const int n = (lane >> 3) + 8 * j; const float* s = scr + (8 * c) * 33 + n;
        u32x4 o; o.x = pk2(s[0 * 33], s[1 * 33]); o.y = pk2(s[2 * 33], s[3 * 33]); o.z = pk2(s[4 * 33], s[5 * 33]); o.w = pk2(s[6 * 33], s[7 * 33]);
        *(u32x4*)(WT + (size_t)(n0 + n) * K + k0 + 8 * c) = o; }
    LDS_WAIT();
}
constexpr float SB_QSCALE = -0.08838834764831845f * 1.4426950408889634f;
__device__ __forceinline__ void transpose_matrix(const float* W, int ldw, int K, int N, bf16_t* WT, float* scr, int gw, int NGW, int lane, const float* kscale = nullptr, bool sbq = false) {
    const int nblk = N / 32, items = (K / 64) * nblk;
    for (int it = gw; it < items; it += NGW) { const int kb = it / nblk, nb = it % nblk; transpose_item(W, ldw, K, WT, 64 * kb, 32 * nb, scr, lane, kscale, (sbq && nb < 32) ? SB_QSCALE : 1.f); }
}

template <bool WITH_IF>
__device__ __forceinline__ void rms_row(const float* xrow, const float* g, bf16_t* orow, const float* wif  , const float* b_if, float* ifout, int lane) {
    const f32x4* xr = (const f32x4*)xrow + lane; const f32x4* gr = (const f32x4*)g + lane;
    f32x4 v[4]; float s = 0.f;
#pragma unroll
    for (int j = 0; j < 4; ++j) { v[j] = xr[64 * j]; s += (v[j].x * v[j].x + v[j].y * v[j].y) + (v[j].z * v[j].z + v[j].w * v[j].w); }
    const float r = rsqrtf(wave_sum(s) * (1.f / D) + EPS);
#pragma unroll
    for (int j = 0; j < 4; ++j) v[j] = v[j] * r * gr[64 * j];
    u32x2* o8 = (u32x2*)orow + lane;
#pragma unroll
    for (int j = 0; j < 4; ++j) { u32x2 w; w.x = pk2(v[j].x, v[j].y); w.y = pk2(v[j].z, v[j].w); o8[64 * j] = w; }
    if (WITH_IF) {
        float a[8];
#pragma unroll
        for (int e = 0; e < 8; ++e) { a[e] = 0.f;
#pragma unroll
            for (int j = 0; j < 4; ++j) { const f32x4 w = *(const f32x4*)(wif + e * 1024 + 256 * j + 4 * lane); a[e] += (v[j].x * w.x + v[j].y * w.y) + (v[j].z * w.z + v[j].w * w.w); }
            a[e] = wave_sum(a[e]); }
        if (lane == 0) {
#pragma unroll
            for (int e = 0; e < 8; ++e) ifout[e] = a[e] + b_if[e]; }
    }
}

__device__ __forceinline__ void rms_row_regs(const f32x4 (&vin)[4], const f32x4 (&gv)[4], bf16_t* orow, const float* wif  , const float (&bif)[8], float* ifout, int lane) {
    f32x4 v[4]; float s = 0.f;
#pragma unroll
    for (int j = 0; j < 4; ++j) { v[j] = vin[j]; s += (v[j].x * v[j].x + v[j].y * v[j].y) + (v[j].z * v[j].z + v[j].w * v[j].w); }
    const float r = rsqrtf(wave_sum(s) * (1.f / D) + EPS);
#pragma unroll
    for (int j = 0; j < 4; ++j) v[j] = v[j] * r * gv[j];
    u32x2* o8 = (u32x2*)orow + lane;
#pragma unroll
    for (int j = 0; j < 4; ++j) { u32x2 w; w.x = pk2(v[j].x, v[j].y); w.y = pk2(v[j].z, v[j].w); o8[64 * j] = w; }
    float a[8];
#pragma unroll
    for (int e = 0; e < 8; ++e) { a[e] = 0.f;
#pragma unroll
        for (int j = 0; j < 4; ++j) { const f32x4 w = *(const f32x4*)(wif + e * 1024 + 256 * j + 4 * lane); a[e] += (v[j].x * w.x + v[j].y * w.y) + (v[j].z * w.z + v[j].w * w.w); } }
#pragma unroll
    for (int e = 0; e < 8; ++e) a[e] = row16_sum(a[e]);
#pragma unroll
    for (int e = 0; e < 8; ++e) a[e] += __shfl_xor(a[e], 16);
#pragma unroll
    for (int e = 0; e < 8; ++e) a[e] += __shfl_xor(a[e], 32);
    if (lane == 0) { f32x4 o0 = (f32x4){a[0] + bif[0], a[1] + bif[1], a[2] + bif[2], a[3] + bif[3]}, o1 = (f32x4){a[4] + bif[4], a[5] + bif[5], a[6] + bif[6], a[7] + bif[7]}; *(f32x4*)ifout = o0; *(f32x4*)(ifout + 4) = o1; }
}

namespace pg8 {
#define PG8_LAS __attribute__((address_space(3)))
typedef unsigned short bf16_t;
typedef short bf16x8 __attribute__((ext_vector_type(8)));
typedef float f32x4 __attribute__((ext_vector_type(4)));
typedef unsigned u32x4 __attribute__((ext_vector_type(4)));
constexpr int BM = 256, BK = 64, HALF = 128, HTB = HALF * BK * 2  , STAGE_BYTES = 8 * HTB, NXCD = 8, WGM = 8;

__host__ __device__ __forceinline__ int lds_byte(int r, int c) { const int st = (r >> 4) * 2 + (c >> 5), rr = r & 15, cc = c & 31, ob = rr * 64 + cc * 2; return st * 1024 + (ob ^ (((ob >> 9) & 1) << 5)); }
__host__ __device__ __forceinline__ void stage_rc(int b, int& R, int& C) { const int st = b / 1024, sb = b % 1024, swz = sb ^ (((sb >> 9) & 1) << 5); R = (st >> 1) * 16 + swz / 64; C = (st & 1) * 32 + (swz % 64) / 2; }
__host__ __device__ __forceinline__ int perm32(int rho) { const int n = rho >> 4, i = rho & 15; return 8 * (i >> 2) + 4 * n + (i & 3); }

struct Unit { int pm, pn; };
struct Gemm { const bf16_t* A; const bf16_t* Bt; int M, N, K; };

struct StaticOrder {
    int nM, nN, nwg, G, c;
    __host__ __device__ void init(int M, int N, int G_, int c_) { nM = M / BM; nN = N / BM; nwg = nM * nN; G = G_; c = c_; }
    __host__ __device__ bool next(int i, Unit& u) const {
        const long L = (long)i * G + c; if (L >= nwg) return false;
        int wgid = (int)L; { const int q = nwg / NXCD, r = nwg % NXCD, xcd = wgid % NXCD, off = wgid / NXCD; wgid = (xcd < r ? xcd * (q + 1) : r * (q + 1) + (xcd - r) * q) + off; }
        const int nig = WGM * nN, gid = wgid / nig, fm = gid * WGM, gsz = (nM - fm) < WGM ? (nM - fm) : WGM;
        u.pm = fm + ((wgid % nig) % gsz); u.pn = (wgid % nig) / gsz; return true;
    }
    __device__ __forceinline__ void a_ready(const Unit&) const {}
    __device__ __forceinline__ void done(const Unit&) const {}
};
template <class Epi, class Sched, bool ALIGN_EPI = false, bool SP2 = false>
__device__ __forceinline__ void gemm_phase(PG8_LAS unsigned char* lds, const Gemm g, const Sched& S, const Epi& E) {
    int tid_ = threadIdx.x; asm volatile("" : "+v"(tid_));
    const int tid = tid_, wid = __builtin_amdgcn_readfirstlane(tid >> 6), lane = tid & 63, wr = wid >> 2, wc = wid & 3, fr = lane & 15, fq = lane >> 4;
    const int K = g.K, nt = K / BK;
    unsigned voffA[2], voffB[2];
#pragma unroll
    for (int i = 0; i < 2; ++i) { int R, C; stage_rc(tid * 16 + i * 8192, R, C); const int Rb = Epi::PERM ? ((R & ~31) + perm32(R & 31)) : R;
        voffA[i] = (unsigned)(R * K + C) * 2u; voffB[i] = (unsigned)(Rb * K + C) * 2u; }
    const size_t kstep = (size_t)(BK * 2);
    const size_t hstep = (size_t)HALF * K * 2;
    const size_t tstep = 2 * hstep;
    const unsigned ldsw = (unsigned)wid * 1024u;
    const int aoff = lds_byte(wr * 64 + fr, fq * 8), boff = lds_byte(wc * 32 + fr, fq * 8);
#define PG8_SA(b, h) (((b) * 2 + (h)) * HTB)
#define PG8_SB(b, h) ((4 + (b) * 2 + (h)) * HTB)
#define PG8_STAGE(bufoff, gbase, voff) do { _Pragma("unroll") for (int _i = 0; _i < 2; ++_i) \
        __builtin_amdgcn_global_load_lds((const unsigned*)((const char*)(gbase) + (voff)[_i]), (PG8_LAS unsigned*)(lds + (bufoff) + ldsw + _i * 8192), 16, 0, 0); } while (0)
#define PG8_LDA(dst, b, h) do { _Pragma("unroll") for (int m = 0; m < 4; ++m) _Pragma("unroll") for (int k = 0; k < 2; ++k) dst[m][k] = *(const PG8_LAS bf16x8*)(lds + PG8_SA(b, h) + aoff + m * 2048 + k * 1024); } while (0)
#define PG8_LDB(dst, b, h) do { _Pragma("unroll") for (int n = 0; n < 2; ++n) _Pragma("unroll") for (int k = 0; k < 2; ++k) dst[n][k] = *(const PG8_LAS bf16x8*)(lds + PG8_SB(b, h) + boff + n * 2048 + k * 1024); } while (0)
#define PG8_MMA(ai, bj, At, Bt) do { __builtin_amdgcn_s_setprio(1); _Pragma("unroll") for (int m = 0; m < 4; ++m) _Pragma("unroll") for (int n = 0; n < 2; ++n) _Pragma("unroll") for (int k = 0; k < 2; ++k) \
        acc[ai][bj][m][n] = __builtin_amdgcn_mfma_f32_16x16x32_bf16(Bt[n][k], At[m][k], acc[ai][bj][m][n], 0, 0, 0); __builtin_amdgcn_s_setprio(0); } while (0)
#define PG8_WAIT_V(n) asm volatile("s_waitcnt vmcnt(" #n ")" ::: "memory")
#define PG8_WAIT_L(n) asm volatile("s_waitcnt lgkmcnt(" #n ")" ::: "memory")
#define PG8_BAR __builtin_amdgcn_s_barrier()
#define PG8_SCHED __builtin_amdgcn_sched_barrier(0)
    Unit cur, nxt; int ui = 0;
    if (!S.next(0, cur)) return;
    f32x4 acc[2][2][4][2];
#pragma unroll
    for (int a = 0; a < 2; ++a)
#pragma unroll
        for (int b = 0; b < 2; ++b)
#pragma unroll
            for (int m = 0; m < 4; ++m)
#pragma unroll
                for (int n = 0; n < 2; ++n) acc[a][b][m][n] = (f32x4){0.f, 0.f, 0.f, 0.f};
    bf16x8 At[4][2], B0[2][2], B1[2][2];
    const char* cA = (const char*)g.A + (size_t)cur.pm * tstep; const char* cB = (const char*)g.Bt + (size_t)cur.pn * tstep;
    S.a_ready(cur);
    if constexpr (SP2) {
        PG8_STAGE(PG8_SB(0, 0), cB, voffB); PG8_STAGE(PG8_SB(0, 1), cB + hstep, voffB); PG8_STAGE(PG8_SA(0, 0), cA, voffA); PG8_STAGE(PG8_SA(0, 1), cA + hstep, voffA);
        if (wr == 1) PG8_BAR;
        PG8_WAIT_V(2); PG8_BAR;
        PG8_STAGE(PG8_SB(1, 0), cB + kstep, voffB); PG8_STAGE(PG8_SA(1, 0), cA + kstep, voffA); PG8_STAGE(PG8_SB(1, 1), cB + hstep + kstep, voffB);
        PG8_WAIT_V(6); PG8_BAR;
    } else {
        PG8_STAGE(PG8_SB(0, 0), cB, voffB); PG8_STAGE(PG8_SA(0, 0), cA, voffA); PG8_STAGE(PG8_SB(0, 1), cB + hstep, voffB); PG8_STAGE(PG8_SA(0, 1), cA + hstep, voffA);
        if (wr == 1) PG8_BAR;
        PG8_WAIT_V(4); PG8_BAR;
        PG8_STAGE(PG8_SB(1, 0), cB + kstep, voffB); PG8_STAGE(PG8_SA(1, 0), cA + kstep, voffA); PG8_STAGE(PG8_SB(1, 1), cB + hstep + kstep, voffB);
        PG8_WAIT_V(6); PG8_BAR;
    }
    for (;;) {
        const bool has_next = S.next(ui + 1, nxt);
        const char* nA = has_next ? (const char*)g.A + (size_t)nxt.pm * tstep : cA; const char* nB = has_next ? (const char*)g.Bt + (size_t)nxt.pn * tstep : cB;
        for (int t = 0; t < nt; t += 2) {
            const bool last = (t == nt - 2);
            const char* a1 = cA + (size_t)(t + 1) * kstep;
            const char* a2 = last ? nA : cA + (size_t)(t + 2) * kstep; const char* b2 = last ? nB : cB + (size_t)(t + 2) * kstep;
            const char* a3 = a2 + kstep; const char* b3 = b2 + kstep;
            if (last && has_next) S.a_ready(nxt);
            if constexpr (SP2) {
            PG8_LDB(B0, 0, 0); PG8_LDB(B1, 0, 1); PG8_SCHED; PG8_LDA(At, 0, 0); PG8_STAGE(PG8_SA(1, 1), a1 + hstep, voffA);
            PG8_WAIT_V(8); PG8_WAIT_L(0); PG8_BAR; PG8_MMA(0, 0, At, B0); PG8_MMA(0, 1, At, B1); PG8_BAR; PG8_SCHED;
            PG8_LDA(At, 0, 1); PG8_STAGE(PG8_SB(0, 0), b2, voffB); PG8_STAGE(PG8_SB(0, 1), b2 + hstep, voffB); PG8_STAGE(PG8_SA(0, 0), a2, voffA);
            PG8_WAIT_V(8); PG8_WAIT_L(0); PG8_BAR; PG8_MMA(1, 0, At, B0); PG8_MMA(1, 1, At, B1); PG8_BAR; PG8_SCHED;
            PG8_LDB(B0, 1, 0); PG8_LDB(B1, 1, 1); PG8_SCHED; PG8_LDA(At, 1, 0); PG8_STAGE(PG8_SA(0, 1), a2 + hstep, voffA);
            PG8_WAIT_V(8); PG8_WAIT_L(0); PG8_BAR; PG8_MMA(0, 0, At, B0); PG8_MMA(0, 1, At, B1); PG8_BAR; PG8_SCHED;
            PG8_LDA(At, 1, 1); PG8_STAGE(PG8_SB(1, 0), b3, voffB); PG8_STAGE(PG8_SB(1, 1), b3 + hstep, voffB); PG8_STAGE(PG8_SA(1, 0), a3, voffA);
            PG8_WAIT_V(8); PG8_WAIT_L(0); PG8_BAR; PG8_MMA(1, 0, At, B0); PG8_MMA(1, 1, At, B1); PG8_BAR; PG8_SCHED;
            } else {
            PG8_LDB(B0, 0, 0); PG8_SCHED; PG8_LDA(At, 0, 0); PG8_STAGE(PG8_SA(1, 1), a1 + hstep, voffA);
            PG8_WAIT_L(8); PG8_BAR; PG8_WAIT_L(0); PG8_MMA(0, 0, At, B0); PG8_BAR; PG8_SCHED;
            PG8_LDB(B1, 0, 1); PG8_STAGE(PG8_SB(0, 0), b2, voffB);
            PG8_BAR; PG8_WAIT_L(0); PG8_MMA(0, 1, At, B1); PG8_BAR;
            PG8_LDA(At, 0, 1); PG8_STAGE(PG8_SA(0, 0), a2, voffA);
            PG8_BAR; PG8_WAIT_L(0); PG8_MMA(1, 0, At, B0); PG8_BAR; PG8_SCHED;
            PG8_STAGE(PG8_SB(0, 1), b2 + hstep, voffB);
            PG8_WAIT_V(6); PG8_BAR; PG8_MMA(1, 1, At, B1); PG8_BAR;
            PG8_LDB(B0, 1, 0); PG8_SCHED; PG8_LDA(At, 1, 0); PG8_STAGE(PG8_SA(0, 1), a2 + hstep, voffA);
            PG8_WAIT_L(8); PG8_BAR; PG8_WAIT_L(0); PG8_MMA(0, 0, At, B0); PG8_BAR; PG8_SCHED;
            PG8_LDB(B1, 1, 1); PG8_STAGE(PG8_SB(1, 0), b3, voffB);
            PG8_BAR; PG8_WAIT_L(0); PG8_MMA(0, 1, At, B1); PG8_BAR;
            PG8_LDA(At, 1, 1); PG8_STAGE(PG8_SA(1, 0), a3, voffA);
            PG8_BAR; PG8_WAIT_L(0); PG8_MMA(1, 0, At, B0); PG8_BAR; PG8_SCHED;
            PG8_STAGE(PG8_SB(1, 1), b3 + hstep, voffB);
            PG8_WAIT_V(6); PG8_BAR; PG8_MMA(1, 1, At, B1); PG8_BAR;
            }
        }
        if constexpr (ALIGN_EPI) { if (wr == 0) PG8_BAR; }
        if constexpr (!Epi::AFTER_DRAIN) { E(acc, cur, wr, wc, fr, fq); S.done(cur); }
        if (!has_next) break;
#pragma unroll
        for (int a = 0; a < 2; ++a)
#pragma unroll
            for (int b = 0; b < 2; ++b)
#pragma unroll
                for (int m = 0; m < 4; ++m)
#pragma unroll
                    for (int n = 0; n < 2; ++n) acc[a][b][m][n] = (f32x4){0.f, 0.f, 0.f, 0.f};
        cur = nxt; cA = nA; cB = nB; ++ui;
        if constexpr (ALIGN_EPI) { if (wr == 1) PG8_BAR; }
    }
    PG8_WAIT_V(0);
    if constexpr (!ALIGN_EPI) { if (wr == 0) PG8_BAR; }
    PG8_BAR;
    if constexpr (Epi::AFTER_DRAIN) { E.fused(acc, cur, wr, wc, fr, fq, lds, wid, lane); S.done(cur); }
#undef PG8_SA
#undef PG8_SB
#undef PG8_STAGE
#undef PG8_LDA
#undef PG8_LDB
#undef PG8_MMA
#undef PG8_WAIT_V
#undef PG8_WAIT_L
#undef PG8_BAR
#undef PG8_SCHED
}
}

template <class EW> struct EpiAdapt { static constexpr bool PERM = false, AFTER_DRAIN = false; EW e;
    __device__ __forceinline__ void operator()(const f32x4 (&acc)[2][2][4][2], const pg8::Unit& u, int wr, int wc, int fr, int fq) const {
#pragma unroll
        for (int ai = 0; ai < 2; ++ai)
#pragma unroll
            for (int m = 0; m < 4; ++m) { const int row = u.pm * 256 + ai * 128 + wr * 64 + m * 16 + fr;
#pragma unroll
                for (int bj = 0; bj < 2; ++bj)
#pragma unroll
                    for (int n = 0; n < 2; ++n) e(row, u.pn * 256 + bj * 128 + wc * 32 + n * 16 + 4 * fq, acc[ai][bj][m][n]); } } };
template <class EW> struct EpiAdapt8 { static constexpr bool PERM = true, AFTER_DRAIN = false; EW e;
    __device__ __forceinline__ void operator()(const f32x4 (&acc)[2][2][4][2], const pg8::Unit& u, int wr, int wc, int fr, int fq) const {
#pragma unroll
        for (int ai = 0; ai < 2; ++ai)
#pragma unroll
            for (int m = 0; m < 4; ++m) { const int row = u.pm * 256 + ai * 128 + wr * 64 + m * 16 + fr;
#pragma unroll
                for (int bj = 0; bj < 2; ++bj) e(row, u.pn * 256 + bj * 128 + wc * 32 + 8 * fq, acc[ai][bj][m][0], acc[ai][bj][m][1]); } } };
template <class EW>
__device__ __forceinline__ void gemm_fast8(unsigned char* lds, const bf16_t* A, const bf16_t* Bt, int M, int N, int K, const EW& e) {
    pg8::Gemm g{A, Bt, M, N, K}; pg8::StaticOrder S; S.init(M, N, (int)gridDim.x, (int)blockIdx.x);
    EpiAdapt8<EW> E{e};
    pg8::gemm_phase<EpiAdapt8<EW>, pg8::StaticOrder, true, true>((PG8_LAS unsigned char*)lds, g, S, E);
}
template <class EW>
__device__ __forceinline__ void gemm_fast(unsigned char* lds, const bf16_t* A, const bf16_t* Bt, int M, int N, int K, const EW& e) {
    pg8::Gemm g{A, Bt, M, N, K}; pg8::StaticOrder S; S.init(M, N, (int)gridDim.x, (int)blockIdx.x);
    EpiAdapt<EW> E{e};
    pg8::gemm_phase<EpiAdapt<EW>, pg8::StaticOrder, true, true>((PG8_LAS unsigned char*)lds, g, S, E);
}

struct EpiBf16 { bf16_t* O; int ldc;
    __device__ __forceinline__ void operator()(int r, int c, f32x4 v) const { u32x2 w; w.x = pk2(v.x, v.y); w.y = pk2(v.z, v.w); *(u32x2*)(O + (size_t)r * ldc + c) = w; } };
struct EpiBf16Halo { bf16_t* O; bf16_t* H;
    __device__ __forceinline__ void operator()(int r, int c, f32x4 v) const { u32x2 w; w.x = pk2(v.x, v.y); w.y = pk2(v.z, v.w); *(u32x2*)(O + (size_t)r * D + c) = w;
        const int rr = r & 63; if (rr >= 61) *(u32x2*)(H + ((size_t)(r >> 6) * 3 + (rr - 61)) * D + c) = w; } };
struct EpiGate { bf16_t* S0; const float* bias;
    __device__ __forceinline__ void operator()(int r, int c, f32x4 v) const { const f32x4 b = *(const f32x4*)(bias + c); const int s = c >> 10, cc = c & 1023; bf16_t* O = S0 + (size_t)(3 + s + (s > 0 ? 1 : 0)) * (SLOT_BYTES / 2);
        u32x2 w; w.x = pk2(sigmoidf_(v.x + b.x), sigmoidf_(v.y + b.y)); w.y = pk2(sigmoidf_(v.z + b.z), sigmoidf_(v.w + b.w)); *(u32x2*)(O + (size_t)r * D + cc) = w; } };
template <int MODE>
struct EpiMix { const bf16_t* G; float* Mx; bf16_t* O;
    __device__ __forceinline__ void operator()(int r, int c, f32x4 v) const { const size_t off = (size_t)r * D + c; const u32x2 gw = *(const u32x2*)(G + off);
        f32x4 m = (f32x4){bflo(gw.x) * v.x, bfhi(gw.x) * v.y, bflo(gw.y) * v.z, bfhi(gw.y) * v.w};
        if (MODE >= 1) m = m + *(const f32x4*)(Mx + off);
        if (MODE <= 1) *(f32x4*)(Mx + off) = m; else { u32x2 w; w.x = pk2(m.x, m.y); w.y = pk2(m.z, m.w); *(u32x2*)(O + off) = w; } } };
struct EpiResid { const float* base; float* out;
    __device__ __forceinline__ void operator()(int r, int c, f32x4 v) const { const size_t off = (size_t)r * D + c; *(f32x4*)(out + off) = *(const f32x4*)(base + off) + v; } };
struct EpiRelu2 { bf16_t* O; int ldc;
    __device__ __forceinline__ void operator()(int r, int c, f32x4 v) const { f32x4 t = (f32x4){fmaxf(v.x, 0.f), fmaxf(v.y, 0.f), fmaxf(v.z, 0.f), fmaxf(v.w, 0.f)}; t = t * t;
        u32x2 w; w.x = pk2(t.x, t.y); w.y = pk2(t.z, t.w); *(u32x2*)(O + (size_t)r * ldc + c) = w; } };

__device__ __forceinline__ void sb_naive(bf16_t* Q, const bf16_t* Kk, const bf16_t* VT, float* qs, int gw, int NGW, int lane) {
    const float scale = 0.08838834764831845f;
    for (int w = gw; w < 2048; w += NGW) {
        for (int i = 0; i < 128; ++i) {
            const int bh = i >> 1, t = (i & 1) ? (SEQ - 1 - w) : w, b = bh >> 3, h = bh & 7;
            const size_t row = (size_t)b * SEQ + t;
            bf16_t* qrow = Q + row * D + h * 128;
            { const unsigned qw = *(const unsigned*)(qrow + 2 * lane); qs[2 * lane] = bflo(qw) * scale; qs[2 * lane + 1] = bfhi(qw) * scale; }
            LDS_WAIT();
            float acc[128];
#pragma unroll
            for (int d = 0; d < 128; ++d) acc[d] = 0.f;
            float R = 0.f;
            const int nb = (t + 63) >> 6;
            for (int blk = nb - 1; blk >= 0; --blk) {
                const int s = blk * 64 + lane; const bool valid = s < t;
                const bf16_t* krow = Kk + ((size_t)b * SEQ + s) * D + h * 128;
                float z = 0.f;
#pragma unroll
                for (int c = 0; c < 16; ++c) { const u32x4 kw = *(const u32x4*)(krow + 8 * c); const f32x4 q0 = *(const f32x4*)(qs + 8 * c), q1 = *(const f32x4*)(qs + 8 * c + 4);
                    z += bflo(kw.x) * q0.x + bfhi(kw.x) * q0.y + bflo(kw.y) * q0.z + bfhi(kw.y) * q0.w + bflo(kw.z) * q1.x + bfhi(kw.z) * q1.y + bflo(kw.w) * q1.z + bfhi(kw.w) * q1.w; }
                const float e = __expf(-fabsf(z)); const float sp = fmaxf(z, 0.f) + __logf(1.f + e);
                const float lm = valid ? -sp : 0.f, ls = z - sp;
                float incl = lm;
#pragma unroll
                for (int off = 1; off < 64; off <<= 1) { const float tmp = __shfl_down(incl, off); if (lane + off < 64) incl += tmp; }
                const float later = R + incl - lm;
                const float p = valid ? __expf(ls + later) : 0.f;
                R += __shfl(incl, 0);
                const bf16_t* vcol = VT + (size_t)(h * 128) * T + (size_t)b * SEQ + s;
#pragma unroll
                for (int d0 = 0; d0 < 128; d0 += 16) {
#pragma unroll
                    for (int d = d0; d < d0 + 16; ++d) acc[d] += p * bf2f(vcol[(size_t)d * T]);
                    asm volatile("" ::: "memory"); }
            }
            float o0 = 0.f, o1 = 0.f;
#pragma unroll
            for (int d = 0; d < 128; ++d) { const float tot = wave_sum(acc[d]); if ((d & 63) == lane) { if (d < 64) o0 = tot; else o1 = tot; } }
            qrow[lane] = (bf16_t)f2bf(o0); qrow[64 + lane] = (bf16_t)f2bf(o1);
            LDS_WAIT();
        }
    }
}

template <class Epi>
__device__ __forceinline__ void gemm_simple(const bf16_t* A, const bf16_t* Bt, int M, int N, int K, int u0, const Epi& E) {
    const int tid = threadIdx.x, wid = tid >> 6, lane = tid & 63, wr = wid >> 2, wc = wid & 3, fr = lane & 15, fq = lane >> 4;
    const int nN = N / 128, nU = (M / 128) * nN;
    for (int uu = blockIdx.x; uu < u0 + nU; uu += gridDim.x) { if (uu < u0) continue; const int u = uu - u0;
        const int pm = u / nN, pn = u % nN, row0 = pm * 128 + wr * 64, col0 = pn * 128 + wc * 32;
        f32x4 acc[4][2];
#pragma unroll
        for (int m = 0; m < 4; ++m)
#pragma unroll
            for (int n = 0; n < 2; ++n) acc[m][n] = (f32x4){0.f, 0.f, 0.f, 0.f};
        const bf16_t* ap = A + (size_t)(row0 + fr) * K + fq * 8; const bf16_t* bp = Bt + (size_t)(col0 + fr) * K + fq * 8;
#pragma unroll 2
        for (int k0 = 0; k0 < K; k0 += 32) { bf16x8 a[4], b[2];
#pragma unroll
            for (int m = 0; m < 4; ++m) a[m] = *(const bf16x8*)(ap + (size_t)m * 16 * K + k0);
#pragma unroll
            for (int n = 0; n < 2; ++n) b[n] = *(const bf16x8*)(bp + (size_t)n * 16 * K + k0);
#pragma unroll
            for (int m = 0; m < 4; ++m)
#pragma unroll
                for (int n = 0; n < 2; ++n) acc[m][n] = __builtin_amdgcn_mfma_f32_16x16x32_bf16(b[n], a[m], acc[m][n], 0, 0, 0); }
#pragma unroll
        for (int m = 0; m < 4; ++m)
#pragma unroll
            for (int n = 0; n < 2; ++n) E(row0 + m * 16 + fr, col0 + n * 16 + 4 * fq, acc[m][n]); }
}

constexpr size_t SLOT_ELEMS = SLOT_BYTES / 2;
struct EpiSeg4 { bf16_t* S0; bf16_t* HQ;
    __device__ __forceinline__ void operator()(int r, int c, f32x4 v) const { const int seg = c >> 10, cc = c & 1023; bf16_t* O = S0 + (size_t)(seg + 1 + (seg >= 2 ? 1 : 0)) * SLOT_ELEMS;
        u32x2 w; w.x = pk2(v.x, v.y); w.y = pk2(v.z, v.w); *(u32x2*)(O + (size_t)r * D + cc) = w;
        const int rr = r & 63; if (seg >= 2 && rr >= 61) *(u32x2*)(HQ + (size_t)(seg - 2) * (3 * MiB / 2) + ((size_t)(r >> 6) * 3 + (rr - 61)) * D + cc) = w; }
    __device__ __forceinline__ void operator()(int r, int c, f32x4 v0, f32x4 v1) const { const int seg = c >> 10, cc = c & 1023; bf16_t* O = S0 + (size_t)(seg + 1 + (seg >= 2 ? 1 : 0)) * SLOT_ELEMS; u32x4 w; w.x = pk2(v0.x, v0.y); w.y = pk2(v0.z, v0.w); w.z = pk2(v1.x, v1.y); w.w = pk2(v1.z, v1.w); *(u32x4*)(O + (size_t)r * D + cc) = w;
        const int rr = r & 63; if (seg >= 2 && rr >= 61) *(u32x4*)(HQ + (size_t)(seg - 2) * (3 * MiB / 2) + ((size_t)(r >> 6) * 3 + (rr - 61)) * D + cc) = w; } };
struct EpiVT2 { bf16_t* S0;
    __device__ __forceinline__ void operator()(int r, int c, f32x4 v) const { bf16_t* O = S0 + (size_t)(3 + 3 * (r >> 10)) * SLOT_ELEMS;
        u32x2 w; w.x = pk2(v.x, v.y); w.y = pk2(v.z, v.w); *(u32x2*)(O + (size_t)(r & 1023) * T + c) = w; }
    __device__ __forceinline__ void operator()(int r, int c, f32x4 v0, f32x4 v1) const { bf16_t* O = S0 + (size_t)(3 + 3 * (r >> 10)) * SLOT_ELEMS; u32x4 w; w.x = pk2(v0.x, v0.y); w.y = pk2(v0.z, v0.w); w.z = pk2(v1.x, v1.y); w.w = pk2(v1.z, v1.w); *(u32x4*)(O + (size_t)(r & 1023) * T + c) = w; } };
struct EpiSeg2 { bf16_t* S0;
    __device__ __forceinline__ void operator()(int r, int c, f32x4 v) const { bf16_t* O = S0 + (size_t)(3 - (c >> 10)) * SLOT_ELEMS;
        u32x2 w; w.x = pk2(v.x, v.y); w.y = pk2(v.z, v.w); *(u32x2*)(O + (size_t)r * D + (c & 1023)) = w; }
    __device__ __forceinline__ void operator()(int r, int c, f32x4 v0, f32x4 v1) const { bf16_t* O = S0 + (size_t)(3 - (c >> 10)) * SLOT_ELEMS; u32x4 w; w.x = pk2(v0.x, v0.y); w.y = pk2(v0.z, v0.w); w.z = pk2(v1.x, v1.y); w.w = pk2(v1.z, v1.w); *(u32x4*)(O + (size_t)r * D + (c & 1023)) = w; } };
struct EpiRelu2RS { bf16_t* O; int ldc; const float* ssq;
    __device__ __forceinline__ void operator()(int r, int c, f32x4 v) const { const float rs = rsqrtf(ssq[r] * (1.f / D) + EPS);
        f32x4 t = (f32x4){fmaxf(v.x * rs, 0.f), fmaxf(v.y * rs, 0.f), fmaxf(v.z * rs, 0.f), fmaxf(v.w * rs, 0.f)}; t = t * t;
        u32x2 w; w.x = pk2(t.x, t.y); w.y = pk2(t.z, t.w); *(u32x2*)(O + (size_t)r * ldc + c) = w; }
    __device__ __forceinline__ void operator()(int r, int c, f32x4 v0, f32x4 v1) const { const float rs = rsqrtf(ssq[r] * (1.f / D) + EPS);
        v0 = (f32x4){fmaxf(v0.x * rs, 0.f), fmaxf(v0.y * rs, 0.f), fmaxf(v0.z * rs, 0.f), fmaxf(v0.w * rs, 0.f)}; v0 = v0 * v0; v1 = (f32x4){fmaxf(v1.x * rs, 0.f), fmaxf(v1.y * rs, 0.f), fmaxf(v1.z * rs, 0.f), fmaxf(v1.w * rs, 0.f)}; v1 = v1 * v1; u32x4 w; w.x = pk2(v0.x, v0.y); w.y = pk2(v0.z, v0.w); w.z = pk2(v1.x, v1.y); w.w = pk2(v1.z, v1.w); *(u32x4*)(O + (size_t)r * ldc + c) = w; } };
struct GateMixOrder { pg8::StaticOrder so;
    __device__ __forceinline__ bool next(int i, pg8::Unit& u) const { const int ti = i / 6, r = i - 6 * ti, br = r >> 1; pg8::Unit t; if (!so.next(ti, t)) return false;
        if ((r & 1) == 0) { u.pm = t.pm; u.pn = br * 4 + t.pn; } else { const int slot = 1 + (br == 1 ? 3 : 0) + (br == 2 ? 1 : 0); u.pm = slot * 128 + t.pm; u.pn = 20 + br * 4 + t.pn; }
        return true; }
    __device__ __forceinline__ void a_ready(const pg8::Unit&) const {}
    __device__ __forceinline__ void done(const pg8::Unit&) const {} };
struct EpiGateMix { static constexpr bool PERM = true, AFTER_DRAIN = false; bf16_t* S0; const float* bias;
    __device__ __forceinline__ void operator()(const f32x4 (&acc)[2][2][4][2], const pg8::Unit& u, int wr, int wc, int fr, int fq) const {
        const bool mix = u.pn >= 20; const int q = mix ? u.pn - 20 : u.pn, br = q >> 2, pn = q & 3, pm = u.pm & 127;
        unsigned char* G8 = (unsigned char*)(S0 + (size_t)(br == 2 ? 6 : 5) * SLOT_ELEMS) + (br == 1 ? (size_t)T * D : 0);
        bf16_t* R = S0 + (size_t)3 * SLOT_ELEMS;
        if (!mix) {
#pragma unroll
            for (int bj = 0; bj < 2; ++bj) { const int col = pn * 256 + bj * 128 + wc * 32 + 8 * fq; const f32x4 b0 = *(const f32x4*)(bias + br * 1024 + col), b1 = *(const f32x4*)(bias + br * 1024 + col + 4);
#pragma unroll
                for (int ai = 0; ai < 2; ++ai)
#pragma unroll
                    for (int m = 0; m < 4; ++m) { const int row = pm * 256 + ai * 128 + wr * 64 + m * 16 + fr; const f32x4 v0 = acc[ai][bj][m][0] + b0, v1 = acc[ai][bj][m][1] + b1;
                        u32x2 g8;
                        g8.x = (unsigned)(sigmoidf_(v0.x) * 255.f + 0.5f) | ((unsigned)(sigmoidf_(v0.y) * 255.f + 0.5f) << 8) | ((unsigned)(sigmoidf_(v0.z) * 255.f + 0.5f) << 16) | ((unsigned)(sigmoidf_(v0.w) * 255.f + 0.5f) << 24);
                        g8.y = (unsigned)(sigmoidf_(v1.x) * 255.f + 0.5f) | ((unsigned)(sigmoidf_(v1.y) * 255.f + 0.5f) << 8) | ((unsigned)(sigmoidf_(v1.z) * 255.f + 0.5f) << 16) | ((unsigned)(sigmoidf_(v1.w) * 255.f + 0.5f) << 24);
                        *(u32x2*)(G8 + ((((size_t)(pm * 4 + pn) * 8 + (wr * 4 + wc)) * 8 + ai * 4 + m) * 2 + bj) * 512 + (fq * 16 + fr) * 8) = g8; } }
        } else {
            const float k255 = 1.f / 255.f;
#pragma unroll
            for (int ai = 0; ai < 2; ++ai) { u32x2 gw[4][2]; u32x4 pw[4][2];
#pragma unroll
                for (int m = 0; m < 4; ++m)
#pragma unroll
                    for (int bj = 0; bj < 2; ++bj) { const size_t off = (size_t)(pm * 256 + ai * 128 + wr * 64 + m * 16 + fr) * D + pn * 256 + bj * 128 + wc * 32 + 8 * fq; gw[m][bj] = *(const u32x2*)(G8 + ((((size_t)(pm * 4 + pn) * 8 + (wr * 4 + wc)) * 8 + ai * 4 + m) * 2 + bj) * 512 + (fq * 16 + fr) * 8); if (br >= 1) pw[m][bj] = *(const u32x4*)(R + off); }
#pragma unroll
                for (int m = 0; m < 4; ++m)
#pragma unroll
                    for (int bj = 0; bj < 2; ++bj) { const size_t off = (size_t)(pm * 256 + ai * 128 + wr * 64 + m * 16 + fr) * D + pn * 256 + bj * 128 + wc * 32 + 8 * fq; const f32x4 v0 = acc[ai][bj][m][0], v1 = acc[ai][bj][m][1];
                        const unsigned ga = gw[m][bj].x, gb = gw[m][bj].y;
                        f32x4 m0 = (f32x4){(float)(ga & 255u) * k255 * v0.x, (float)((ga >> 8) & 255u) * k255 * v0.y, (float)((ga >> 16) & 255u) * k255 * v0.z, (float)(ga >> 24) * k255 * v0.w};
                        f32x4 m1 = (f32x4){(float)(gb & 255u) * k255 * v1.x, (float)((gb >> 8) & 255u) * k255 * v1.y, (float)((gb >> 16) & 255u) * k255 * v1.z, (float)(gb >> 24) * k255 * v1.w};
                        if (br >= 1) { const u32x4 p = pw[m][bj]; m0.x += bflo(p.x); m0.y += bfhi(p.x); m0.z += bflo(p.y); m0.w += bfhi(p.y); m1.x += bflo(p.z); m1.y += bfhi(p.z); m1.z += bflo(p.w); m1.w += bfhi(p.w); }
                        u32x4 w; w.x = pk2(m0.x, m0.y); w.y = pk2(m0.z, m0.w); w.z = pk2(m1.x, m1.y); w.w = pk2(m1.z, m1.w); *(u32x4*)(R + off) = w; } }
        } } };
struct EpiResidSS { static constexpr bool PERM = true, AFTER_DRAIN = false; const float* base; float* out; bf16_t* xb; float* ssq;
    __device__ __forceinline__ void operator()(const f32x4 (&acc)[2][2][4][2], const pg8::Unit& u, int wr, int wc, int fr, int fq) const {
#pragma unroll
        for (int ai = 0; ai < 2; ++ai) { f32x4 pre[4][2][2];
#pragma unroll
            for (int m = 0; m < 4; ++m)
#pragma unroll
                for (int bj = 0; bj < 2; ++bj) { const float* bp = base + (size_t)(u.pm * 256 + ai * 128 + wr * 64 + m * 16 + fr) * D + u.pn * 256 + bj * 128 + wc * 32 + 8 * fq; pre[m][bj][0] = *(const f32x4*)bp; pre[m][bj][1] = *(const f32x4*)(bp + 4); }
#pragma unroll
            for (int m = 0; m < 4; ++m) { const int row = u.pm * 256 + ai * 128 + wr * 64 + m * 16 + fr; float ss = 0.f;
#pragma unroll
                for (int bj = 0; bj < 2; ++bj) { const size_t off = (size_t)row * D + u.pn * 256 + bj * 128 + wc * 32 + 8 * fq;
                    const f32x4 o0 = pre[m][bj][0] + acc[ai][bj][m][0], o1 = pre[m][bj][1] + acc[ai][bj][m][1];
                    u32x4 w; w.x = pk2(o0.x, o0.y); w.y = pk2(o0.z, o0.w); w.z = pk2(o1.x, o1.y); w.w = pk2(o1.z, o1.w); *(u32x4*)(xb + off) = w;
                    ss += ((o0.x * o0.x + o0.y * o0.y) + (o0.z * o0.z + o0.w * o0.w)) + ((o1.x * o1.x + o1.y * o1.y) + (o1.z * o1.z + o1.w * o1.w)); }
                ss += __shfl_xor(ss, 16); ss += __shfl_xor(ss, 32);
                if (fq == 0) atomicAdd(ssq + row, ss); } } } };
struct EpiResidIn { static constexpr bool PERM = true, AFTER_DRAIN = false; const bf16_t* xb; float* out;
    __device__ __forceinline__ void operator()(const f32x4 (&acc)[2][2][4][2], const pg8::Unit& u, int wr, int wc, int fr, int fq) const {
#pragma unroll
        for (int ai = 0; ai < 2; ++ai) { u32x4 pre[4][2];
#pragma unroll
            for (int m = 0; m < 4; ++m)
#pragma unroll
                for (int bj = 0; bj < 2; ++bj) pre[m][bj] = *(const u32x4*)(xb + (size_t)(u.pm * 256 + ai * 128 + wr * 64 + m * 16 + fr) * D + u.pn * 256 + bj * 128 + wc * 32 + 8 * fq);
#pragma unroll
            for (int m = 0; m < 4; ++m)
#pragma unroll
                for (int bj = 0; bj < 2; ++bj) { const f32x4 a0 = acc[ai][bj][m][0], a1 = acc[ai][bj][m][1]; const u32x4 p = pre[m][bj];
                    float* op = out + (size_t)(u.pm * 256 + ai * 128 + wr * 64 + m * 16 + fr) * D + u.pn * 256 + bj * 128 + wc * 32 + 8 * fq;
                    *(f32x4*)op = (f32x4){bflo(p.x) + a0.x, bfhi(p.x) + a0.y, bflo(p.y) + a0.z, bfhi(p.y) + a0.w}; *(f32x4*)(op + 4) = (f32x4){bflo(p.z) + a1.x, bfhi(p.z) + a1.y, bflo(p.w) + a1.z, bfhi(p.w) + a1.w}; } } } };

#define LAS __attribute__((address_space(3)))
typedef float f32x16 __attribute__((ext_vector_type(16)));
constexpr int SB_KST = 272, SB_VST = 136, SB_KBYTES = 64 * SB_KST, SB_VBYTES = 128 * SB_VST, SB_BUF = SB_KBYTES + SB_VBYTES;
template <bool DIAG>
__device__ __forceinline__ void sb_subtile(LAS unsigned char* buf, int st, const bf16x8 (&qf)[8], f32x16 (&Y)[4], float& R, int k0, int qi, int r32, int hh) {
    f32x16 X;
#pragma unroll
    for (int r = 0; r < 16; ++r) X[r] = 0.f;
    LAS unsigned char* kp = buf + (32 * st + r32) * SB_KST + hh * 16;
#pragma unroll
    for (int s = 0; s < 8; ++s) { const bf16x8 kf = *(LAS bf16x8*)(kp + s * 32); X = __builtin_amdgcn_mfma_f32_32x32x16_bf16(kf, qf[s], X, 0, 0, 0); }
    float om[16];
#pragma unroll
    for (int r = 0; r < 16; ++r) { const float zz = __builtin_amdgcn_fmed3f(X[r], -80.f, 80.f);
        const float u = __builtin_amdgcn_exp2f(zz); const float be = __builtin_amdgcn_rcpf(1.f + u);
        const int key = k0 + (r & 3) + 8 * (r >> 2) + 4 * hh; const bool valid = !DIAG || key < qi;
        om[r] = valid ? u * be : 1.f; X[r] = valid ? be : 0.f; }
    float g[4], og[4], pr[4];
#pragma unroll
    for (int c = 0; c < 4; ++c) { g[c] = (om[4 * c] * om[4 * c + 1]) * (om[4 * c + 2] * om[4 * c + 3]); og[c] = __shfl_xor(g[c], 32); pr[c] = g[c] * og[c]; }
    float Tc[4]; Tc[3] = 1.f; Tc[2] = pr[3]; Tc[1] = pr[3] * pr[2]; Tc[0] = Tc[1] * pr[1];
    const float total = Tc[0] * pr[0];
#pragma unroll
    for (int c = 0; c < 4; ++c) { float later = R * Tc[c] * (hh == 0 ? og[c] : 1.f);
#pragma unroll
        for (int i = 3; i >= 0; --i) { const int r = 4 * c + i; const float pv = X[r] * later; later *= om[r]; X[r] = pv; } }
    R *= total;
    bf16x8 pf[2];
#pragma unroll
    for (int s2 = 0; s2 < 2; ++s2) { u32x4 w; w.x = pk2(X[8 * s2], X[8 * s2 + 1]); w.y = pk2(X[8 * s2 + 2], X[8 * s2 + 3]); w.z = pk2(X[8 * s2 + 4], X[8 * s2 + 5]); w.w = pk2(X[8 * s2 + 6], X[8 * s2 + 7]); pf[s2] = __builtin_bit_cast(bf16x8, w); }
#pragma unroll
    for (int dt = 0; dt < 4; ++dt) { LAS unsigned char* vp = buf + SB_KBYTES + (32 * dt + r32) * SB_VST + (32 * st + 4 * hh) * 2;
#pragma unroll
        for (int s2 = 0; s2 < 2; ++s2) { const u32x2 lo = *(LAS u32x2*)(vp + s2 * 32), hi = *(LAS u32x2*)(vp + s2 * 32 + 16);
            u32x4 w; w.x = lo.x; w.y = lo.y; w.z = hi.x; w.w = hi.y;
            Y[dt] = __builtin_amdgcn_mfma_f32_32x32x16_bf16(__builtin_bit_cast(bf16x8, w), pf[s2], Y[dt], 0, 0, 0); } }
}
__device__ __forceinline__ void sb_tile_full(LAS unsigned char* buf, const bf16x8 (&qf)[8], f32x16 (&Y)[4], float& R, int r32, int hh) {
    f32x16 X1, X0;
#pragma unroll
    for (int r = 0; r < 16; ++r) { X1[r] = 0.f; X0[r] = 0.f; }
    LAS unsigned char* kp = buf + r32 * SB_KST + hh * 16;
#pragma unroll
    for (int s = 0; s < 8; ++s) { const bf16x8 k1 = *(LAS bf16x8*)(kp + 32 * SB_KST + s * 32), k0_ = *(LAS bf16x8*)(kp + s * 32);
        X1 = __builtin_amdgcn_mfma_f32_32x32x16_bf16(k1, qf[s], X1, 0, 0, 0); X0 = __builtin_amdgcn_mfma_f32_32x32x16_bf16(k0_, qf[s], X0, 0, 0, 0); }
    float om1[16], om0[16];
#pragma unroll
    for (int r = 0; r < 16; ++r) { const float z1 = X1[r], z0 = X0[r];
        const float u1 = __builtin_amdgcn_exp2f(z1), u0 = __builtin_amdgcn_exp2f(z0); const float b1 = __builtin_amdgcn_rcpf(1.f + u1), b0 = __builtin_amdgcn_rcpf(1.f + u0);
        om1[r] = u1 * b1; om0[r] = u0 * b0; X1[r] = b1; X0[r] = b0; }
    float g1[4], g0[4], o1[4], o0[4];
#pragma unroll
    for (int c = 0; c < 4; ++c) { g1[c] = (om1[4 * c] * om1[4 * c + 1]) * (om1[4 * c + 2] * om1[4 * c + 3]); g0[c] = (om0[4 * c] * om0[4 * c + 1]) * (om0[4 * c + 2] * om0[4 * c + 3]); }
#pragma unroll
    for (int c = 0; c < 4; ++c) { o1[c] = __shfl_xor(g1[c], 32); o0[c] = __shfl_xor(g0[c], 32); }
    float T1[4], T0[4];
    { const float p3 = g1[3] * o1[3], p2 = g1[2] * o1[2], p1 = g1[1] * o1[1], p0 = g1[0] * o1[0]; T1[3] = R; T1[2] = R * p3; T1[1] = T1[2] * p2; T1[0] = T1[1] * p1; R = T1[0] * p0; }
    { const float p3 = g0[3] * o0[3], p2 = g0[2] * o0[2], p1 = g0[1] * o0[1], p0 = g0[0] * o0[0]; T0[3] = R; T0[2] = R * p3; T0[1] = T0[2] * p2; T0[0] = T0[1] * p1; R = T0[0] * p0; }
#pragma unroll
    for (int c = 0; c < 4; ++c) { float l1 = T1[c] * (hh == 0 ? o1[c] : 1.f), l0 = T0[c] * (hh == 0 ? o0[c] : 1.f);
#pragma unroll
        for (int i = 3; i >= 0; --i) { const int r = 4 * c + i; const float p1 = X1[r] * l1, p0 = X0[r] * l0; l1 *= om1[r]; l0 *= om0[r]; X1[r] = p1; X0[r] = p0; } }
    bf16x8 pf1[2], pf0[2];
#pragma unroll
    for (int s2 = 0; s2 < 2; ++s2) { u32x4 w; w.x = pk2(X1[8 * s2], X1[8 * s2 + 1]); w.y = pk2(X1[8 * s2 + 2], X1[8 * s2 + 3]); w.z = pk2(X1[8 * s2 + 4], X1[8 * s2 + 5]); w.w = pk2(X1[8 * s2 + 6], X1[8 * s2 + 7]); pf1[s2] = __builtin_bit_cast(bf16x8, w);
        w.x = pk2(X0[8 * s2], X0[8 * s2 + 1]); w.y = pk2(X0[8 * s2 + 2], X0[8 * s2 + 3]); w.z = pk2(X0[8 * s2 + 4], X0[8 * s2 + 5]); w.w = pk2(X0[8 * s2 + 6], X0[8 * s2 + 7]); pf0[s2] = __builtin_bit_cast(bf16x8, w); }
    LAS unsigned char* vp0 = buf + SB_KBYTES + r32 * SB_VST + (4 * hh) * 2;
    u32x4 va[8], vb[8];
#pragma unroll
    for (int i = 0; i < 8; ++i) { LAS unsigned char* vp = vp0 + (32 * (i >> 2)) * SB_VST + (i & 3) * 32; const u32x2 lo = *(LAS u32x2*)vp, hi = *(LAS u32x2*)(vp + 16); va[i].x = lo.x; va[i].y = lo.y; va[i].z = hi.x; va[i].w = hi.y; }
#pragma unroll
    for (int i = 0; i < 8; ++i) asm volatile("" : "+v"(va[i]));
#pragma unroll
    for (int i = 0; i < 8; ++i) { LAS unsigned char* vp = vp0 + (32 * (2 + (i >> 2))) * SB_VST + (i & 3) * 32; const u32x2 lo = *(LAS u32x2*)vp, hi = *(LAS u32x2*)(vp + 16); vb[i].x = lo.x; vb[i].y = lo.y; vb[i].z = hi.x; vb[i].w = hi.y; }
    __builtin_amdgcn_sched_barrier(0);
#pragma unroll
    for (int i = 0; i < 8; ++i) { const int q4 = i & 3; Y[i >> 2] = __builtin_amdgcn_mfma_f32_32x32x16_bf16(__builtin_bit_cast(bf16x8, va[i]), (q4 < 2) ? pf0[q4] : pf1[q4 - 2], Y[i >> 2], 0, 0, 0); }
#pragma unroll
    for (int i = 0; i < 8; ++i) asm volatile("" : "+v"(vb[i]));
#pragma unroll
    for (int i = 0; i < 8; ++i) { const int q4 = i & 3; Y[2 + (i >> 2)] = __builtin_amdgcn_mfma_f32_32x32x16_bf16(__builtin_bit_cast(bf16x8, vb[i]), (q4 < 2) ? pf0[q4] : pf1[q4 - 2], Y[2 + (i >> 2)], 0, 0, 0); }
}
__device__ __forceinline__ void sb_fast(bf16_t* Q, const bf16_t* Kk, const bf16_t* VT, LAS unsigned char* lds) {
    int tid_ = threadIdx.x; asm volatile("" : "+v"(tid_));
    const int tid = tid_, lane = tid & 63, wid = tid >> 6, r32 = lane & 31, hh = lane >> 5;
    const int vcu_ = (gridDim.x % 8 == 0) ? (int)((blockIdx.x % 8) * (gridDim.x / 8) + blockIdx.x / 8) : (int)blockIdx.x;
    for (int vw = vcu_; vw < 256; vw += gridDim.x) {
        const int bh = vw >> 2, jj = vw & 3, b = bh >> 3, h = bh & 7;
        const bf16_t* kg = Kk + ((size_t)b * SEQ) * D + h * 128;
        const bf16_t* vg = VT + (size_t)(h * 128) * T + (size_t)b * SEQ;
        for (int ui = 0; ui < 4; ++ui) {
            const int qb = ui == 0 ? 2 * jj : (ui == 1 ? 15 - 2 * jj : (ui == 2 ? 2 * jj + 1 : 14 - 2 * jj));
            const int q0w = qb * 256 + 32 * wid, qi = q0w + r32;
            bf16_t* qrow = Q + ((size_t)b * SEQ + qi) * D + h * 128;
            bf16x8 qf[8];
#pragma unroll
            for (int s = 0; s < 8; ++s) qf[s] = *(const bf16x8*)(qrow + 16 * s + 8 * hh);
            f32x16 Y[4];
#pragma unroll
            for (int dt = 0; dt < 4; ++dt)
#pragma unroll
                for (int r = 0; r < 16; ++r) Y[dt][r] = 0.f;
            float R = 1.f;
            const int ktmax = 4 * qb + 3;
            u32x4 kr[2], vr[2];
#define SB_LOADG(kt) do { _Pragma("unroll") for (int i_ = 0; i_ < 2; ++i_) { const int c_ = tid + 512 * i_; \
                kr[i_] = *(const u32x4*)(kg + (size_t)(64 * (kt) + (c_ >> 4)) * D + (c_ & 15) * 8); \
                vr[i_] = *(const u32x4*)(vg + (size_t)(c_ >> 3) * T + 64 * (kt) + (c_ & 7) * 8); } } while (0)
#define SB_STORES(bufp) do { _Pragma("unroll") for (int i_ = 0; i_ < 2; ++i_) { const int c_ = tid + 512 * i_; \
                *(LAS u32x4*)((bufp) + (c_ >> 4) * SB_KST + (c_ & 15) * 16) = kr[i_]; \
                LAS u32x2* vp_ = (LAS u32x2*)((bufp) + SB_KBYTES + (c_ >> 3) * SB_VST + (c_ & 7) * 16); \
                u32x2 a_; a_.x = vr[i_].x; a_.y = vr[i_].y; u32x2 b_; b_.x = vr[i_].z; b_.y = vr[i_].w; vp_[0] = a_; vp_[1] = b_; } } while (0)
            SB_LOADG(ktmax); SB_STORES(lds);
#pragma unroll
            for (int s_ = 0; s_ < 8; ++s_) asm volatile("" : "+v"(qf[s_]));
            __syncthreads();
            for (int kt = ktmax, it = 0; kt >= 0; --kt, ++it) {
                LAS unsigned char* cur = lds + (it & 1) * SB_BUF; LAS unsigned char* nxt = lds + ((it & 1) ^ 1) * SB_BUF;
                if (kt > 0) SB_LOADG(kt - 1);
                if (64 * kt + 63 < q0w) sb_tile_full(cur, qf, Y, R, r32, hh);
                else {
#pragma unroll
                for (int st = 1; st >= 0; --st) { const int k0 = 64 * kt + 32 * st;
                    if (k0 < q0w + 31) { if (k0 + 31 >= q0w) sb_subtile<true>(cur, st, qf, Y, R, k0, qi, r32, hh); else sb_subtile<false>(cur, st, qf, Y, R, k0, qi, r32, hh); } } }
                if (kt > 0) SB_STORES(nxt);
                __syncthreads();
            }
#undef SB_LOADG
#undef SB_STORES
            { LAS unsigned char* stg = lds + wid * 8704;
#pragma unroll
              for (int dt = 0; dt < 4; ++dt)
#pragma unroll
                  for (int c = 0; c < 4; ++c) { u32x2 w; w.x = pk2(Y[dt][4 * c], Y[dt][4 * c + 1]); w.y = pk2(Y[dt][4 * c + 2], Y[dt][4 * c + 3]); *(LAS u32x2*)(stg + r32 * 272 + (32 * dt + 8 * c + 4 * hh) * 2) = w; }
              LDS_WAIT();
              bf16_t* orow = Q + ((size_t)b * SEQ + q0w) * D + h * 128;
#pragma unroll 1
              for (int i = 0; i < 8; ++i) { const int row = 4 * i + (lane >> 4), ch = lane & 15; const u32x4 v = *(LAS u32x4*)(stg + row * 272 + ch * 16); *(u32x4*)(orow + (size_t)row * D + ch * 8) = v; }
              __syncthreads(); }
        }
    }
}

__device__ __forceinline__ void conv_pass(bf16_t* MQ, bf16_t* MK, const bf16_t* haloQ, const bf16_t* haloK, const float* conv_w, const float* conv_b, int gw, int NGW, int lane) {
    for (int it = gw; it < 2048; it += NGW) {
        const int blk = it >> 2, isk = (it >> 1) & 1, half = it & 1;
        const int ch0 = (half * 64 + lane) * 8;
        bf16_t* base = (isk ? MK : MQ) + (size_t)blk * 64 * D + ch0;
        const float* cw = conv_w + isk * 1024 + ch0;
        float w0[8], w1[8], w2[8], w3[8], cb[8], r0[8], r1[8], r2[8];
#pragma unroll
        for (int e = 0; e < 8; ++e) { w0[e] = cw[e]; w1[e] = cw[2048 + e]; w2[e] = cw[4096 + e]; w3[e] = cw[6144 + e]; cb[e] = conv_b[isk * 1024 + ch0 + e]; r0[e] = 0.f; r1[e] = 0.f; r2[e] = 0.f; }
        if ((blk & 63) != 0) { const bf16_t* hal = (isk ? haloK : haloQ) + (size_t)(blk - 1) * 3 * D + ch0;
            const u32x4 h0 = *(const u32x4*)hal, h1 = *(const u32x4*)(hal + D), h2 = *(const u32x4*)(hal + 2 * D);
#pragma unroll
            for (int e2 = 0; e2 < 4; ++e2) { r0[2 * e2] = bflo(h0[e2]); r0[2 * e2 + 1] = bfhi(h0[e2]); r1[2 * e2] = bflo(h1[e2]); r1[2 * e2 + 1] = bfhi(h1[e2]); r2[2 * e2] = bflo(h2[e2]); r2[2 * e2 + 1] = bfhi(h2[e2]); } }
        const float osc = isk ? 0.0625f : 1.f;
        u32x4 in[4];
#pragma unroll
        for (int i = 0; i < 4; ++i) in[i] = *(const u32x4*)(base + (size_t)i * D);
#pragma unroll 1
        for (int r4 = 0; r4 < 64; r4 += 4) {
            u32x4 nx[4]; const int rn = (r4 + 4 < 64) ? r4 + 4 : r4;
#pragma unroll
            for (int i = 0; i < 4; ++i) nx[i] = *(const u32x4*)(base + (size_t)(rn + i) * D);
#pragma unroll
            for (int i = 0; i < 4; ++i) { float y[8];
#pragma unroll
                for (int e = 0; e < 8; ++e) { const float xv = (e & 1) ? bfhi(in[i][e >> 1]) : bflo(in[i][e >> 1]);
                    const float u = w0[e] * r0[e] + w1[e] * r1[e] + w2[e] * r2[e] + w3[e] * xv + cb[e]; r0[e] = r1[e]; r1[e] = r2[e]; r2[e] = xv; y[e] = u * sigmoidf_(u) * osc; }
                u32x4 o; o.x = pk2(y[0], y[1]); o.y = pk2(y[2], y[3]); o.z = pk2(y[4], y[5]); o.w = pk2(y[6], y[7]); *(u32x4*)(base + (size_t)(r4 + i) * D) = o; }
#pragma unroll
            for (int i = 0; i < 4; ++i) in[i] = nx[i];
        }
    }
}

__device__ __forceinline__ void gate_pass(const float* ifp, float* GA, float* GP, float* GB, int gw, int NGW, int lane) {
    for (int it = gw; it < 2048; it += NGW) { const int bh = it >> 6, c = it & 63, b = bh >> 2, h = bh & 3;
        const size_t trow = (size_t)b * SEQ + 64 * c + lane; const float gi = ifp[trow * 8 + h], gf = ifp[trow * 8 + 4 + h];
        const float lf = -(fmaxf(-gf, 0.f) + __logf(1.f + __expf(-fabsf(gf))));
        float bc = lf;
#pragma unroll
        for (int o = 1; o < 64; o <<= 1) { const float t_ = __shfl_up(bc, o); if (lane >= o) bc += t_; }
        const float a = gi - bc; float pm = a;
#pragma unroll
        for (int o = 1; o < 64; o <<= 1) { const float t_ = __shfl_up(pm, o); if (lane >= o) pm = fmaxf(pm, t_); }
        const size_t o_ = (size_t)bh * SEQ + 64 * c + lane; GA[o_] = a; GP[o_] = pm; GB[o_] = bc; }
}

constexpr int ML_QS = 0, ML_KS = 33792, ML_KST = 67584, ML_VTS = 104448, ML_VWT = 109200, ML_SCB = 113952, ML_CB = 123168, ML_VEC = 140592, ML_RS = 528, ML_TS = 144;
__device__ __forceinline__ void mlstm_fast(const bf16_t* MQ, const bf16_t* MK, const bf16_t* MVT, const float* GA, const float* GP, const float* GB, bf16_t* HUN, LAS unsigned char* lds) {
    int tid_ = threadIdx.x; asm volatile("" : "+v"(tid_));
    const int tid = tid_, lane = tid & 63, w = tid >> 6, fr = lane & 15, fq = lane >> 4;
    LAS float* vA = (LAS float*)(lds + ML_VEC); LAS float* vM = vA + 64; LAS float* vSI = vA + 128; LAS float* vEM = vA + 192; LAS float* vWK = vA + 256; LAS float* vDEC = vA + 320;
    const int tt = w & 3, sp = w >> 2;
    const int vcu_ = (gridDim.x % 8 == 0) ? (int)((blockIdx.x % 8) * (gridDim.x / 8) + blockIdx.x / 8) : (int)blockIdx.x;
    for (int item = vcu_; item < 256; item += gridDim.x) {
        const int bh = item >> 3, vs = item & 7, b = bh >> 2, h = bh & 3;
        const bf16_t* qg = MQ + ((size_t)b * SEQ + (tid >> 5)) * D + h * 256 + (tid & 31) * 8;
        const bf16_t* kg = MK + ((size_t)b * SEQ + (tid >> 5)) * D + h * 256 + (tid & 31) * 8;
        const bf16_t* vg = MVT + (size_t)(h * 256 + vs * 32 + ((tid >> 3) & 31)) * T + (size_t)b * SEQ + (tid & 7) * 8;
        const size_t go = (size_t)bh * SEQ + lane;
        bf16_t* hg = HUN + ((size_t)b * SEQ + 16 * tt + fr) * D + h * 256 + vs * 32 + 16 * sp + 4 * fq;
        for (int i = tid; i < 17424 / 16; i += NTHREADS) *(LAS u32x4*)(lds + ML_CB + i * 16) = (u32x4){0u, 0u, 0u, 0u};
        if (tid < 32) *(LAS unsigned*)(lds + ML_VTS + 32 * ML_TS + 4 * tid) = 0x3F803F80u;
        u32x4 pq[4], pk[4], pv; float ga = 0.f, gp_ = 0.f, gb = 0.f, nga = 0.f, ngp = 0.f, ngb = 0.f;
#define ML_LOAD(c) do { _Pragma("unroll") for (int i_ = 0; i_ < 4; ++i_) { pq[i_] = *(const u32x4*)(qg + (size_t)(64 * (c) + 16 * i_) * D); pk[i_] = *(const u32x4*)(kg + (size_t)(64 * (c) + 16 * i_) * D); } \
            if (tid < 256) pv = *(const u32x4*)(vg + 64 * (c)); if (w == 0) { nga = GA[go + 64 * (c)]; ngp = GP[go + 64 * (c)]; ngb = GB[go + 64 * (c)]; } } while (0)
#define ML_STORE() do { _Pragma("unroll") for (int i_ = 0; i_ < 4; ++i_) { *(LAS u32x4*)(lds + ML_QS + ((tid >> 5) + 16 * i_) * ML_RS + (tid & 31) * 16) = pq[i_]; *(LAS u32x4*)(lds + ML_KS + ((tid >> 5) + 16 * i_) * ML_RS + (tid & 31) * 16) = pk[i_]; } \
            if (tid < 256) *(LAS u32x4*)(lds + ML_VTS + (tid >> 3) * ML_TS + (tid & 7) * 16) = pv; } while (0)
        ML_LOAD(0); ML_STORE(); ga = nga; gp_ = ngp; gb = ngb;
        __syncthreads();
        float m_prev = 0.f;
        f32x4 Cacc[2][3];
#pragma unroll
        for (int u = 0; u < 2; ++u)
#pragma unroll
            for (int v3 = 0; v3 < 3; ++v3) Cacc[u][v3] = (f32x4){0.f, 0.f, 0.f, 0.f};
#pragma unroll 1
        for (int c = 0; c < 64; ++c) {
            if (c < 63) ML_LOAD(c + 1);
#pragma unroll
            for (int i_ = 0; i_ < 4; ++i_) { const u32x4 kv = *(LAS u32x4*)(lds + ML_KS + lane * ML_RS + (4 * w + i_) * 16);
#pragma unroll
                for (int e_ = 0; e_ < 8; ++e_) { const unsigned wd_ = kv[e_ >> 1]; *(LAS bf16_t*)(lds + ML_KST + (32 * w + 8 * i_ + e_) * ML_TS + 2 * lane) = (bf16_t)((e_ & 1) ? (wd_ >> 16) : (wd_ & 0xffffu)); } }
            if (w == 0) {
                const float Mt = fmaxf(m_prev, gp_);
                const float Mend = __shfl(Mt, 63), bend = __shfl(gb, 63);
                vA[lane] = ga; vM[lane] = Mt; vSI[lane] = __expf(m_prev - Mt); vEM[lane] = __expf(-(gb + Mt)); vWK[lane] = __expf(ga - Mend);
                if (lane == 0) vDEC[0] = __expf(m_prev - Mend);
                m_prev = bend + Mend;
            }
            f32x4 S[2]; S[0] = (f32x4){0.f, 0.f, 0.f, 0.f}; S[1] = S[0];
#pragma unroll
            for (int ks = 0; ks < 8; ++ks) { const bf16x8 bq = *(LAS bf16x8*)(lds + ML_QS + (16 * tt + fr) * ML_RS + (32 * ks + 8 * fq) * 2);
                const bf16x8 a0 = *(LAS bf16x8*)(lds + ML_KS + (32 * sp + fr) * ML_RS + (32 * ks + 8 * fq) * 2); const bf16x8 a1 = *(LAS bf16x8*)(lds + ML_KS + (32 * sp + 16 + fr) * ML_RS + (32 * ks + 8 * fq) * 2);
                S[0] = __builtin_amdgcn_mfma_f32_16x16x32_bf16(a0, bq, S[0], 0, 0, 0); S[1] = __builtin_amdgcn_mfma_f32_16x16x32_bf16(a1, bq, S[1], 0, 0, 0); }
            LDS_BARRIER();
            { const float Mt = vM[16 * tt + fr]; const int t = 16 * tt + fr;
#pragma unroll
              for (int u = 0; u < 2; ++u) { const int st = 2 * sp + u; const f32x4 av = *(LAS f32x4*)(vA + 16 * st + 4 * fq); float sc[4];
#pragma unroll
                  for (int j = 0; j < 4; ++j) { const int s_ = 16 * st + 4 * fq + j; sc[j] = (s_ <= t) ? S[u][j] * __expf(av[j] - Mt) : 0.f; }
                  u32x2 o; o.x = pk2(sc[0], sc[1]); o.y = pk2(sc[2], sc[3]); *(LAS u32x2*)(lds + ML_SCB + t * ML_TS + (16 * st + 4 * fq) * 2) = o; }
              const int v_ = tid >> 4, s4 = (tid & 15) * 4; const f32x4 wk = *(LAS f32x4*)(vWK + s4);
              const u32x2 vv = *(LAS u32x2*)(lds + ML_VTS + v_ * ML_TS + s4 * 2);
              u32x2 o; o.x = pk2(bflo(vv.x) * wk.x, bfhi(vv.x) * wk.y); o.y = pk2(bflo(vv.y) * wk.z, bfhi(vv.y) * wk.w); *(LAS u32x2*)(lds + ML_VWT + v_ * ML_TS + s4 * 2) = o;
              if (tid < 16) { u32x2 o2; o2.x = pk2(wk.x, wk.y); o2.y = pk2(wk.z, wk.w); *(LAS u32x2*)(lds + ML_VWT + 32 * ML_TS + s4 * 2) = o2; } }
            LDS_BARRIER();
            { f32x4 a1 = (f32x4){0.f, 0.f, 0.f, 0.f}, a1n = a1, a2 = a1, a2n = a1;
#pragma unroll
              for (int ks = 0; ks < 8; ++ks) { const bf16x8 bq = *(LAS bf16x8*)(lds + ML_QS + (16 * tt + fr) * ML_RS + (32 * ks + 8 * fq) * 2);
                  const bf16x8 ac = *(LAS bf16x8*)(lds + ML_CB + (16 * sp + fr) * ML_RS + (32 * ks + 8 * fq) * 2); const bf16x8 an = *(LAS bf16x8*)(lds + ML_CB + 32 * ML_RS + (32 * ks + 8 * fq) * 2);
                  a1 = __builtin_amdgcn_mfma_f32_16x16x32_bf16(ac, bq, a1, 0, 0, 0); a1n = __builtin_amdgcn_mfma_f32_16x16x32_bf16(an, bq, a1n, 0, 0, 0); }
#pragma unroll
              for (int ks = 0; ks < 2; ++ks) { const bf16x8 bs = *(LAS bf16x8*)(lds + ML_SCB + (16 * tt + fr) * ML_TS + (32 * ks + 8 * fq) * 2);
                  const bf16x8 av = *(LAS bf16x8*)(lds + ML_VTS + (16 * sp + fr) * ML_TS + (32 * ks + 8 * fq) * 2); const bf16x8 an = *(LAS bf16x8*)(lds + ML_VTS + 32 * ML_TS + (32 * ks + 8 * fq) * 2);
                  a2 = __builtin_amdgcn_mfma_f32_16x16x32_bf16(av, bs, a2, 0, 0, 0); a2n = __builtin_amdgcn_mfma_f32_16x16x32_bf16(an, bs, a2n, 0, 0, 0); }
              const float si = vSI[16 * tt + fr], em = vEM[16 * tt + fr];
              const float den = a2n[0] + si * a1n[0]; const float rd = 1.f / fmaxf(fabsf(den), em);
              u32x2 o; o.x = pk2((a2[0] + si * a1[0]) * rd, (a2[1] + si * a1[1]) * rd); o.y = pk2((a2[2] + si * a1[2]) * rd, (a2[3] + si * a1[3]) * rd);
              *(u32x2*)(hg + (size_t)(64 * c) * D) = o; }
            { const float dec = vDEC[0];
#pragma unroll
              for (int u = 0; u < 2; ++u)
#pragma unroll
                  for (int v3 = 0; v3 < 3; ++v3) Cacc[u][v3] = Cacc[u][v3] * dec;
#pragma unroll
              for (int ks = 0; ks < 2; ++ks) { bf16x8 bv[3];
#pragma unroll
                  for (int v3 = 0; v3 < 3; ++v3) { const int vr = (v3 < 2) ? 16 * v3 + fr : 32; bv[v3] = *(LAS bf16x8*)(lds + ML_VWT + vr * ML_TS + (32 * ks + 8 * fq) * 2); }
#pragma unroll
                  for (int u = 0; u < 2; ++u) { const bf16x8 ak = *(LAS bf16x8*)(lds + ML_KST + (16 * (2 * w + u) + fr) * ML_TS + (32 * ks + 8 * fq) * 2);
#pragma unroll
                      for (int v3 = 0; v3 < 3; ++v3) Cacc[u][v3] = __builtin_amdgcn_mfma_f32_16x16x32_bf16(ak, bv[v3], Cacc[u][v3], 0, 0, 0); } } }
            LDS_BARRIER();
#pragma unroll
            for (int u = 0; u < 2; ++u)
#pragma unroll
                for (int v3 = 0; v3 < 3; ++v3) { if (v3 < 2 || fr == 0) { const int vr = (v3 < 2) ? 16 * v3 + fr : 32; const f32x4 cv = Cacc[u][v3];
                    u32x2 o; o.x = pk2(cv.x, cv.y); o.y = pk2(cv.z, cv.w); *(LAS u32x2*)(lds + ML_CB + vr * ML_RS + (16 * (2 * w + u) + 4 * fq) * 2) = o; } }
            if (c < 63) { ML_STORE(); ga = nga; gp_ = ngp; gb = ngb; }
            LDS_BARRIER();
        }
#undef ML_LOAD
#undef ML_STORE
    }
}

__device__ __forceinline__ void memk_norm(bf16_t* MK, const float* gk, const float* gq, int gw, int NGW, int lane) {
    for (int r = gw; r < TMEM * 4; r += NGW) { const int bm = r >> 2, h = r & 3; bf16_t* p = MK + (size_t)bm * D + h * 256 + 4 * lane;
        const u32x2 w = *(const u32x2*)p; f32x4 v = (f32x4){bflo(w.x), bfhi(w.x), bflo(w.y), bfhi(w.y)};
        const float rs = rsqrtf(wave_sum(v.x * v.x + v.y * v.y + v.z * v.z + v.w * v.w) * (1.f / 256.f) + EPS);
        const f32x4 g = *(const f32x4*)(gk + 4 * lane); const f32x4 g2 = *(const f32x4*)(gq + 4 * lane); v = v * rs * g * g2 * 0.0625f;
        u32x2 o; o.x = pk2(v.x, v.y); o.y = pk2(v.z, v.w); *(u32x2*)p = o; }
}
constexpr int CX_RS = 528;
__device__ __forceinline__ void cross_lds(bf16_t* XQ, const bf16_t* MK, const bf16_t* MVT, LAS unsigned char* lds) {
    int tid_ = threadIdx.x; asm volatile("" : "+v"(tid_));
    const int tid = tid_, lane = tid & 63, w = tid >> 6, fr = lane & 15, fq = lane >> 4;
    for (int un = blockIdx.x; un < (T / 128) * 4; un += gridDim.x) {
        const int h = un & 3, t0 = (un >> 2) * 128, b = t0 >> 12;
        { const bf16_t* src = MK + (size_t)(b * NMEM) * D + h * 256 + (size_t)(tid >> 5) * D + (tid & 31) * 8; LAS unsigned char* dst = lds + (tid >> 5) * CX_RS + (tid & 31) * 16;
#pragma unroll 1
          for (int i0 = 0; i0 < 16; i0 += 8) { u32x4 tmp[8];
#pragma unroll
              for (int i = 0; i < 8; ++i) tmp[i] = *(const u32x4*)(src + (size_t)(16 * (i0 + i)) * D);
#pragma unroll
              for (int i = 0; i < 8; ++i) *(LAS u32x4*)(dst + 16 * (i0 + i) * CX_RS) = tmp[i]; } }
        asm volatile("" ::: "memory");
        bf16_t* qrow = XQ + (size_t)(t0 + 16 * w + fr) * D + h * 256;
        bf16x8 qf[8]; float ss = 0.f;
#pragma unroll
        for (int s_ = 0; s_ < 8; ++s_) { const u32x4 wq = *(const u32x4*)(qrow + 32 * s_ + 8 * fq); qf[s_] = __builtin_bit_cast(bf16x8, wq);
            ss += bflo(wq.x) * bflo(wq.x) + bfhi(wq.x) * bfhi(wq.x) + bflo(wq.y) * bflo(wq.y) + bfhi(wq.y) * bfhi(wq.y) + bflo(wq.z) * bflo(wq.z) + bfhi(wq.z) * bfhi(wq.z) + bflo(wq.w) * bflo(wq.w) + bfhi(wq.w) * bfhi(wq.w); }
        ss += __shfl_xor(ss, 16); ss += __shfl_xor(ss, 32);
        const float rs = rsqrtf(ss * (1.f / 256.f) + EPS);
        __syncthreads();
        f32x4 X[16];
#pragma unroll
        for (int kt = 0; kt < 16; ++kt) { X[kt] = (f32x4){0.f, 0.f, 0.f, 0.f};
#pragma unroll
            for (int s_ = 0; s_ < 8; ++s_) { const bf16x8 kf = *(LAS bf16x8*)(lds + (16 * kt + fr) * CX_RS + (32 * s_ + 8 * fq) * 2); X[kt] = __builtin_amdgcn_mfma_f32_16x16x32_bf16(kf, qf[s_], X[kt], 0, 0, 0); }
            asm volatile("" : "+v"(X[kt]) : : "memory"); }
        __syncthreads();
        asm volatile("" ::: "memory");
        { const bf16_t* src = MVT + (size_t)(h * 256) * TMEM + b * NMEM + (size_t)(tid >> 5) * TMEM + (tid & 31) * 8; LAS unsigned char* dst = lds + (tid >> 5) * CX_RS + (tid & 31) * 16;
#pragma unroll 1
          for (int i0 = 0; i0 < 16; i0 += 8) { u32x4 tmp[8];
#pragma unroll
              for (int i = 0; i < 8; ++i) tmp[i] = *(const u32x4*)(src + (size_t)(16 * (i0 + i)) * TMEM);
#pragma unroll
              for (int i = 0; i < 8; ++i) *(LAS u32x4*)(dst + 16 * (i0 + i) * CX_RS) = tmp[i]; } }
        asm volatile("" ::: "memory");
        float mx = -3.0e38f;
#pragma unroll
        for (int kt = 0; kt < 16; ++kt) { X[kt] = X[kt] * rs; mx = fmaxf(mx, fmaxf(fmaxf(X[kt].x, X[kt].y), fmaxf(X[kt].z, X[kt].w))); }
        mx = fmaxf(mx, __shfl_xor(mx, 16)); mx = fmaxf(mx, __shfl_xor(mx, 32));
        float sum = 0.f;
#pragma unroll
        for (int kt = 0; kt < 16; ++kt) { X[kt].x = __expf(X[kt].x - mx); X[kt].y = __expf(X[kt].y - mx); X[kt].z = __expf(X[kt].z - mx); X[kt].w = __expf(X[kt].w - mx); sum += (X[kt].x + X[kt].y) + (X[kt].z + X[kt].w); }
        sum += __shfl_xor(sum, 16); sum += __shfl_xor(sum, 32);
        const float inv = 1.f / sum;
        bf16x8 pf[8];
#pragma unroll
        for (int kp = 0; kp < 8; ++kp) { u32x4 wp; wp.x = pk2(X[2 * kp].x, X[2 * kp].y); wp.y = pk2(X[2 * kp].z, X[2 * kp].w); wp.z = pk2(X[2 * kp + 1].x, X[2 * kp + 1].y); wp.w = pk2(X[2 * kp + 1].z, X[2 * kp + 1].w); pf[kp] = __builtin_bit_cast(bf16x8, wp); }
        __syncthreads();
#pragma unroll 2
        for (int dt = 0; dt < 16; ++dt) { f32x4 Y = (f32x4){0.f, 0.f, 0.f, 0.f};
#pragma unroll
            for (int kp = 0; kp < 8; ++kp) { LAS unsigned char* vp = lds + (16 * dt + fr) * CX_RS + (32 * kp + 4 * fq) * 2; const u32x2 lo = *(LAS u32x2*)vp, hi = *(LAS u32x2*)(vp + 32);
                u32x4 wv; wv.x = lo.x; wv.y = lo.y; wv.z = hi.x; wv.w = hi.y; Y = __builtin_amdgcn_mfma_f32_16x16x32_bf16(__builtin_bit_cast(bf16x8, wv), pf[kp], Y, 0, 0, 0); }
            Y = Y * inv; u32x2 o; o.x = pk2(Y.x, Y.y); o.y = pk2(Y.z, Y.w); *(u32x2*)(qrow + 16 * dt + 4 * fq) = o; }
        __syncthreads();
    }
}
__device__ __forceinline__ void ml_finalize(const bf16_t* HUN, const bf16_t* MO, const float* g, bf16_t* Y, int gw, int NGW, int lane) {
    const f32x4 g0 = *(const f32x4*)(g + 4 * lane), g1 = *(const f32x4*)(g + 256 + 4 * lane), g2 = *(const f32x4*)(g + 512 + 4 * lane), g3 = *(const f32x4*)(g + 768 + 4 * lane);
    u32x2 hw[4], ow[4];
#pragma unroll
    for (int i = 0; i < 4; ++i) { const size_t off = (size_t)gw * D + i * 256 + 4 * lane; hw[i] = *(const u32x2*)(HUN + off); ow[i] = *(const u32x2*)(MO + off); }
    for (int t = gw; t < T; t += NGW) {
        const int tn = (t + NGW < T) ? t + NGW : t; u32x2 nh[4], no[4];
#pragma unroll
        for (int i = 0; i < 4; ++i) { const size_t off = (size_t)tn * D + i * 256 + 4 * lane; nh[i] = *(const u32x2*)(HUN + off); no[i] = *(const u32x2*)(MO + off); }
        float ssv[4]; f32x4 v[4];
#pragma unroll
        for (int i = 0; i < 4; ++i) { v[i] = (f32x4){bflo(hw[i].x), bfhi(hw[i].x), bflo(hw[i].y), bfhi(hw[i].y)}; ssv[i] = (v[i].x * v[i].x + v[i].y * v[i].y) + (v[i].z * v[i].z + v[i].w * v[i].w); }
#pragma unroll
        for (int i = 0; i < 4; ++i) ssv[i] = row16_sum(ssv[i]);
#pragma unroll
        for (int i = 0; i < 4; ++i) ssv[i] += __shfl_xor(ssv[i], 16);
#pragma unroll
        for (int i = 0; i < 4; ++i) ssv[i] += __shfl_xor(ssv[i], 32);
#pragma unroll
        for (int i = 0; i < 4; ++i) { const size_t off = (size_t)t * D + i * 256 + 4 * lane; const float rs = rsqrtf(ssv[i] * (1.f / 256.f) + EPS);
            const f32x4 gg = i == 0 ? g0 : (i == 1 ? g1 : (i == 2 ? g2 : g3));
            f32x4 r = v[i] * rs * gg; r.x *= sigmoidf_(bflo(ow[i].x)); r.y *= sigmoidf_(bfhi(ow[i].x)); r.z *= sigmoidf_(bflo(ow[i].y)); r.w *= sigmoidf_(bfhi(ow[i].y));
            u32x2 o; o.x = pk2(r.x, r.y); o.y = pk2(r.z, r.w); *(u32x2*)(Y + off) = o; }
#pragma unroll
        for (int i = 0; i < 4; ++i) { hw[i] = nh[i]; ow[i] = no[i]; }
    }
}

__global__ void __launch_bounds__(NTHREADS) fwd_megakernel(Params p) {
    extern __shared__ __attribute__((aligned(16))) unsigned char lds[];
    cg::grid_group grid = cg::this_grid();
#define LANE() ({ int l_ = threadIdx.x & 63; asm volatile("" : "+v"(l_)); l_; })
    int tid0_ = threadIdx.x; asm volatile("" : "+v"(tid0_));
    const int tid = tid0_, wave = __builtin_amdgcn_readfirstlane(threadIdx.x >> 6);
    const int gw = blockIdx.x * NWAVES + wave, NGW = gridDim.x * NWAVES;
    unsigned char* ws = p.ws; unsigned char* dob = (unsigned char*)p.out;
    const float* x = p.in[0]; const float* mem = p.in[1]; const float* g_mix = p.in[2]; const float* w_in = p.in[3]; const float* b_if = p.in[4]; const float* b_gate = p.in[5];
    const float* conv_w = p.in[6]; const float* conv_b = p.in[7]; const float* ml_norm_g = p.in[8]; const float* g_mem = p.in[9]; const float* w_mem_kv = p.in[10];
    const float* q_norm_g = p.in[11]; const float* k_norm_g = p.in[12]; const float* w_sb = p.in[13]; const float* w_ml = p.in[14]; const float* w_x = p.in[15]; const float* w_out = p.in[16];
    const float* g_mlp = p.in[17]; const float* w_ff1 = p.in[18]; const float* w_ff2 = p.in[19];
    bf16_t* Wt_in = (bf16_t*)(ws + WS_WIN); bf16_t* Wt_mkv = (bf16_t*)(ws + WS_WMKV); bf16_t* Wt_sb = (bf16_t*)(ws + WS_WSB); bf16_t* Wt_ml = (bf16_t*)(ws + WS_WML);
    bf16_t* Wt_x = (bf16_t*)(ws + WS_WX); bf16_t* Wt_out = (bf16_t*)(ws + WS_WOUT); bf16_t* Wt_ff1 = (bf16_t*)(ws + WS_WFF1); bf16_t* Wt_ff2 = (bf16_t*)(ws + WS_WFF2);
    float* ifp = (float*)(ws + WS_IF);
#define SLOT(i) ((bf16_t*)(ws + WS_SLOT0 + (size_t)(i) * SLOT_BYTES))
    bf16_t* memn = (bf16_t*)(dob + DO_MEMN); bf16_t* memk = (bf16_t*)(dob + DO_MEMK); bf16_t* memvt = (bf16_t*)(dob + DO_MEMVT); bf16_t* hun = (bf16_t*)(dob + DO_HUN);

    unsigned long long probe_t0 = 0, probe_dur = 0;
    PROBE_BEGIN(3);
    float* wscr = (float*)(lds + wave * 8448);
    float* wif = (float*)(lds + 69632);
    float* ssq = (float*)(ws + WS_SSQ);
    for (int i = tid; i < 8192; i += NTHREADS) { const int e = i >> 10, k = i & 1023; wif[i] = w_in[(size_t)k * NIN + IF_COL + e]; }
    for (int i = blockIdx.x * NTHREADS + tid; i < T; i += gridDim.x * NTHREADS) ssq[i] = 0.f;
    __syncthreads();
    transpose_matrix(w_in, NIN, D, 2048, Wt_in, wscr, gw, NGW, LANE(), nullptr, true);
    transpose_matrix(w_in + 3072, NIN, D, 2048, Wt_in + (size_t)2048 * D, wscr, gw, NGW, LANE());
    transpose_matrix(w_in + 2048, NIN, D, 1024, Wt_in + (size_t)4096 * D, wscr, gw, NGW, LANE());
    transpose_matrix(w_in + 5120, NIN, D, 2048, Wt_in + (size_t)5120 * D, wscr, gw, NGW, LANE());
    transpose_matrix(w_in + 7176, NIN, D, 4096, Wt_in + (size_t)7168 * D, wscr, gw, NGW, LANE());
    transpose_matrix(w_mem_kv, 2048, D, 2048, Wt_mkv, wscr, gw, NGW, LANE());
    transpose_matrix(w_sb, D, D, D, Wt_sb, wscr, gw, NGW, LANE());
    transpose_matrix(w_ml, D, D, D, Wt_ml, wscr, gw, NGW, LANE());
    transpose_matrix(w_x, D, D, D, Wt_x, wscr, gw, NGW, LANE());
    transpose_matrix(w_out, D, D, D, Wt_out, wscr, gw, NGW, LANE());
    transpose_matrix(w_ff1, FF, D, FF, Wt_ff1, wscr, gw, NGW, LANE(), g_mlp);
    transpose_matrix(w_ff2, D, FF, D, Wt_ff2, wscr, gw, NGW, LANE());
    { const int lane = LANE(); f32x4 cur[4];
      f32x4 gv[4]; float bif[8];
#pragma unroll
      for (int j = 0; j < 4; ++j) gv[j] = ((const f32x4*)g_mix + lane)[64 * j];
#pragma unroll
      for (int e = 0; e < 8; ++e) bif[e] = b_if[e];
#pragma unroll
      for (int j = 0; j < 4; ++j) cur[j] = ((const f32x4*)(x + (size_t)gw * D) + lane)[64 * j];
      for (int m = gw; m < T; m += NGW) { f32x4 nxt[4]; const int mn = (m + NGW < T) ? m + NGW : m;
#pragma unroll
          for (int j = 0; j < 4; ++j) nxt[j] = ((const f32x4*)(x + (size_t)mn * D) + lane)[64 * j];
          rms_row_regs(cur, gv, SLOT(0) + (size_t)m * D, wif, bif, ifp + (size_t)m * 8, lane);
#pragma unroll
          for (int j = 0; j < 4; ++j) cur[j] = nxt[j]; } }
    for (int m = gw; m < TMEM; m += NGW) rms_row<false>(mem + (size_t)m * D, g_mem, memn + (size_t)m * D, nullptr, nullptr, nullptr, LANE());
    PROBE_END(3);
    grid.sync();

    PROBE_BEGIN(7);
    { const bf16_t* hN = SLOT(0);
      gemm_fast8(lds, hN, Wt_in, T, 4096, D, EpiSeg4{SLOT(0), (bf16_t*)(ws + WS_HALOQ)});
      gemm_fast8(lds, Wt_in + (size_t)4096 * D, hN, 2048, T, D, EpiVT2{SLOT(0)});
      gemm_simple(memn, Wt_mkv, TMEM, 1024, D, 0, EpiBf16{memk, D});
      gemm_simple(Wt_mkv + (size_t)1024 * D, memn, 1024, TMEM, D, 128, EpiBf16{memvt, TMEM}); }
    PROBE_END(7);
    grid.sync();

    PROBE_BEGIN(4);
    memk_norm(memk, k_norm_g, q_norm_g, gw, NGW, LANE());
    conv_pass(SLOT(4), SLOT(5), (const bf16_t*)(ws + WS_HALOQ), (const bf16_t*)(ws + WS_HALOK), conv_w, conv_b, gw, NGW, LANE());
    PROBE_END(4);
    PROBE_BEGIN(1);
    gate_pass(ifp, (float*)(ws + WS_GATE), (float*)(ws + WS_GATE) + 32 * SEQ, (float*)(ws + WS_GATE) + 64 * SEQ, gw, NGW, LANE());
    sb_fast(SLOT(1), SLOT(2), SLOT(3), (LAS unsigned char*)lds);
    PROBE_END(1);
    grid.sync();

    PROBE_BEGIN(2);
    mlstm_fast(SLOT(4), SLOT(5), SLOT(6), (const float*)(ws + WS_GATE), (const float*)(ws + WS_GATE) + 32 * SEQ, (const float*)(ws + WS_GATE) + 64 * SEQ, hun, (LAS unsigned char*)lds);
    PROBE_END(2);
    __syncthreads();
    PROBE_BEGIN(8);
    gemm_fast8(lds, SLOT(0), Wt_in + (size_t)6144 * D, T, 2048, D, EpiSeg2{SLOT(0)});
    PROBE_END(8);
    grid.sync();

    PROBE_BEGIN(5);
    cross_lds(SLOT(2), memk, memvt, (LAS unsigned char*)lds);
    PROBE_END(5);
    PROBE_BEGIN(6);
    ml_finalize(hun, SLOT(3), ml_norm_g, SLOT(4), gw, NGW, LANE());
    PROBE_END(6);
    grid.sync();

    PROBE_BEGIN(9);
    { pg8::Gemm g{SLOT(0), Wt_in + (size_t)8192 * D, T, D, D}; GateMixOrder S; S.so.init(T, D, (int)gridDim.x, (int)blockIdx.x); EpiGateMix E{SLOT(0), b_gate};
      pg8::gemm_phase<EpiGateMix, GateMixOrder, true, true>((PG8_LAS unsigned char*)lds, g, S, E); }
    PROBE_END(9);
    grid.sync();

    PROBE_BEGIN(11);
    { pg8::Gemm g{SLOT(3), Wt_out, T, D, D}; pg8::StaticOrder S; S.init(T, D, (int)gridDim.x, (int)blockIdx.x); EpiResidSS E{x, p.out, SLOT(1), ssq};
      pg8::gemm_phase<EpiResidSS, pg8::StaticOrder, true, true>((PG8_LAS unsigned char*)lds, g, S, E); }
    PROBE_END(11);
    grid.sync();

    PROBE_BEGIN(12);
    gemm_fast8(lds, SLOT(1), Wt_ff1, T, FF, D, EpiRelu2RS{SLOT(2), FF, ssq});
    PROBE_END(12);
    grid.sync();

    PROBE_BEGIN(13);
    { pg8::Gemm g{SLOT(2), Wt_ff2, T, D, FF}; pg8::StaticOrder S; S.init(T, D, (int)gridDim.x, (int)blockIdx.x); EpiResidIn E{SLOT(1), p.out};
      pg8::gemm_phase<EpiResidIn, pg8::StaticOrder, true, true>((PG8_LAS unsigned char*)lds, g, S, E); }
    PROBE_END(13);
    if (PROBE_PHASE != 0) { const unsigned long long te = __builtin_amdgcn_s_memrealtime(); while (__builtin_amdgcn_s_memrealtime() - te < probe_dur) __builtin_amdgcn_s_sleep(8); }
}

extern "C" void kernel_launch(void* const* d_in, const int* in_sizes, int n_in, void* d_out, int out_size, void* d_ws, size_t ws_size, hipStream_t stream) {
    static int grid_blocks = 0;
    if (grid_blocks == 0) {
        if (n_in != 20 || out_size != T * D || ws_size < WS_NEED) { fprintf(stderr, "kernel_launch: unexpected shapes (n_in %d out %d ws %zu)\n", n_in, out_size, ws_size); grid_blocks = -1; return; }
        int dev = 0, cus = 0, per_cu = 0;
        hipGetDevice(&dev);
        hipDeviceGetAttribute(&cus, hipDeviceAttributeMultiprocessorCount, dev);
        hipFuncSetAttribute((const void*)fwd_megakernel, hipFuncAttributeMaxDynamicSharedMemorySize, LDS_BYTES);
        hipOccupancyMaxActiveBlocksPerMultiprocessor(&per_cu, (const void*)fwd_megakernel, NTHREADS, LDS_BYTES);
        if (per_cu < 1) per_cu = 1;
        grid_blocks = cus * per_cu;
    }
    if (grid_blocks < 0) return;
    Params p{};
    for (int i = 0; i < 20; ++i) p.in[i] = (const float*)d_in[i];
    p.out = (float*)d_out; p.ws = (unsigned char*)d_ws;
    void* args[] = {&p};
    hipError_t e = hipLaunchCooperativeKernel((const void*)fwd_megakernel, dim3(grid_blocks), dim3(NTHREADS), args, LDS_BYTES, stream);
    if (e != hipSuccess) fprintf(stderr, "cooperative launch failed: %s (grid %d)\n", hipGetErrorString(e), grid_blocks);
}
```

```cpp
#include <hip/hip_runtime.h>
#include <hip/hip_cooperative_groups.h>
#include <cstdint>
#include <cstdio>
namespace cg = cooperative_groups;

typedef unsigned short bf16_t;
typedef short bf16x8 __attribute__((ext_vector_type(8)));
typedef float f32x4 __attribute__((ext_vector_type(4)));
typedef unsigned u32x2 __attribute__((ext_vector_type(2)));
typedef unsigned u32x4 __attribute__((ext_vector_type(4)));

constexpr int D = 1024, BATCH = 8, SEQ = 4096, T = BATCH * SEQ, NMEM = 256, TMEM = BATCH * NMEM, FF = 4096;
constexpr int NIN = 11272;
constexpr int IF_COL = 7168;
constexpr float EPS = 1e-6f;
constexpr int NTHREADS = 512, NWAVES = 8;
constexpr int LDS_BYTES = 144 * 1024;
#ifndef PROBE_PHASE
#define PROBE_PHASE 0
#endif
#define PROBE_BEGIN(k) do { if (PROBE_PHASE & (1 << (k))) probe_t0 = __builtin_amdgcn_s_memrealtime(); } while (0)
#define PROBE_END(k) do { if (PROBE_PHASE & (1 << (k))) probe_dur += __builtin_amdgcn_s_memrealtime() - probe_t0; } while (0)

constexpr size_t MiB = (size_t)1 << 20;
constexpr size_t WS_WIN = 0;
constexpr size_t WS_WMKV = 22 * MiB;
constexpr size_t WS_WSB = 26 * MiB, WS_WML = 28 * MiB, WS_WX = 30 * MiB, WS_WOUT = 32 * MiB;
constexpr size_t WS_WFF1 = 34 * MiB;
constexpr size_t WS_WFF2 = 42 * MiB;
constexpr size_t WS_IF = 50 * MiB;
constexpr size_t WS_GATE = 58 * MiB;
constexpr size_t WS_BAR = 60 * MiB, WS_BAR_BYTES = 16384;
constexpr size_t WS_SSQ = 57 * MiB;
constexpr size_t WS_HALOQ = 51 * MiB, WS_HALOK = 54 * MiB;
constexpr size_t WS_SLOT0 = 64 * MiB, SLOT_BYTES = 64 * MiB;
constexpr size_t WS_NEED = WS_SLOT0 + 7 * SLOT_BYTES;
constexpr size_t DO_MEMN = 0;
constexpr size_t DO_MEMK = 4 * MiB;
constexpr size_t DO_MEMVT = 8 * MiB;
constexpr size_t DO_HUN = 64 * MiB;

struct Params { const float* in[20]; float* out; unsigned char* ws; };

__device__ __forceinline__ unsigned f2bf(float f) { unsigned u = __builtin_bit_cast(unsigned, f); return (u + 0x7fffu + ((u >> 16) & 1u)) >> 16; }
typedef float f32x2_t __attribute__((ext_vector_type(2))); typedef __bf16 bf16x2_t __attribute__((ext_vector_type(2)));
__device__ __forceinline__ unsigned pk2(float lo, float hi) { f32x2_t v = {lo, hi}; bf16x2_t b = __builtin_convertvector(v, bf16x2_t); return __builtin_bit_cast(unsigned, b); }
__device__ __forceinline__ float bf2f(bf16_t v) { return __builtin_bit_cast(float, (unsigned)v << 16); }
__device__ __forceinline__ float bflo(unsigned w) { return __builtin_bit_cast(float, w << 16); }
__device__ __forceinline__ float bfhi(unsigned w) { return __builtin_bit_cast(float, w & 0xffff0000u); }
__device__ __forceinline__ float row16_sum(float v) {
    v += __builtin_bit_cast(float, __builtin_amdgcn_update_dpp(0, __builtin_bit_cast(int, v), 0xB1, 0xF, 0xF, true));
    v += __builtin_bit_cast(float, __builtin_amdgcn_update_dpp(0, __builtin_bit_cast(int, v), 0x4E, 0xF, 0xF, true));
    v += __builtin_bit_cast(float, __builtin_amdgcn_update_dpp(0, __builtin_bit_cast(int, v), 0x141, 0xF, 0xF, true));
    v += __builtin_bit_cast(float, __builtin_amdgcn_update_dpp(0, __builtin_bit_cast(int, v), 0x140, 0xF, 0xF, true));
    return v;
}
__device__ __forceinline__ float wave_sum(float v) { v = row16_sum(v); v += __shfl_xor(v, 16); v += __shfl_xor(v, 32); return v; }
__device__ __forceinline__ float wave_max(float v) {
#pragma unroll
    for (int o = 1; o < 64; o <<= 1) v = fmaxf(v, __shfl_xor(v, o));
    return v;
}
__device__ __forceinline__ float sigmoidf_(float x) { return __builtin_amdgcn_rcpf(1.f + __builtin_amdgcn_exp2f(x * -1.4426950408889634f)); }
#define LDS_WAIT() asm volatile("s_waitcnt lgkmcnt(0)" ::: "memory")
#define LDS_BARRIER() do { asm volatile("s_waitcnt lgkmcnt(0)" ::: "memory"); __builtin_amdgcn_s_barrier(); asm volatile("" ::: "memory"); } while (0)

__device__ __forceinline__ void transpose_item(const float* W, int ldw, int K, bf16_t* WT, int k0, int n0, float* scr, int lane, const float* kscale, float cs = 1.f) {
#pragma unroll 8
    for (int i = 0; i < 32; ++i) { const int kk = 2 * i + (lane >> 5); float v = W[(size_t)(k0 + kk) * ldw + n0 + (lane & 31)] * cs; if (kscale) v *= kscale[k0 + kk]; scr[kk * 33 + (lane & 31)] = v; }
    LDS_WAIT();
    const int c = lane & 7;
#pragma unroll
    for (int j = 0; j < 4; ++j) { const int n = (lane >> 3) + 8 * j; const float* s = scr + (8 * c) * 33 + n;
        u32x4 o; o.x = pk2(s[0 * 33], s[1 * 33]); o.y = pk2(s[2 * 33], s[3 * 33]); o.z = pk2(s[4 * 33], s[5 * 33]); o.w = pk2(s[6 * 33], s[7 * 33]);
        *(u32x4*)(WT + (size_t)(n0 + n) * K + k0 + 8 * c) = o; }
    LDS_WAIT();
}
constexpr float SB_QSCALE = -0.08838834764831845f * 1.4426950408889634f;
__device__ __forceinline__ void transpose_matrix(const float* W, int ldw, int K, int N, bf16_t* WT, float* scr, int gw, int NGW, int lane, const float* kscale = nullptr, bool sbq = false) {
    const int nblk = N / 32, items = (K / 64) * nblk;
    for (int it = gw; it < items; it += NGW) { const int kb = it / nblk, nb = it % nblk; transpose_item(W, ldw, K, WT, 64 * kb, 32 * nb, scr, lane, kscale, (sbq && nb < 32) ? SB_QSCALE : 1.f); }
}

template <bool WITH_IF>
__device__ __forceinline__ void rms_row(const float* xrow, const float* g, bf16_t* orow, const float* wif  , const float* b_if, float* ifout, int lane) {
    const f32x4* xr = (const f32x4*)xrow + lane; const f32x4* gr = (const f32x4*)g + lane;
    f32x4 v[4]; float s = 0.f;
#pragma unroll
    for (int j = 0; j < 4; ++j) { v[j] = xr[64 * j]; s += (v[j].x * v[j].x + v[j].y * v[j].y) + (v[j].z * v[j].z + v[j].w * v[j].w); }
    const float r = rsqrtf(wave_sum(s) * (1.f / D) + EPS);
#pragma unroll
    for (int j = 0; j < 4; ++j) v[j] = v[j] * r * gr[64 * j];
    u32x2* o8 = (u32x2*)orow + lane;
#pragma unroll
    for (int j = 0; j < 4; ++j) { u32x2 w; w.x = pk2(v[j].x, v[j].y); w.y = pk2(v[j].z, v[j].w); o8[64 * j] = w; }
    if (WITH_IF) {
        float a[8];
#pragma unroll
        for (int e = 0; e < 8; ++e) { a[e] = 0.f;
#pragma unroll
            for (int j = 0; j < 4; ++j) { const f32x4 w = *(const f32x4*)(wif + e * 1024 + 256 * j + 4 * lane); a[e] += (v[j].x * w.x + v[j].y * w.y) + (v[j].z * w.z + v[j].w * w.w); }
            a[e] = wave_sum(a[e]); }
        if (lane == 0) {
#pragma unroll
            for (int e = 0; e < 8; ++e) ifout[e] = a[e] + b_if[e]; }
    }
}

__device__ __forceinline__ void rms_row_regs(const f32x4 (&vin)[4], const f32x4 (&gv)[4], bf16_t* orow, const float* wif  , const float (&bif)[8], float* ifout, int lane) {
    f32x4 v[4]; float s = 0.f;
#pragma unroll
    for (int j = 0; j < 4; ++j) { v[j] = vin[j]; s += (v[j].x * v[j].x + v[j].y * v[j].y) + (v[j].z * v[j].z + v[j].w * v[j].w); }
    const float r = rsqrtf(wave_sum(s) * (1.f / D) + EPS);
#pragma unroll
    for (int j = 0; j < 4; ++j) v[j] = v[j] * r * gv[j];
    u32x2* o8 = (u32x2*)orow + lane;
#pragma unroll
    for (int j = 0; j < 4; ++j) { u32x2 w; w.x = pk2(v[j].x, v[j].y); w.y = pk2(v[j].z, v[j].w); o8[64 * j] = w; }
    float a[8];
#pragma unroll
    for (int e = 0; e < 8; ++e) { a[e] = 0.f;
#pragma unroll
        for (int j = 0; j < 4; ++j) { const f32x4 w = *(const f32x4*)(wif + e * 1024 + 256 * j + 4 * lane); a[e] += (v[j].x * w.x + v[j].y * w.y) + (v[j].z * w.z + v[j].w * w.w); } }
#pragma unroll
    for (int e = 0; e < 8; ++e) a[e] = row16_sum(a[e]);
#pragma unroll
    for (int e = 0; e < 8; ++e) a[e] += __shfl_xor(a[e], 16);
#pragma unroll
    for (int e = 0; e < 8; ++e) a[e] += __shfl_xor(a[e], 32);
    if (lane == 0) { f32x4 o0 = (f32x4){a[0] + bif[0], a[1] + bif[1], a[2] + bif[2], a[3] + bif[3]}, o1 = (f32x4){a[4] + bif[4], a[5] + bif[5], a[6] + bif[6], a[7] + bif[7]}; *(f32x4*)ifout = o0; *(f32x4*)(ifout + 4) = o1; }
}

namespace pg8 {
#define PG8_LAS __attribute__((address_space(3)))
typedef unsigned short bf16_t;
typedef short bf16x8 __attribute__((ext_vector_type(8)));
typedef float f32x4 __attribute__((ext_vector_type(4)));
typedef unsigned u32x4 __attribute__((ext_vector_type(4)));
constexpr int BM = 256, BK = 64, HALF = 128, HTB = HALF * BK * 2  , STAGE_BYTES = 8 * HTB, NXCD = 8, WGM = 8;

__host__ __device__ __forceinline__ int lds_byte(int r, int c) { const int st = (r >> 4) * 2 + (c >> 5), rr = r & 15, cc = c & 31, ob = rr * 64 + cc * 2; return st * 1024 + (ob ^ (((ob >> 9) & 1) << 5)); }
__host__ __device__ __forceinline__ void stage_rc(int b, int& R, int& C) { const int st = b / 1024, sb = b % 1024, swz = sb ^ (((sb >> 9) & 1) << 5); R = (st >> 1) * 16 + swz / 64; C = (st & 1) * 32 + (swz % 64) / 2; }
__host__ __device__ __forceinline__ int perm32(int rho) { const int n = rho >> 4, i = rho & 15; return 8 * (i >> 2) + 4 * n + (i & 3); }

struct Unit { int pm, pn; };
struct Gemm { const bf16_t* A; const bf16_t* Bt; int M, N, K; };

struct StaticOrder {
    int nM, nN, nwg, G, c;
    __host__ __device__ void init(int M, int N, int G_, int c_) { nM = M / BM; nN = N / BM; nwg = nM * nN; G = G_; c = c_; }
    __host__ __device__ bool next(int i, Unit& u) const {
        const long L = (long)i * G + c; if (L >= nwg) return false;
        int wgid = (int)L; { const int q = nwg / NXCD, r = nwg % NXCD, xcd = wgid % NXCD, off = wgid / NXCD; wgid = (xcd < r ? xcd * (q + 1) : r * (q + 1) + (xcd - r) * q) + off; }
        const int nig = WGM * nN, gid = wgid / nig, fm = gid * WGM, gsz = (nM - fm) < WGM ? (nM - fm) : WGM;
        u.pm = fm + ((wgid % nig) % gsz); u.pn = (wgid % nig) / gsz; return true;
    }
    __device__ __forceinline__ void a_ready(const Unit&) const {}
    __device__ __forceinline__ void done(const Unit&) const {}
};
template <class Epi, class Sched, bool ALIGN_EPI = false, bool SP2 = false>
__device__ __forceinline__ void gemm_phase(PG8_LAS unsigned char* lds, const Gemm g, const Sched& S, const Epi& E) {
    int tid_ = threadIdx.x; asm volatile("" : "+v"(tid_));
    const int tid = tid_, wid = __builtin_amdgcn_readfirstlane(tid >> 6), lane = tid & 63, wr = wid >> 2, wc = wid & 3, fr = lane & 15, fq = lane >> 4;
    const int K = g.K, nt = K / BK;
    unsigned voffA[2], voffB[2];
#pragma unroll
    for (int i = 0; i < 2; ++i) { int R, C; stage_rc(tid * 16 + i * 8192, R, C); const int Rb = Epi::PERM ? ((R & ~31) + perm32(R & 31)) : R;
        voffA[i] = (unsigned)(R * K + C) * 2u; voffB[i] = (unsigned)(Rb * K + C) * 2u; }
    const size_t kstep = (size_t)(BK * 2);
    const size_t hstep = (size_t)HALF * K * 2;
    const size_t tstep = 2 * hstep;
    const unsigned ldsw = (unsigned)wid * 1024u;
    const int aoff = lds_byte(wr * 64 + fr, fq * 8), boff = lds_byte(wc * 32 + fr, fq * 8);
#define PG8_SA(b, h) (((b) * 2 + (h)) * HTB)
#define PG8_SB(b, h) ((4 + (b) * 2 + (h)) * HTB)
#define PG8_STAGE(bufoff, gbase, voff) do { _Pragma("unroll") for (int _i = 0; _i < 2; ++_i) \
        __builtin_amdgcn_global_load_lds((const unsigned*)((const char*)(gbase) + (voff)[_i]), (PG8_LAS unsigned*)(lds + (bufoff) + ldsw + _i * 8192), 16, 0, 0); } while (0)
#define PG8_LDA(dst, b, h) do { _Pragma("unroll") for (int m = 0; m < 4; ++m) _Pragma("unroll") for (int k = 0; k < 2; ++k) dst[m][k] = *(const PG8_LAS bf16x8*)(lds + PG8_SA(b, h) + aoff + m * 2048 + k * 1024); } while (0)
#define PG8_LDB(dst, b, h) do { _Pragma("unroll") for (int n = 0; n < 2; ++n) _Pragma("unroll") for (int k = 0; k < 2; ++k) dst[n][k] = *(const PG8_LAS bf16x8*)(lds + PG8_SB(b, h) + boff + n * 2048 + k * 1024); } while (0)
#define PG8_MMA(ai, bj, At, Bt) do { __builtin_amdgcn_s_setprio(1); _Pragma("unroll") for (int m = 0; m < 4; ++m) _Pragma("unroll") for (int n = 0; n < 2; ++n) _Pragma("unroll") for (int k = 0; k < 2; ++k) \
        acc[ai][bj][m][n] = __builtin_amdgcn_mfma_f32_16x16x32_bf16(Bt[n][k], At[m][k], acc[ai][bj][m][n], 0, 0, 0); __builtin_amdgcn_s_setprio(0); } while (0)
#define PG8_WAIT_V(n) asm volatile("s_waitcnt vmcnt(" #n ")" ::: "memory")
#define PG8_WAIT_L(n) asm volatile("s_waitcnt lgkmcnt(" #n ")" ::: "memory")
#define PG8_BAR __builtin_amdgcn_s_barrier()
#define PG8_SCHED __builtin_amdgcn_sched_barrier(0)
    Unit cur, nxt; int ui = 0;
    if (!S.next(0, cur)) return;
    f32x4 acc[2][2][4][2];
#pragma unroll
    for (int a = 0; a < 2; ++a)
#pragma unroll
        for (int b = 0; b < 2; ++b)
#pragma unroll
            for (int m = 0; m < 4; ++m)
#pragma unroll
                for (int n = 0; n < 2; ++n) acc[a][b][m][n] = (f32x4){0.f, 0.f, 0.f, 0.f};
    bf16x8 At[4][2], B0[2][2], B1[2][2];
    const char* cA = (const char*)g.A + (size_t)cur.pm * tstep; const char* cB = (const char*)g.Bt + (size_t)cur.pn * tstep;
    S.a_ready(cur);
    if constexpr (SP2) {
        PG8_STAGE(PG8_SB(0, 0), cB, voffB); PG8_STAGE(PG8_SB(0, 1), cB + hstep, voffB); PG8_STAGE(PG8_SA(0, 0), cA, voffA); PG8_STAGE(PG8_SA(0, 1), cA + hstep, voffA);
        if (wr == 1) PG8_BAR;
        PG8_WAIT_V(2); PG8_BAR;
        PG8_STAGE(PG8_SB(1, 0), cB + kstep, voffB); PG8_STAGE(PG8_SA(1, 0), cA + kstep, voffA); PG8_STAGE(PG8_SB(1, 1), cB + hstep + kstep, voffB);
        PG8_WAIT_V(6); PG8_BAR;
    } else {
        PG8_STAGE(PG8_SB(0, 0), cB, voffB); PG8_STAGE(PG8_SA(0, 0), cA, voffA); PG8_STAGE(PG8_SB(0, 1), cB + hstep, voffB); PG8_STAGE(PG8_SA(0, 1), cA + hstep, voffA);
        if (wr == 1) PG8_BAR;
        PG8_WAIT_V(4); PG8_BAR;
        PG8_STAGE(PG8_SB(1, 0), cB + kstep, voffB); PG8_STAGE(PG8_SA(1, 0), cA + kstep, voffA); PG8_STAGE(PG8_SB(1, 1), cB + hstep + kstep, voffB);
        PG8_WAIT_V(6); PG8_BAR;
    }
    for (;;) {
        const bool has_next = S.next(ui + 1, nxt);
        const char* nA = has_next ? (const char*)g.A + (size_t)nxt.pm * tstep : cA; const char* nB = has_next ? (const char*)g.Bt + (size_t)nxt.pn * tstep : cB;
        for (int t = 0; t < nt; t += 2) {
            const bool last = (t == nt - 2);
            const char* a1 = cA + (size_t)(t + 1) * kstep;
            const char* a2 = last ? nA : cA + (size_t)(t + 2) * kstep; const char* b2 = last ? nB : cB + (size_t)(t + 2) * kstep;
            const char* a3 = a2 + kstep; const char* b3 = b2 + kstep;
            if (last && has_next) S.a_ready(nxt);
            if constexpr (SP2) {
            PG8_LDB(B0, 0, 0); PG8_LDB(B1, 0, 1); PG8_SCHED; PG8_LDA(At, 0, 0); PG8_STAGE(PG8_SA(1, 1), a1 + hstep, voffA);
            PG8_WAIT_V(8); PG8_WAIT_L(0); PG8_BAR; PG8_MMA(0, 0, At, B0); PG8_MMA(0, 1, At, B1); PG8_BAR; PG8_SCHED;
            PG8_LDA(At, 0, 1); PG8_STAGE(PG8_SB(0, 0), b2, voffB); PG8_STAGE(PG8_SB(0, 1), b2 + hstep, voffB); PG8_STAGE(PG8_SA(0, 0), a2, voffA);
            PG8_WAIT_V(8); PG8_WAIT_L(0); PG8_BAR; PG8_MMA(1, 0, At, B0); PG8_MMA(1, 1, At, B1); PG8_BAR; PG8_SCHED;
            PG8_LDB(B0, 1, 0); PG8_LDB(B1, 1, 1); PG8_SCHED; PG8_LDA(At, 1, 0); PG8_STAGE(PG8_SA(0, 1), a2 + hstep, voffA);
            PG8_WAIT_V(8); PG8_WAIT_L(0); PG8_BAR; PG8_MMA(0, 0, At, B0); PG8_MMA(0, 1, At, B1); PG8_BAR; PG8_SCHED;
            PG8_LDA(At, 1, 1); PG8_STAGE(PG8_SB(1, 0), b3, voffB); PG8_STAGE(PG8_SB(1, 1), b3 + hstep, voffB); PG8_STAGE(PG8_SA(1, 0), a3, voffA);
            PG8_WAIT_V(8); PG8_WAIT_L(0); PG8_BAR; PG8_MMA(1, 0, At, B0); PG8_MMA(1, 1, At, B1); PG8_BAR; PG8_SCHED;
            } else {
            PG8_LDB(B0, 0, 0); PG8_SCHED; PG8_LDA(At, 0, 0); PG8_STAGE(PG8_SA(1, 1), a1 + hstep, voffA);
            PG8_WAIT_L(8); PG8_BAR; PG8_WAIT_L(0); PG8_MMA(0, 0, At, B0); PG8_BAR; PG8_SCHED;
            PG8_LDB(B1, 0, 1); PG8_STAGE(PG8_SB(0, 0), b2, voffB);
            PG8_BAR; PG8_WAIT_L(0); PG8_MMA(0, 1, At, B1); PG8_BAR;
            PG8_LDA(At, 0, 1); PG8_STAGE(PG8_SA(0, 0), a2, voffA);
            PG8_BAR; PG8_WAIT_L(0); PG8_MMA(1, 0, At, B0); PG8_BAR; PG8_SCHED;
            PG8_STAGE(PG8_SB(0, 1), b2 + hstep, voffB);
            PG8_WAIT_V(6); PG8_BAR; PG8_MMA(1, 1, At, B1); PG8_BAR;
            PG8_LDB(B0, 1, 0); PG8_SCHED; PG8_LDA(At, 1, 0); PG8_STAGE(PG8_SA(0, 1), a2 + hstep, voffA);
            PG8_WAIT_L(8); PG8_BAR; PG8_WAIT_L(0); PG8_MMA(0, 0, At, B0); PG8_BAR; PG8_SCHED;
            PG8_LDB(B1, 1, 1); PG8_STAGE(PG8_SB(1, 0), b3, voffB);
            PG8_BAR; PG8_WAIT_L(0); PG8_MMA(0, 1, At, B1); PG8_BAR;
            PG8_LDA(At, 1, 1); PG8_STAGE(PG8_SA(1, 0), a3, voffA);
            PG8_BAR; PG8_WAIT_L(0); PG8_MMA(1, 0, At, B0); PG8_BAR; PG8_SCHED;
            PG8_STAGE(PG8_SB(1, 1), b3 + hstep, voffB);
            PG8_WAIT_V(6); PG8_BAR; PG8_MMA(1, 1, At, B1); PG8_BAR;
            }
        }
        if constexpr (ALIGN_EPI) { if (wr == 0) PG8_BAR; }
        if constexpr (!Epi::AFTER_DRAIN) { E(acc, cur, wr, wc, fr, fq); S.done(cur); }
        if (!has_next) break;
#pragma unroll
        for (int a = 0; a < 2; ++a)
#pragma unroll
            for (int b = 0; b < 2; ++b)
#pragma unroll
                for (int m = 0; m < 4; ++m)
#pragma unroll
                    for (int n = 0; n < 2; ++n) acc[a][b][m][n] = (f32x4){0.f, 0.f, 0.f, 0.f};
        cur = nxt; cA = nA; cB = nB; ++ui;
        if constexpr (ALIGN_EPI) { if (wr == 1) PG8_BAR; }
    }
    PG8_WAIT_V(0);
    if constexpr (!ALIGN_EPI) { if (wr == 0) PG8_BAR; }
    PG8_BAR;
    if constexpr (Epi::AFTER_DRAIN) { E.fused(acc, cur, wr, wc, fr, fq, lds, wid, lane); S.done(cur); }
#undef PG8_SA
#undef PG8_SB
#undef PG8_STAGE
#undef PG8_LDA
#undef PG8_LDB
#undef PG8_MMA
#undef PG8_WAIT_V
#undef PG8_WAIT_L
#undef PG8_BAR
#undef PG8_SCHED
}
}

template <class EW> struct EpiAdapt { static constexpr bool PERM = false, AFTER_DRAIN = false; EW e;
    __device__ __forceinline__ void operator()(const f32x4 (&acc)[2][2][4][2], const pg8::Unit& u, int wr, int wc, int fr, int fq) const {
#pragma unroll
        for (int ai = 0; ai < 2; ++ai)
#pragma unroll
            for (int m = 0; m < 4; ++m) { const int row = u.pm * 256 + ai * 128 + wr * 64 + m * 16 + fr;
#pragma unroll
                for (int bj = 0; bj < 2; ++bj)
#pragma unroll
                    for (int n = 0; n < 2; ++n) e(row, u.pn * 256 + bj * 128 + wc * 32 + n * 16 + 4 * fq, acc[ai][bj][m][n]); } } };
template <class EW> struct EpiAdapt8 { static constexpr bool PERM = true, AFTER_DRAIN = false; EW e;
    __device__ __forceinline__ void operator()(const f32x4 (&acc)[2][2][4][2], const pg8::Unit& u, int wr, int wc, int fr, int fq) const {
#pragma unroll
        for (int ai = 0; ai < 2; ++ai)
#pragma unroll
            for (int m = 0; m < 4; ++m) { const int row = u.pm * 256 + ai * 128 + wr * 64 + m * 16 + fr;
#pragma unroll
                for (int bj = 0; bj < 2; ++bj) e(row, u.pn * 256 + bj * 128 + wc * 32 + 8 * fq, acc[ai][bj][m][0], acc[ai][bj][m][1]); } } };
template <class EW>
__device__ __forceinline__ void gemm_fast8(unsigned char* lds, const bf16_t* A, const bf16_t* Bt, int M, int N, int K, const EW& e) {
    pg8::Gemm g{A, Bt, M, N, K}; pg8::StaticOrder S; S.init(M, N, (int)gridDim.x, (int)blockIdx.x);
    EpiAdapt8<EW> E{e};
    pg8::gemm_phase<EpiAdapt8<EW>, pg8::StaticOrder, true, true>((PG8_LAS unsigned char*)lds, g, S, E);
}
template <class EW>
__device__ __forceinline__ void gemm_fast(unsigned char* lds, const bf16_t* A, const bf16_t* Bt, int M, int N, int K, const EW& e) {
    pg8::Gemm g{A, Bt, M, N, K}; pg8::StaticOrder S; S.init(M, N, (int)gridDim.x, (int)blockIdx.x);
    EpiAdapt<EW> E{e};
    pg8::gemm_phase<EpiAdapt<EW>, pg8::StaticOrder, true, true>((PG8_LAS unsigned char*)lds, g, S, E);
}

struct EpiBf16 { bf16_t* O; int ldc;
    __device__ __forceinline__ void operator()(int r, int c, f32x4 v) const { u32x2 w; w.x = pk2(v.x, v.y); w.y = pk2(v.z, v.w); *(u32x2*)(O + (size_t)r * ldc + c) = w; } };
struct EpiBf16Halo { bf16_t* O; bf16_t* H;
    __device__ __forceinline__ void operator()(int r, int c, f32x4 v) const { u32x2 w; w.x = pk2(v.x, v.y); w.y = pk2(v.z, v.w); *(u32x2*)(O + (size_t)r * D + c) = w;
        const int rr = r & 63; if (rr >= 61) *(u32x2*)(H + ((size_t)(r >> 6) * 3 + (rr - 61)) * D + c) = w; } };
struct EpiGate { bf16_t* S0; const float* bias;
    __device__ __forceinline__ void operator()(int r, int c, f32x4 v) const { const f32x4 b = *(const f32x4*)(bias + c); const int s = c >> 10, cc = c & 1023; bf16_t* O = S0 + (size_t)(3 + s + (s > 0 ? 1 : 0)) * (SLOT_BYTES / 2);
        u32x2 w; w.x = pk2(sigmoidf_(v.x + b.x), sigmoidf_(v.y + b.y)); w.y = pk2(sigmoidf_(v.z + b.z), sigmoidf_(v.w + b.w)); *(u32x2*)(O + (size_t)r * D + cc) = w; } };
template <int MODE>
struct EpiMix { const bf16_t* G; float* Mx; bf16_t* O;
    __device__ __forceinline__ void operator()(int r, int c, f32x4 v) const { const size_t off = (size_t)r * D + c; const u32x2 gw = *(const u32x2*)(G + off);
        f32x4 m = (f32x4){bflo(gw.x) * v.x, bfhi(gw.x) * v.y, bflo(gw.y) * v.z, bfhi(gw.y) * v.w};
        if (MODE >= 1) m = m + *(const f32x4*)(Mx + off);
        if (MODE <= 1) *(f32x4*)(Mx + off) = m; else { u32x2 w; w.x = pk2(m.x, m.y); w.y = pk2(m.z, m.w); *(u32x2*)(O + off) = w; } } };
struct EpiResid { const float* base; float* out;
    __device__ __forceinline__ void operator()(int r, int c, f32x4 v) const { const size_t off = (size_t)r * D + c; *(f32x4*)(out + off) = *(const f32x4*)(base + off) + v; } };
struct EpiRelu2 { bf16_t* O; int ldc;
    __device__ __forceinline__ void operator()(int r, int c, f32x4 v) const { f32x4 t = (f32x4){fmaxf(v.x, 0.f), fmaxf(v.y, 0.f), fmaxf(v.z, 0.f), fmaxf(v.w, 0.f)}; t = t * t;
        u32x2 w; w.x = pk2(t.x, t.y); w.y = pk2(t.z, t.w); *(u32x2*)(O + (size_t)r * ldc + c) = w; } };

__device__ __forceinline__ void sb_naive(bf16_t* Q, const bf16_t* Kk, const bf16_t* VT, float* qs, int gw, int NGW, int lane) {
    const float scale = 0.08838834764831845f;
    for (int w = gw; w < 2048; w += NGW) {
        for (int i = 0; i < 128; ++i) {
            const int bh = i >> 1, t = (i & 1) ? (SEQ - 1 - w) : w, b = bh >> 3, h = bh & 7;
            const size_t row = (size_t)b * SEQ + t;
            bf16_t* qrow = Q + row * D + h * 128;
            { const unsigned qw = *(const unsigned*)(qrow + 2 * lane); qs[2 * lane] = bflo(qw) * scale; qs[2 * lane + 1] = bfhi(qw) * scale; }
            LDS_WAIT();
            float acc[128];
#pragma unroll
            for (int d = 0; d < 128; ++d) acc[d] = 0.f;
            float R = 0.f;
            const int nb = (t + 63) >> 6;
            for (int blk = nb - 1; blk >= 0; --blk) {
                const int s = blk * 64 + lane; const bool valid = s < t;
                const bf16_t* krow = Kk + ((size_t)b * SEQ + s) * D + h * 128;
                float z = 0.f;
#pragma unroll
                for (int c = 0; c < 16; ++c) { const u32x4 kw = *(const u32x4*)(krow + 8 * c); const f32x4 q0 = *(const f32x4*)(qs + 8 * c), q1 = *(const f32x4*)(qs + 8 * c + 4);
                    z += bflo(kw.x) * q0.x + bfhi(kw.x) * q0.y + bflo(kw.y) * q0.z + bfhi(kw.y) * q0.w + bflo(kw.z) * q1.x + bfhi(kw.z) * q1.y + bflo(kw.w) * q1.z + bfhi(kw.w) * q1.w; }
                const float e = __expf(-fabsf(z)); const float sp = fmaxf(z, 0.f) + __logf(1.f + e);
                const float lm = valid ? -sp : 0.f, ls = z - sp;
                float incl = lm;
#pragma unroll
                for (int off = 1; off < 64; off <<= 1) { const float tmp = __shfl_down(incl, off); if (lane + off < 64) incl += tmp; }
                const float later = R + incl - lm;
                const float p = valid ? __expf(ls + later) : 0.f;
                R += __shfl(incl, 0);
                const bf16_t* vcol = VT + (size_t)(h * 128) * T + (size_t)b * SEQ + s;
#pragma unroll
                for (int d0 = 0; d0 < 128; d0 += 16) {
#pragma unroll
                    for (int d = d0; d < d0 + 16; ++d) acc[d] += p * bf2f(vcol[(size_t)d * T]);
                    asm volatile("" ::: "memory"); }
            }
            float o0 = 0.f, o1 = 0.f;
#pragma unroll
            for (int d = 0; d < 128; ++d) { const float tot = wave_sum(acc[d]); if ((d & 63) == lane) { if (d < 64) o0 = tot; else o1 = tot; } }
            qrow[lane] = (bf16_t)f2bf(o0); qrow[64 + lane] = (bf16_t)f2bf(o1);
            LDS_WAIT();
        }
    }
}

template <class Epi>
__device__ __forceinline__ void gemm_simple(const bf16_t* A, const bf16_t* Bt, int M, int N, int K, int u0, const Epi& E) {
    const int tid = threadIdx.x, wid = tid >> 6, lane = tid & 63, wr = wid >> 2, wc = wid & 3, fr = lane & 15, fq = lane >> 4;
    const int nN = N / 128, nU = (M / 128) * nN;
    for (int uu = blockIdx.x; uu < u0 + nU; uu += gridDim.x) { if (uu < u0) continue; const int u = uu - u0;
        const int pm = u / nN, pn = u % nN, row0 = pm * 128 + wr * 64, col0 = pn * 128 + wc * 32;
        f32x4 acc[4][2];
#pragma unroll
        for (int m = 0; m < 4; ++m)
#pragma unroll
            for (int n = 0; n < 2; ++n) acc[m][n] = (f32x4){0.f, 0.f, 0.f, 0.f};
        const bf16_t* ap = A + (size_t)(row0 + fr) * K + fq * 8; const bf16_t* bp = Bt + (size_t)(col0 + fr) * K + fq * 8;
#pragma unroll 2
        for (int k0 = 0; k0 < K; k0 += 32) { bf16x8 a[4], b[2];
#pragma unroll
            for (int m = 0; m < 4; ++m) a[m] = *(const bf16x8*)(ap + (size_t)m * 16 * K + k0);
#pragma unroll
            for (int n = 0; n < 2; ++n) b[n] = *(const bf16x8*)(bp + (size_t)n * 16 * K + k0);
#pragma unroll
            for (int m = 0; m < 4; ++m)
#pragma unroll
                for (int n = 0; n < 2; ++n) acc[m][n] = __builtin_amdgcn_mfma_f32_16x16x32_bf16(b[n], a[m], acc[m][n], 0, 0, 0); }
#pragma unroll
        for (int m = 0; m < 4; ++m)
#pragma unroll
            for (int n = 0; n < 2; ++n) E(row0 + m * 16 + fr, col0 + n * 16 + 4 * fq, acc[m][n]); }
}

constexpr size_t SLOT_ELEMS = SLOT_BYTES / 2;
struct EpiSeg4 { bf16_t* S0; bf16_t* HQ;
    __device__ __forceinline__ void operator()(int r, int c, f32x4 v) const { const int seg = c >> 10, cc = c & 1023; bf16_t* O = S0 + (size_t)(seg + 1 + (seg >= 2 ? 1 : 0)) * SLOT_ELEMS;
        u32x2 w; w.x = pk2(v.x, v.y); w.y = pk2(v.z, v.w); *(u32x2*)(O + (size_t)r * D + cc) = w;
        const int rr = r & 63; if (seg >= 2 && rr >= 61) *(u32x2*)(HQ + (size_t)(seg - 2) * (3 * MiB / 2) + ((size_t)(r >> 6) * 3 + (rr - 61)) * D + cc) = w; }
    __device__ __forceinline__ void operator()(int r, int c, f32x4 v0, f32x4 v1) const { const int seg = c >> 10, cc = c & 1023; bf16_t* O = S0 + (size_t)(seg + 1 + (seg >= 2 ? 1 : 0)) * SLOT_ELEMS; u32x4 w; w.x = pk2(v0.x, v0.y); w.y = pk2(v0.z, v0.w); w.z = pk2(v1.x, v1.y); w.w = pk2(v1.z, v1.w); *(u32x4*)(O + (size_t)r * D + cc) = w;
        const int rr = r & 63; if (seg >= 2 && rr >= 61) *(u32x4*)(HQ + (size_t)(seg - 2) * (3 * MiB / 2) + ((size_t)(r >> 6) * 3 + (rr - 61)) * D + cc) = w; } };
struct EpiVT2 { bf16_t* S0;
    __device__ __forceinline__ void operator()(int r, int c, f32x4 v) const { bf16_t* O = S0 + (size_t)(3 + 3 * (r >> 10)) * SLOT_ELEMS;
        u32x2 w; w.x = pk2(v.x, v.y); w.y = pk2(v.z, v.w); *(u32x2*)(O + (size_t)(r & 1023) * T + c) = w; }
    __device__ __forceinline__ void operator()(int r, int c, f32x4 v0, f32x4 v1) const { bf16_t* O = S0 + (size_t)(3 + 3 * (r >> 10)) * SLOT_ELEMS; u32x4 w; w.x = pk2(v0.x, v0.y); w.y = pk2(v0.z, v0.w); w.z = pk2(v1.x, v1.y); w.w = pk2(v1.z, v1.w); *(u32x4*)(O + (size_t)(r & 1023) * T + c) = w; } };
struct EpiSeg2 { bf16_t* S0;
    __device__ __forceinline__ void operator()(int r, int c, f32x4 v) const { bf16_t* O = S0 + (size_t)(3 - (c >> 10)) * SLOT_ELEMS;
        u32x2 w; w.x = pk2(v.x, v.y); w.y = pk2(v.z, v.w); *(u32x2*)(O + (size_t)r * D + (c & 1023)) = w; }
    __device__ __forceinline__ void operator()(int r, int c, f32x4 v0, f32x4 v1) const { bf16_t* O = S0 + (size_t)(3 - (c >> 10)) * SLOT_ELEMS; u32x4 w; w.x = pk2(v0.x, v0.y); w.y = pk2(v0.z, v0.w); w.z = pk2(v1.x, v1.y); w.w = pk2(v1.z, v1.w); *(u32x4*)(O + (size_t)r * D + (c & 1023)) = w; } };
struct EpiRelu2RS { bf16_t* O; int ldc; const float* ssq;
    __device__ __forceinline__ void operator()(int r, int c, f32x4 v) const { const float rs = rsqrtf(ssq[r] * (1.f / D) + EPS);
        f32x4 t = (f32x4){fmaxf(v.x * rs, 0.f), fmaxf(v.y * rs, 0.f), fmaxf(v.z * rs, 0.f), fmaxf(v.w * rs, 0.f)}; t = t * t;
        u32x2 w; w.x = pk2(t.x, t.y); w.y = pk2(t.z, t.w); *(u32x2*)(O + (size_t)r * ldc + c) = w; }
    __device__ __forceinline__ void operator()(int r, int c, f32x4 v0, f32x4 v1) const { const float rs = rsqrtf(ssq[r] * (1.f / D) + EPS);
        v0 = (f32x4){fmaxf(v0.x * rs, 0.f), fmaxf(v0.y * rs, 0.f), fmaxf(v0.z * rs, 0.f), fmaxf(v0.w * rs, 0.f)}; v0 = v0 * v0; v1 = (f32x4){fmaxf(v1.x * rs, 0.f), fmaxf(v1.y * rs, 0.f), fmaxf(v1.z * rs, 0.f), fmaxf(v1.w * rs, 0.f)}; v1 = v1 * v1; u32x4 w; w.x = pk2(v0.x, v0.y); w.y = pk2(v0.z, v0.w); w.z = pk2(v1.x, v1.y); w.w = pk2(v1.z, v1.w); *(u32x4*)(O + (size_t)r * ldc + c) = w; } };
struct GateMixOrder { pg8::StaticOrder so;
    __device__ __forceinline__ bool next(int i, pg8::Unit& u) const { const int ti = i / 6, r = i - 6 * ti, br = r >> 1; pg8::Unit t; if (!so.next(ti, t)) return false;
        if ((r & 1) == 0) { u.pm = t.pm; u.pn = br * 4 + t.pn; } else { const int slot = 1 + (br == 1 ? 3 : 0) + (br == 2 ? 1 : 0); u.pm = slot * 128 + t.pm; u.pn = 20 + br * 4 + t.pn; }
        return true; }
    __device__ __forceinline__ void a_ready(const pg8::Unit&) const {}
    __device__ __forceinline__ void done(const pg8::Unit&) const {} };
struct EpiGateMix { static constexpr bool PERM = true, AFTER_DRAIN = false; bf16_t* S0; const float* bias;
    __device__ __forceinline__ void operator()(const f32x4 (&acc)[2][2][4][2], const pg8::Unit& u, int wr, int wc, int fr, int fq) const {
        const bool mix = u.pn >= 20; const int q = mix ? u.pn - 20 : u.pn, br = q >> 2, pn = q & 3, pm = u.pm & 127;
        unsigned char* G8 = (unsigned char*)(S0 + (size_t)(br == 2 ? 6 : 5) * SLOT_ELEMS) + (br == 1 ? (size_t)T * D : 0);
        bf16_t* R = S0 + (size_t)3 * SLOT_ELEMS;
        if (!mix) {
#pragma unroll
            for (int bj = 0; bj < 2; ++bj) { const int col = pn * 256 + bj * 128 + wc * 32 + 8 * fq; const f32x4 b0 = *(const f32x4*)(bias + br * 1024 + col), b1 = *(const f32x4*)(bias + br * 1024 + col + 4);
#pragma unroll
                for (int ai = 0; ai < 2; ++ai)
#pragma unroll
                    for (int m = 0; m < 4; ++m) { const int row = pm * 256 + ai * 128 + wr * 64 + m * 16 + fr; const f32x4 v0 = acc[ai][bj][m][0] + b0, v1 = acc[ai][bj][m][1] + b1;
                        u32x2 g8;
                        g8.x = (unsigned)(sigmoidf_(v0.x) * 255.f + 0.5f) | ((unsigned)(sigmoidf_(v0.y) * 255.f + 0.5f) << 8) | ((unsigned)(sigmoidf_(v0.z) * 255.f + 0.5f) << 16) | ((unsigned)(sigmoidf_(v0.w) * 255.f + 0.5f) << 24);
                        g8.y = (unsigned)(sigmoidf_(v1.x) * 255.f + 0.5f) | ((unsigned)(sigmoidf_(v1.y) * 255.f + 0.5f) << 8) | ((unsigned)(sigmoidf_(v1.z) * 255.f + 0.5f) << 16) | ((unsigned)(sigmoidf_(v1.w) * 255.f + 0.5f) << 24);
                        *(u32x2*)(G8 + ((((size_t)(pm * 4 + pn) * 8 + (wr * 4 + wc)) * 8 + ai * 4 + m) * 2 + bj) * 512 + (fq * 16 + fr) * 8) = g8; } }
        } else {
            const float k255 = 1.f / 255.f;
#pragma unroll
            for (int ai = 0; ai < 2; ++ai) { u32x2 gw[4][2]; u32x4 pw[4][2];
#pragma unroll
                for (int m = 0; m < 4; ++m)
#pragma unroll
                    for (int bj = 0; bj < 2; ++bj) { const size_t off = (size_t)(pm * 256 + ai * 128 + wr * 64 + m * 16 + fr) * D + pn * 256 + bj * 128 + wc * 32 + 8 * fq; gw[m][bj] = *(const u32x2*)(G8 + ((((size_t)(pm * 4 + pn) * 8 + (wr * 4 + wc)) * 8 + ai * 4 + m) * 2 + bj) * 512 + (fq * 16 + fr) * 8); if (br >= 1) pw[m][bj] = *(const u32x4*)(R + off); }
#pragma unroll
                for (int m = 0; m < 4; ++m)
#pragma unroll
                    for (int bj = 0; bj < 2; ++bj) { const size_t off = (size_t)(pm * 256 + ai * 128 + wr * 64 + m * 16 + fr) * D + pn * 256 + bj * 128 + wc * 32 + 8 * fq; const f32x4 v0 = acc[ai][bj][m][0], v1 = acc[ai][bj][m][1];
                        const unsigned ga = gw[m][bj].x, gb = gw[m][bj].y;
                        f32x4 m0 = (f32x4){(float)(ga & 255u) * k255 * v0.x, (float)((ga >> 8) & 255u) * k255 * v0.y, (float)((ga >> 16) & 255u) * k255 * v0.z, (float)(ga >> 24) * k255 * v0.w};
                        f32x4 m1 = (f32x4){(float)(gb & 255u) * k255 * v1.x, (float)((gb >> 8) & 255u) * k255 * v1.y, (float)((gb >> 16) & 255u) * k255 * v1.z, (float)(gb >> 24) * k255 * v1.w};
                        if (br >= 1) { const u32x4 p = pw[m][bj]; m0.x += bflo(p.x); m0.y += bfhi(p.x); m0.z += bflo(p.y); m0.w += bfhi(p.y); m1.x += bflo(p.z); m1.y += bfhi(p.z); m1.z += bflo(p.w); m1.w += bfhi(p.w); }
                        u32x4 w; w.x = pk2(m0.x, m0.y); w.y = pk2(m0.z, m0.w); w.z = pk2(m1.x, m1.y); w.w = pk2(m1.z, m1.w); *(u32x4*)(R + off) = w; } }
        } } };
struct EpiResidSS { static constexpr bool PERM = true, AFTER_DRAIN = false; const float* base; float* out; bf16_t* xb; float* ssq;
    __device__ __forceinline__ void operator()(const f32x4 (&acc)[2][2][4][2], const pg8::Unit& u, int wr, int wc, int fr, int fq) const {
#pragma unroll
        for (int ai = 0; ai < 2; ++ai) { f32x4 pre[4][2][2];
#pragma unroll
            for (int m = 0; m < 4; ++m)
#pragma unroll
                for (int bj = 0; bj < 2; ++bj) { const float* bp = base + (size_t)(u.pm * 256 + ai * 128 + wr * 64 + m * 16 + fr) * D + u.pn * 256 + bj * 128 + wc * 32 + 8 * fq; pre[m][bj][0] = *(const f32x4*)bp; pre[m][bj][1] = *(const f32x4*)(bp + 4); }
#pragma unroll
            for (int m = 0; m < 4; ++m) { const int row = u.pm * 256 + ai * 128 + wr * 64 + m * 16 + fr; float ss = 0.f;
#pragma unroll
                for (int bj = 0; bj < 2; ++bj) { const size_t off = (size_t)row * D + u.pn * 256 + bj * 128 + wc * 32 + 8 * fq;
                    const f32x4 o0 = pre[m][bj][0] + acc[ai][bj][m][0], o1 = pre[m][bj][1] + acc[ai][bj][m][1];
                    u32x4 w; w.x = pk2(o0.x, o0.y); w.y = pk2(o0.z, o0.w); w.z = pk2(o1.x, o1.y); w.w = pk2(o1.z, o1.w); *(u32x4*)(xb + off) = w;
                    ss += ((o0.x * o0.x + o0.y * o0.y) + (o0.z * o0.z + o0.w * o0.w)) + ((o1.x * o1.x + o1.y * o1.y) + (o1.z * o1.z + o1.w * o1.w)); }
                ss += __shfl_xor(ss, 16); ss += __shfl_xor(ss, 32);
                if (fq == 0) atomicAdd(ssq + row, ss); } } } };
struct EpiResidIn { static constexpr bool PERM = true, AFTER_DRAIN = false; const bf16_t* xb; float* out;
    __device__ __forceinline__ void operator()(const f32x4 (&acc)[2][2][4][2], const pg8::Unit& u, int wr, int wc, int fr, int fq) const {
#pragma unroll
        for (int ai = 0; ai < 2; ++ai) { u32x4 pre[4][2];
#pragma unroll
            for (int m = 0; m < 4; ++m)
#pragma unroll
                for (int bj = 0; bj < 2; ++bj) pre[m][bj] = *(const u32x4*)(xb + (size_t)(u.pm * 256 + ai * 128 + wr * 64 + m * 16 + fr) * D + u.pn * 256 + bj * 128 + wc * 32 + 8 * fq);
#pragma unroll
            for (int m = 0; m < 4; ++m)
#pragma unroll
                for (int bj = 0; bj < 2; ++bj) { const f32x4 a0 = acc[ai][bj][m][0], a1 = acc[ai][bj][m][1]; const u32x4 p = pre[m][bj];
                    float* op = out + (size_t)(u.pm * 256 + ai * 128 + wr * 64 + m * 16 + fr) * D + u.pn * 256 + bj * 128 + wc * 32 + 8 * fq;
                    *(f32x4*)op = (f32x4){bflo(p.x) + a0.x, bfhi(p.x) + a0.y, bflo(p.y) + a0.z, bfhi(p.y) + a0.w}; *(f32x4*)(op + 4) = (f32x4){bflo(p.z) + a1.x, bfhi(p.z) + a1.y, bflo(p.w) + a1.z, bfhi(p.w) + a1.w}; } } } };

#define LAS __attribute__((address_space(3)))
typedef float f32x16 __attribute__((ext_vector_type(16)));
constexpr int SB_KST = 272, SB_VST = 136, SB_KBYTES = 64 * SB_KST, SB_VBYTES = 128 * SB_VST, SB_BUF = SB_KBYTES + SB_VBYTES;
template <bool DIAG>
__device__ __forceinline__ void sb_subtile(LAS unsigned char* buf, int st, const bf16x8 (&qf)[8], f32x16 (&Y)[4], float& R, int k0, int qi, int r32, int hh) {
    f32x16 X;
#pragma unroll
    for (int r = 0; r < 16; ++r) X[r] = 0.f;
    LAS unsigned char* kp = buf + (32 * st + r32) * SB_KST + hh * 16;
#pragma unroll
    for (int s = 0; s < 8; ++s) { const bf16x8 kf = *(LAS bf16x8*)(kp + s * 32); X = __builtin_amdgcn_mfma_f32_32x32x16_bf16(kf, qf[s], X, 0, 0, 0); }
    float om[16];
#pragma unroll
    for (int r = 0; r < 16; ++r) { const float zz = __builtin_amdgcn_fmed3f(X[r], -80.f, 80.f);
        const float u = __builtin_amdgcn_exp2f(zz); const float be = __builtin_amdgcn_rcpf(1.f + u);
        const int key = k0 + (r & 3) + 8 * (r >> 2) + 4 * hh; const bool valid = !DIAG || key < qi;
        om[r] = valid ? u * be : 1.f; X[r] = valid ? be : 0.f; }
    float g[4], og[4], pr[4];
#pragma unroll
    for (int c = 0; c < 4; ++c) { g[c] = (om[4 * c] * om[4 * c + 1]) * (om[4 * c + 2] * om[4 * c + 3]); og[c] = __shfl_xor(g[c], 32); pr[c] = g[c] * og[c]; }
    float Tc[4]; Tc[3] = 1.f; Tc[2] = pr[3]; Tc[1] = pr[3] * pr[2]; Tc[0] = Tc[1] * pr[1];
    const float total = Tc[0] * pr[0];
#pragma unroll
    for (int c = 0; c < 4; ++c) { float later = R * Tc[c] * (hh == 0 ? og[c] : 1.f);
#pragma unroll
        for (int i = 3; i >= 0; --i) { const int r = 4 * c + i; const float pv = X[r] * later; later *= om[r]; X[r] = pv; } }
    R *= total;
    bf16x8 pf[2];
#pragma unroll
    for (int s2 = 0; s2 < 2; ++s2) { u32x4 w; w.x = pk2(X[8 * s2], X[8 * s2 + 1]); w.y = pk2(X[8 * s2 + 2], X[8 * s2 + 3]); w.z = pk2(X[8 * s2 + 4], X[8 * s2 + 5]); w.w = pk2(X[8 * s2 + 6], X[8 * s2 + 7]); pf[s2] = __builtin_bit_cast(bf16x8, w); }
#pragma unroll
    for (int dt = 0; dt < 4; ++dt) { LAS unsigned char* vp = buf + SB_KBYTES + (32 * dt + r32) * SB_VST + (32 * st + 4 * hh) * 2;
#pragma unroll
        for (int s2 = 0; s2 < 2; ++s2) { const u32x2 lo = *(LAS u32x2*)(vp + s2 * 32), hi = *(LAS u32x2*)(vp + s2 * 32 + 16);
            u32x4 w; w.x = lo.x; w.y = lo.y; w.z = hi.x; w.w = hi.y;
            Y[dt] = __builtin_amdgcn_mfma_f32_32x32x16_bf16(__builtin_bit_cast(bf16x8, w), pf[s2], Y[dt], 0, 0, 0); } }
}
__device__ __forceinline__ void sb_tile_full(LAS unsigned char* buf, const bf16x8 (&qf)[8], f32x16 (&Y)[4], float& R, int r32, int hh) {
    f32x16 X1, X0;
#pragma unroll
    for (int r = 0; r < 16; ++r) { X1[r] = 0.f; X0[r] = 0.f; }
    LAS unsigned char* kp = buf + r32 * SB_KST + hh * 16;
#pragma unroll
    for (int s = 0; s < 8; ++s) { const bf16x8 k1 = *(LAS bf16x8*)(kp + 32 * SB_KST + s * 32), k0_ = *(LAS bf16x8*)(kp + s * 32);
        X1 = __builtin_amdgcn_mfma_f32_32x32x16_bf16(k1, qf[s], X1, 0, 0, 0); X0 = __builtin_amdgcn_mfma_f32_32x32x16_bf16(k0_, qf[s], X0, 0, 0, 0); }
    float om1[16], om0[16];
#pragma unroll
    for (int r = 0; r < 16; ++r) { const float z1 = X1[r], z0 = X0[r];
        const float u1 = __builtin_amdgcn_exp2f(z1), u0 = __builtin_amdgcn_exp2f(z0); const float b1 = __builtin_amdgcn_rcpf(1.f + u1), b0 = __builtin_amdgcn_rcpf(1.f + u0);
        om1[r] = u1 * b1; om0[r] = u0 * b0; X1[r] = b1; X0[r] = b0; }
    float g1[4], g0[4], o1[4], o0[4];
#pragma unroll
    for (int c = 0; c < 4; ++c) { g1[c] = (om1[4 * c] * om1[4 * c + 1]) * (om1[4 * c + 2] * om1[4 * c + 3]); g0[c] = (om0[4 * c] * om0[4 * c + 1]) * (om0[4 * c + 2] * om0[4 * c + 3]); }
#pragma unroll
    for (int c = 0; c < 4; ++c) { o1[c] = __shfl_xor(g1[c], 32); o0[c] = __shfl_xor(g0[c], 32); }
    float T1[4], T0[4];
    { const float p3 = g1[3] * o1[3], p2 = g1[2] * o1[2], p1 = g1[1] * o1[1], p0 = g1[0] * o1[0]; T1[3] = R; T1[2] = R * p3; T1[1] = T1[2] * p2; T1[0] = T1[1] * p1; R = T1[0] * p0; }
    { const float p3 = g0[3] * o0[3], p2 = g0[2] * o0[2], p1 = g0[1] * o0[1], p0 = g0[0] * o0[0]; T0[3] = R; T0[2] = R * p3; T0[1] = T0[2] * p2; T0[0] = T0[1] * p1; R = T0[0] * p0; }
#pragma unroll
    for (int c = 0; c < 4; ++c) { float l1 = T1[c] * (hh == 0 ? o1[c] : 1.f), l0 = T0[c] * (hh == 0 ? o0[c] : 1.f);
#pragma unroll
        for (int i = 3; i >= 0; --i) { const int r = 4 * c + i; const float p1 = X1[r] * l1, p0 = X0[r] * l0; l1 *= om1[r]; l0 *= om0[r]; X1[r] = p1; X0[r] = p0; } }
    bf16x8 pf1[2], pf0[2];
#pragma unroll
    for (int s2 = 0; s2 < 2; ++s2) { u32x4 w; w.x = pk2(X1[8 * s2], X1[8 * s2 + 1]); w.y = pk2(X1[8 * s2 + 2], X1[8 * s2 + 3]); w.z = pk2(X1[8 * s2 + 4], X1[8 * s2 + 5]); w.w = pk2(X1[8 * s2 + 6], X1[8 * s2 + 7]); pf1[s2] = __builtin_bit_cast(bf16x8, w);
        w.x = pk2(X0[8 * s2], X0[8 * s2 + 1]); w.y = pk2(X0[8 * s2 + 2], X0[8 * s2 + 3]); w.z = pk2(X0[8 * s2 + 4], X0[8 * s2 + 5]); w.w = pk2(X0[8 * s2 + 6], X0[8 * s2 + 7]); pf0[s2] = __builtin_bit_cast(bf16x8, w); }
    LAS unsigned char* vp0 = buf + SB_KBYTES + r32 * SB_VST + (4 * hh) * 2;
    u32x4 va[8], vb[8];
#pragma unroll
    for (int i = 0; i < 8; ++i) { LAS unsigned char* vp = vp0 + (32 * (i >> 2)) * SB_VST + (i & 3) * 32; const u32x2 lo = *(LAS u32x2*)vp, hi = *(LAS u32x2*)(vp + 16); va[i].x = lo.x; va[i].y = lo.y; va[i].z = hi.x; va[i].w = hi.y; }
#pragma unroll
    for (int i = 0; i < 8; ++i) asm volatile("" : "+v"(va[i]));
#pragma unroll
    for (int i = 0; i < 8; ++i) { LAS unsigned char* vp = vp0 + (32 * (2 + (i >> 2))) * SB_VST + (i & 3) * 32; const u32x2 lo = *(LAS u32x2*)vp, hi = *(LAS u32x2*)(vp + 16); vb[i].x = lo.x; vb[i].y = lo.y; vb[i].z = hi.x; vb[i].w = hi.y; }
    __builtin_amdgcn_sched_barrier(0);
#pragma unroll
    for (int i = 0; i < 8; ++i) { const int q4 = i & 3; Y[i >> 2] = __builtin_amdgcn_mfma_f32_32x32x16_bf16(__builtin_bit_cast(bf16x8, va[i]), (q4 < 2) ? pf0[q4] : pf1[q4 - 2], Y[i >> 2], 0, 0, 0); }
#pragma unroll
    for (int i = 0; i < 8; ++i) asm volatile("" : "+v"(vb[i]));
#pragma unroll
    for (int i = 0; i < 8; ++i) { const int q4 = i & 3; Y[2 + (i >> 2)] = __builtin_amdgcn_mfma_f32_32x32x16_bf16(__builtin_bit_cast(bf16x8, vb[i]), (q4 < 2) ? pf0[q4] : pf1[q4 - 2], Y[2 + (i >> 2)], 0, 0, 0); }
}
__device__ __forceinline__ void sb_fast(bf16_t* Q, const bf16_t* Kk, const bf16_t* VT, LAS unsigned char* lds) {
    int tid_ = threadIdx.x; asm volatile("" : "+v"(tid_));
    const int tid = tid_, lane = tid & 63, wid = tid >> 6, r32 = lane & 31, hh = lane >> 5;
    const int vcu_ = (gridDim.x % 8 == 0) ? (int)((blockIdx.x % 8) * (gridDim.x / 8) + blockIdx.x / 8) : (int)blockIdx.x;
    for (int vw = vcu_; vw < 256; vw += gridDim.x) {
        const int bh = vw >> 2, jj = vw & 3, b = bh >> 3, h = bh & 7;
        const bf16_t* kg = Kk + ((size_t)b * SEQ) * D + h * 128;
        const bf16_t* vg = VT + (size_t)(h * 128) * T + (size_t)b * SEQ;
        for (int ui = 0; ui < 4; ++ui) {
            const int qb = ui == 0 ? 2 * jj : (ui == 1 ? 15 - 2 * jj : (ui == 2 ? 2 * jj + 1 : 14 - 2 * jj));
            const int q0w = qb * 256 + 32 * wid, qi = q0w + r32;
            bf16_t* qrow = Q + ((size_t)b * SEQ + qi) * D + h * 128;
            bf16x8 qf[8];
#pragma unroll
            for (int s = 0; s < 8; ++s) qf[s] = *(const bf16x8*)(qrow + 16 * s + 8 * hh);
            f32x16 Y[4];
#pragma unroll
            for (int dt = 0; dt < 4; ++dt)
#pragma unroll
                for (int r = 0; r < 16; ++r) Y[dt][r] = 0.f;
            float R = 1.f;
            const int ktmax = 4 * qb + 3;
            u32x4 kr[2], vr[2];
#define SB_LOADG(kt) do { _Pragma("unroll") for (int i_ = 0; i_ < 2; ++i_) { const int c_ = tid + 512 * i_; \
                kr[i_] = *(const u32x4*)(kg + (size_t)(64 * (kt) + (c_ >> 4)) * D + (c_ & 15) * 8); \
                vr[i_] = *(const u32x4*)(vg + (size_t)(c_ >> 3) * T + 64 * (kt) + (c_ & 7) * 8); } } while (0)
#define SB_STORES(bufp) do { _Pragma("unroll") for (int i_ = 0; i_ < 2; ++i_) { const int c_ = tid + 512 * i_; \
                *(LAS u32x4*)((bufp) + (c_ >> 4) * SB_KST + (c_ & 15) * 16) = kr[i_]; \
                LAS u32x2* vp_ = (LAS u32x2*)((bufp) + SB_KBYTES + (c_ >> 3) * SB_VST + (c_ & 7) * 16); \
                u32x2 a_; a_.x = vr[i_].x; a_.y = vr[i_].y; u32x2 b_; b_.x = vr[i_].z; b_.y = vr[i_].w; vp_[0] = a_; vp_[1] = b_; } } while (0)
            SB_LOADG(ktmax); SB_STORES(lds);
#pragma unroll
            for (int s_ = 0; s_ < 8; ++s_) asm volatile("" : "+v"(qf[s_]));
            __syncthreads();
            for (int kt = ktmax, it = 0; kt >= 0; --kt, ++it) {
                LAS unsigned char* cur = lds + (it & 1) * SB_BUF; LAS unsigned char* nxt = lds + ((it & 1) ^ 1) * SB_BUF;
                if (kt > 0) SB_LOADG(kt - 1);
                if (64 * kt + 63 < q0w) sb_tile_full(cur, qf, Y, R, r32, hh);
                else {
#pragma unroll
                for (int st = 1; st >= 0; --st) { const int k0 = 64 * kt + 32 * st;
                    if (k0 < q0w + 31) { if (k0 + 31 >= q0w) sb_subtile<true>(cur, st, qf, Y, R, k0, qi, r32, hh); else sb_subtile<false>(cur, st, qf, Y, R, k0, qi, r32, hh); } } }
                if (kt > 0) SB_STORES(nxt);
                __syncthreads();
            }
#undef SB_LOADG
#undef SB_STORES
            { LAS unsigned char* stg = lds + wid * 8704;
#pragma unroll
              for (int dt = 0; dt < 4; ++dt)
#pragma unroll
                  for (int c = 0; c < 4; ++c) { u32x2 w; w.x = pk2(Y[dt][4 * c], Y[dt][4 * c + 1]); w.y = pk2(Y[dt][4 * c + 2], Y[dt][4 * c + 3]); *(LAS u32x2*)(stg + r32 * 272 + (32 * dt + 8 * c + 4 * hh) * 2) = w; }
              LDS_WAIT();
              bf16_t* orow = Q + ((size_t)b * SEQ + q0w) * D + h * 128;
#pragma unroll 1
              for (int i = 0; i < 8; ++i) { const int row = 4 * i + (lane >> 4), ch = lane & 15; const u32x4 v = *(LAS u32x4*)(stg + row * 272 + ch * 16); *(u32x4*)(orow + (size_t)row * D + ch * 8) = v; }
              __syncthreads(); }
        }
    }
}

__device__ __forceinline__ void conv_pass(bf16_t* MQ, bf16_t* MK, const bf16_t* haloQ, const bf16_t* haloK, const float* conv_w, const float* conv_b, int gw, int NGW, int lane) {
    for (int it = gw; it < 2048; it += NGW) {
        const int blk = it >> 2, isk = (it >> 1) & 1, half = it & 1;
        const int ch0 = (half * 64 + lane) * 8;
        bf16_t* base = (isk ? MK : MQ) + (size_t)blk * 64 * D + ch0;
        const float* cw = conv_w + isk * 1024 + ch0;
        float w0[8], w1[8], w2[8], w3[8], cb[8], r0[8], r1[8], r2[8];
#pragma unroll
        for (int e = 0; e < 8; ++e) { w0[e] = cw[e]; w1[e] = cw[2048 + e]; w2[e] = cw[4096 + e]; w3[e] = cw[6144 + e]; cb[e] = conv_b[isk * 1024 + ch0 + e]; r0[e] = 0.f; r1[e] = 0.f; r2[e] = 0.f; }
        if ((blk & 63) != 0) { const bf16_t* hal = (isk ? haloK : haloQ) + (size_t)(blk - 1) * 3 * D + ch0;
            const u32x4 h0 = *(const u32x4*)hal, h1 = *(const u32x4*)(hal + D), h2 = *(const u32x4*)(hal + 2 * D);
#pragma unroll
            for (int e2 = 0; e2 < 4; ++e2) { r0[2 * e2] = bflo(h0[e2]); r0[2 * e2 + 1] = bfhi(h0[e2]); r1[2 * e2] = bflo(h1[e2]); r1[2 * e2 + 1] = bfhi(h1[e2]); r2[2 * e2] = bflo(h2[e2]); r2[2 * e2 + 1] = bfhi(h2[e2]); } }
        const float osc = isk ? 0.0625f : 1.f;
        u32x4 in[4];
#pragma unroll
        for (int i = 0; i < 4; ++i) in[i] = *(const u32x4*)(base + (size_t)i * D);
#pragma unroll 1
        for (int r4 = 0; r4 < 64; r4 += 4) {
            u32x4 nx[4]; const int rn = (r4 + 4 < 64) ? r4 + 4 : r4;
#pragma unroll
            for (int i = 0; i < 4; ++i) nx[i] = *(const u32x4*)(base + (size_t)(rn + i) * D);
#pragma unroll
            for (int i = 0; i < 4; ++i) { float y[8];
#pragma unroll
                for (int e = 0; e < 8; ++e) { const float xv = (e & 1) ? bfhi(in[i][e >> 1]) : bflo(in[i][e >> 1]);
                    const float u = w0[e] * r0[e] + w1[e] * r1[e] + w2[e] * r2[e] + w3[e] * xv + cb[e]; r0[e] = r1[e]; r1[e] = r2[e]; r2[e] = xv; y[e] = u * sigmoidf_(u) * osc; }
                u32x4 o; o.x = pk2(y[0], y[1]); o.y = pk2(y[2], y[3]); o.z = pk2(y[4], y[5]); o.w = pk2(y[6], y[7]); *(u32x4*)(base + (size_t)(r4 + i) * D) = o; }
#pragma unroll
            for (int i = 0; i < 4; ++i) in[i] = nx[i];
        }
    }
}

__device__ __forceinline__ void gate_pass(const float* ifp, float* GA, float* GP, float* GB, int gw, int NGW, int lane) {
    for (int it = gw; it < 2048; it += NGW) { const int bh = it >> 6, c = it & 63, b = bh >> 2, h = bh & 3;
        const size_t trow = (size_t)b * SEQ + 64 * c + lane; const float gi = ifp[trow * 8 + h], gf = ifp[trow * 8 + 4 + h];
        const float lf = -(fmaxf(-gf, 0.f) + __logf(1.f + __expf(-fabsf(gf))));
        float bc = lf;
#pragma unroll
        for (int o = 1; o < 64; o <<= 1) { const float t_ = __shfl_up(bc, o); if (lane >= o) bc += t_; }
        const float a = gi - bc; float pm = a;
#pragma unroll
        for (int o = 1; o < 64; o <<= 1) { const float t_ = __shfl_up(pm, o); if (lane >= o) pm = fmaxf(pm, t_); }
        const size_t o_ = (size_t)bh * SEQ + 64 * c + lane; GA[o_] = a; GP[o_] = pm; GB[o_] = bc; }
}

constexpr int ML_QS = 0, ML_KS = 33792, ML_KST = 67584, ML_VTS = 104448, ML_VWT = 109200, ML_SCB = 113952, ML_CB = 123168, ML_VEC = 140592, ML_RS = 528, ML_TS = 144;
__device__ __forceinline__ void mlstm_fast(const bf16_t* MQ, const bf16_t* MK, const bf16_t* MVT, const float* GA, const float* GP, const float* GB, bf16_t* HUN, LAS unsigned char* lds) {
    int tid_ = threadIdx.x; asm volatile("" : "+v"(tid_));
    const int tid = tid_, lane = tid & 63, w = tid >> 6, fr = lane & 15, fq = lane >> 4;
    LAS float* vA = (LAS float*)(lds + ML_VEC); LAS float* vM = vA + 64; LAS float* vSI = vA + 128; LAS float* vEM = vA + 192; LAS float* vWK = vA + 256; LAS float* vDEC = vA + 320;
    const int tt = w & 3, sp = w >> 2;
    const int vcu_ = (gridDim.x % 8 == 0) ? (int)((blockIdx.x % 8) * (gridDim.x / 8) + blockIdx.x / 8) : (int)blockIdx.x;
    for (int item = vcu_; item < 256; item += gridDim.x) {
        const int bh = item >> 3, vs = item & 7, b = bh >> 2, h = bh & 3;
        const bf16_t* qg = MQ + ((size_t)b * SEQ + (tid >> 5)) * D + h * 256 + (tid & 31) * 8;
        const bf16_t* kg = MK + ((size_t)b * SEQ + (tid >> 5)) * D + h * 256 + (tid & 31) * 8;
        const bf16_t* vg = MVT + (size_t)(h * 256 + vs * 32 + ((tid >> 3) & 31)) * T + (size_t)b * SEQ + (tid & 7) * 8;
        const size_t go = (size_t)bh * SEQ + lane;
        bf16_t* hg = HUN + ((size_t)b * SEQ + 16 * tt + fr) * D + h * 256 + vs * 32 + 16 * sp + 4 * fq;
        for (int i = tid; i < 17424 / 16; i += NTHREADS) *(LAS u32x4*)(lds + ML_CB + i * 16) = (u32x4){0u, 0u, 0u, 0u};
        if (tid < 32) *(LAS unsigned*)(lds + ML_VTS + 32 * ML_TS + 4 * tid) = 0x3F803F80u;
        u32x4 pq[4], pk[4], pv; float ga = 0.f, gp_ = 0.f, gb = 0.f, nga = 0.f, ngp = 0.f, ngb = 0.f;
#define ML_LOAD(c) do { _Pragma("unroll") for (int i_ = 0; i_ < 4; ++i_) { pq[i_] = *(const u32x4*)(qg + (size_t)(64 * (c) + 16 * i_) * D); pk[i_] = *(const u32x4*)(kg + (size_t)(64 * (c) + 16 * i_) * D); } \
            if (tid < 256) pv = *(const u32x4*)(vg + 64 * (c)); if (w == 0) { nga = GA[go + 64 * (c)]; ngp = GP[go + 64 * (c)]; ngb = GB[go + 64 * (c)]; } } while (0)
#define ML_STORE() do { _Pragma("unroll") for (int i_ = 0; i_ < 4; ++i_) { *(LAS u32x4*)(lds + ML_QS + ((tid >> 5) + 16 * i_) * ML_RS + (tid & 31) * 16) = pq[i_]; *(LAS u32x4*)(lds + ML_KS + ((tid >> 5) + 16 * i_) * ML_RS + (tid & 31) * 16) = pk[i_]; } \
            if (tid < 256) *(LAS u32x4*)(lds + ML_VTS + (tid >> 3) * ML_TS + (tid & 7) * 16) = pv; } while (0)
        ML_LOAD(0); ML_STORE(); ga = nga; gp_ = ngp; gb = ngb;
        __syncthreads();
        float m_prev = 0.f;
        f32x4 Cacc[2][3];
#pragma unroll
        for (int u = 0; u < 2; ++u)
#pragma unroll
            for (int v3 = 0; v3 < 3; ++v3) Cacc[u][v3] = (f32x4){0.f, 0.f, 0.f, 0.f};
#pragma unroll 1
        for (int c = 0; c < 64; ++c) {
            if (c < 63) ML_LOAD(c + 1);
#pragma unroll
            for (int i_ = 0; i_ < 4; ++i_) { const u32x4 kv = *(LAS u32x4*)(lds + ML_KS + lane * ML_RS + (4 * w + i_) * 16);
#pragma unroll
                for (int e_ = 0; e_ < 8; ++e_) { const unsigned wd_ = kv[e_ >> 1]; *(LAS bf16_t*)(lds + ML_KST + (32 * w + 8 * i_ + e_) * ML_TS + 2 * lane) = (bf16_t)((e_ & 1) ? (wd_ >> 16) : (wd_ & 0xffffu)); } }
            if (w == 0) {
                const float Mt = fmaxf(m_prev, gp_);
                const float Mend = __shfl(Mt, 63), bend = __shfl(gb, 63);
                vA[lane] = ga; vM[lane] = Mt; vSI[lane] = __expf(m_prev - Mt); vEM[lane] = __expf(-(gb + Mt)); vWK[lane] = __expf(ga - Mend);
                if (lane == 0) vDEC[0] = __expf(m_prev - Mend);
                m_prev = bend + Mend;
            }
            f32x4 S[2]; S[0] = (f32x4){0.f, 0.f, 0.f, 0.f}; S[1] = S[0];
#pragma unroll
            for (int ks = 0; ks < 8; ++ks) { const bf16x8 bq = *(LAS bf16x8*)(lds + ML_QS + (16 * tt + fr) * ML_RS + (32 * ks + 8 * fq) * 2);
                const bf16x8 a0 = *(LAS bf16x8*)(lds + ML_KS + (32 * sp + fr) * ML_RS + (32 * ks + 8 * fq) * 2); const bf16x8 a1 = *(LAS bf16x8*)(lds + ML_KS + (32 * sp + 16 + fr) * ML_RS + (32 * ks + 8 * fq) * 2);
                S[0] = __builtin_amdgcn_mfma_f32_16x16x32_bf16(a0, bq, S[0], 0, 0, 0); S[1] = __builtin_amdgcn_mfma_f32_16x16x32_bf16(a1, bq, S[1], 0, 0, 0); }
            LDS_BARRIER();
            { const float Mt = vM[16 * tt + fr]; const int t = 16 * tt + fr;
#pragma unroll
              for (int u = 0; u < 2; ++u) { const int st = 2 * sp + u; const f32x4 av = *(LAS f32x4*)(vA + 16 * st + 4 * fq); float sc[4];
#pragma unroll
                  for (int j = 0; j < 4; ++j) { const int s_ = 16 * st + 4 * fq + j; sc[j] = (s_ <= t) ? S[u][j] * __expf(av[j] - Mt) : 0.f; }
                  u32x2 o; o.x = pk2(sc[0], sc[1]); o.y = pk2(sc[2], sc[3]); *(LAS u32x2*)(lds + ML_SCB + t * ML_TS + (16 * st + 4 * fq) * 2) = o; }
              const int v_ = tid >> 4, s4 = (tid & 15) * 4; const f32x4 wk = *(LAS f32x4*)(vWK + s4);
              const u32x2 vv = *(LAS u32x2*)(lds + ML_VTS + v_ * ML_TS + s4 * 2);
              u32x2 o; o.x = pk2(bflo(vv.x) * wk.x, bfhi(vv.x) * wk.y); o.y = pk2(bflo(vv.y) * wk.z, bfhi(vv.y) * wk.w); *(LAS u32x2*)(lds + ML_VWT + v_ * ML_TS + s4 * 2) = o;
              if (tid < 16) { u32x2 o2; o2.x = pk2(wk.x, wk.y); o2.y = pk2(wk.z, wk.w); *(LAS u32x2*)(lds + ML_VWT + 32 * ML_TS + s4 * 2) = o2; } }
            LDS_BARRIER();
            { f32x4 a1 = (f32x4){0.f, 0.f, 0.f, 0.f}, a1n = a1, a2 = a1, a2n = a1;
#pragma unroll
              for (int ks = 0; ks < 8; ++ks) { const bf16x8 bq = *(LAS bf16x8*)(lds + ML_QS + (16 * tt + fr) * ML_RS + (32 * ks + 8 * fq) * 2);
                  const bf16x8 ac = *(LAS bf16x8*)(lds + ML_CB + (16 * sp + fr) * ML_RS + (32 * ks + 8 * fq) * 2); const bf16x8 an = *(LAS bf16x8*)(lds + ML_CB + 32 * ML_RS + (32 * ks + 8 * fq) * 2);
                  a1 = __builtin_amdgcn_mfma_f32_16x16x32_bf16(ac, bq, a1, 0, 0, 0); a1n = __builtin_amdgcn_mfma_f32_16x16x32_bf16(an, bq, a1n, 0, 0, 0); }
#pragma unroll
              for (int ks = 0; ks < 2; ++ks) { const bf16x8 bs = *(LAS bf16x8*)(lds + ML_SCB + (16 * tt + fr) * ML_TS + (32 * ks + 8 * fq) * 2);
                  const bf16x8 av = *(LAS bf16x8*)(lds + ML_VTS + (16 * sp + fr) * ML_TS + (32 * ks + 8 * fq) * 2); const bf16x8 an = *(LAS bf16x8*)(lds + ML_VTS + 32 * ML_TS + (32 * ks + 8 * fq) * 2);
                  a2 = __builtin_amdgcn_mfma_f32_16x16x32_bf16(av, bs, a2, 0, 0, 0); a2n = __builtin_amdgcn_mfma_f32_16x16x32_bf16(an, bs, a2n, 0, 0, 0); }
              const float si = vSI[16 * tt + fr], em = vEM[16 * tt + fr];
              const float den = a2n[0] + si * a1n[0]; const float rd = 1.f / fmaxf(fabsf(den), em);
              u32x2 o; o.x = pk2((a2[0] + si * a1[0]) * rd, (a2[1] + si * a1[1]) * rd); o.y = pk2((a2[2] + si * a1[2]) * rd, (a2[3] + si * a1[3]) * rd);
              *(u32x2*)(hg + (size_t)(64 * c) * D) = o; }
            { const float dec = vDEC[0];
#pragma unroll
              for (int u = 0; u < 2; ++u)
#pragma unroll
                  for (int v3 = 0; v3 < 3; ++v3) Cacc[u][v3] = Cacc[u][v3] * dec;
#pragma unroll
              for (int ks = 0; ks < 2; ++ks) { bf16x8 bv[3];
#pragma unroll
                  for (int v3 = 0; v3 < 3; ++v3) { const int vr = (v3 < 2) ? 16 * v3 + fr : 32; bv[v3] = *(LAS bf16x8*)(lds + ML_VWT + vr * ML_TS + (32 * ks + 8 * fq) * 2); }
#pragma unroll
                  for (int u = 0; u < 2; ++u) { const bf16x8 ak = *(LAS bf16x8*)(lds + ML_KST + (16 * (2 * w + u) + fr) * ML_TS + (32 * ks + 8 * fq) * 2);
#pragma unroll
                      for (int v3 = 0; v3 < 3; ++v3) Cacc[u][v3] = __builtin_amdgcn_mfma_f32_16x16x32_bf16(ak, bv[v3], Cacc[u][v3], 0, 0, 0); } } }
            LDS_BARRIER();
#pragma unroll
            for (int u = 0; u < 2; ++u)
#pragma unroll
                for (int v3 = 0; v3 < 3; ++v3) { if (v3 < 2 || fr == 0) { const int vr = (v3 < 2) ? 16 * v3 + fr : 32; const f32x4 cv = Cacc[u][v3];
                    u32x2 o; o.x = pk2(cv.x, cv.y); o.y = pk2(cv.z, cv.w); *(LAS u32x2*)(lds + ML_CB + vr * ML_RS + (16 * (2 * w + u) + 4 * fq) * 2) = o; } }
            if (c < 63) { ML_STORE(); ga = nga; gp_ = ngp; gb = ngb; }
            LDS_BARRIER();
        }
#undef ML_LOAD
#undef ML_STORE
    }
}

__device__ __forceinline__ void memk_norm(bf16_t* MK, const float* gk, const float* gq, int gw, int NGW, int lane) {
    for (int r = gw; r < TMEM * 4; r += NGW) { const int bm = r >> 2, h = r & 3; bf16_t* p = MK + (size_t)bm * D + h * 256 + 4 * lane;
        const u32x2 w = *(const u32x2*)p; f32x4 v = (f32x4){bflo(w.x), bfhi(w.x), bflo(w.y), bfhi(w.y)};
        const float rs = rsqrtf(wave_sum(v.x * v.x + v.y * v.y + v.z * v.z + v.w * v.w) * (1.f / 256.f) + EPS);
        const f32x4 g = *(const f32x4*)(gk + 4 * lane); const f32x4 g2 = *(const f32x4*)(gq + 4 * lane); v = v * rs * g * g2 * 0.0625f;
        u32x2 o; o.x = pk2(v.x, v.y); o.y = pk2(v.z, v.w); *(u32x2*)p = o; }
}
constexpr int CX_RS = 528;
__device__ __forceinline__ void cross_lds(bf16_t* XQ, const bf16_t* MK, const bf16_t* MVT, LAS unsigned char* lds) {
    int tid_ = threadIdx.x; asm volatile("" : "+v"(tid_));
    const int tid = tid_, lane = tid & 63, w = tid >> 6, fr = lane & 15, fq = lane >> 4;
    for (int un = blockIdx.x; un < (T / 128) * 4; un += gridDim.x) {
        const int h = un & 3, t0 = (un >> 2) * 128, b = t0 >> 12;
        { const bf16_t* src = MK + (size_t)(b * NMEM) * D + h * 256 + (size_t)(tid >> 5) * D + (tid & 31) * 8; LAS unsigned char* dst = lds + (tid >> 5) * CX_RS + (tid & 31) * 16;
#pragma unroll 1
          for (int i0 = 0; i0 < 16; i0 += 8) { u32x4 tmp[8];
#pragma unroll
              for (int i = 0; i < 8; ++i) tmp[i] = *(const u32x4*)(src + (size_t)(16 * (i0 + i)) * D);
#pragma unroll
              for (int i = 0; i < 8; ++i) *(LAS u32x4*)(dst + 16 * (i0 + i) * CX_RS) = tmp[i]; } }
        asm volatile("" ::: "memory");
        bf16_t* qrow = XQ + (size_t)(t0 + 16 * w + fr) * D + h * 256;
        bf16x8 qf[8]; float ss = 0.f;
#pragma unroll
        for (int s_ = 0; s_ < 8; ++s_) { const u32x4 wq = *(const u32x4*)(qrow + 32 * s_ + 8 * fq); qf[s_] = __builtin_bit_cast(bf16x8, wq);
            ss += bflo(wq.x) * bflo(wq.x) + bfhi(wq.x) * bfhi(wq.x) + bflo(wq.y) * bflo(wq.y) + bfhi(wq.y) * bfhi(wq.y) + bflo(wq.z) * bflo(wq.z) + bfhi(wq.z) * bfhi(wq.z) + bflo(wq.w) * bflo(wq.w) + bfhi(wq.w) * bfhi(wq.w); }
        ss += __shfl_xor(ss, 16); ss += __shfl_xor(ss, 32);
        const float rs = rsqrtf(ss * (1.f / 256.f) + EPS);
        __syncthreads();
        f32x4 X[16];
#pragma unroll
        for (int kt = 0; kt < 16; ++kt) { X[kt] = (f32x4){0.f, 0.f, 0.f, 0.f};
#pragma unroll
            for (int s_ = 0; s_ < 8; ++s_) { const bf16x8 kf = *(LAS bf16x8*)(lds + (16 * kt + fr) * CX_RS + (32 * s_ + 8 * fq) * 2); X[kt] = __builtin_amdgcn_mfma_f32_16x16x32_bf16(kf, qf[s_], X[kt], 0, 0, 0); }
            asm volatile("" : "+v"(X[kt]) : : "memory"); }
        __syncthreads();
        asm volatile("" ::: "memory");
        { const bf16_t* src = MVT + (size_t)(h * 256) * TMEM + b * NMEM + (size_t)(tid >> 5) * TMEM + (tid & 31) * 8; LAS unsigned char* dst = lds + (tid >> 5) * CX_RS + (tid & 31) * 16;
#pragma unroll 1
          for (int i0 = 0; i0 < 16; i0 += 8) { u32x4 tmp[8];
#pragma unroll
              for (int i = 0; i < 8; ++i) tmp[i] = *(const u32x4*)(src + (size_t)(16 * (i0 + i)) * TMEM);
#pragma unroll
              for (int i = 0; i < 8; ++i) *(LAS u32x4*)(dst + 16 * (i0 + i) * CX_RS) = tmp[i]; } }
        asm volatile("" ::: "memory");
        float mx = -3.0e38f;
#pragma unroll
        for (int kt = 0; kt < 16; ++kt) { X[kt] = X[kt] * rs; mx = fmaxf(mx, fmaxf(fmaxf(X[kt].x, X[kt].y), fmaxf(X[kt].z, X[kt].w))); }
        mx = fmaxf(mx, __shfl_xor(mx, 16)); mx = fmaxf(mx, __shfl_xor(mx, 32));
        float sum = 0.f;
#pragma unroll
        for (int kt = 0; kt < 16; ++kt) { X[kt].x = __expf(X[kt].x - mx); X[kt].y = __expf(X[kt].y - mx); X[kt].z = __expf(X[kt].z - mx); X[kt].w = __expf(X[kt].w - mx); sum += (X[kt].x + X[kt].y) + (X[kt].z + X[kt].w); }
        sum += __shfl_xor(sum, 16); sum += __shfl_xor(sum, 32);
        const float inv = 1.f / sum;
        bf16x8 pf[8];
#pragma unroll
        for (int kp = 0; kp < 8; ++kp) { u32x4 wp; wp.x = pk2(X[2 * kp].x, X[2 * kp].y); wp.y = pk2(X[2 * kp].z, X[2 * kp].w); wp.z = pk2(X[2 * kp + 1].x, X[2 * kp + 1].y); wp.w = pk2(X[2 * kp + 1].z, X[2 * kp + 1].w); pf[kp] = __builtin_bit_cast(bf16x8, wp); }
        __syncthreads();
#pragma unroll 2
        for (int dt = 0; dt < 16; ++dt) { f32x4 Y = (f32x4){0.f, 0.f, 0.f, 0.f};
#pragma unroll
            for (int kp = 0; kp < 8; ++kp) { LAS unsigned char* vp = lds + (16 * dt + fr) * CX_RS + (32 * kp + 4 * fq) * 2; const u32x2 lo = *(LAS u32x2*)vp, hi = *(LAS u32x2*)(vp + 32);
                u32x4 wv; wv.x = lo.x; wv.y = lo.y; wv.z = hi.x; wv.w = hi.y; Y = __builtin_amdgcn_mfma_f32_16x16x32_bf16(__builtin_bit_cast(bf16x8, wv), pf[kp], Y, 0, 0, 0); }
            Y = Y * inv; u32x2 o; o.x = pk2(Y.x, Y.y); o.y = pk2(Y.z, Y.w); *(u32x2*)(qrow + 16 * dt + 4 * fq) = o; }
        __syncthreads();
    }
}
__device__ __forceinline__ void ml_finalize(const bf16_t* HUN, const bf16_t* MO, const float* g, bf16_t* Y, int gw, int NGW, int lane) {
    const f32x4 g0 = *(const f32x4*)(g + 4 * lane), g1 = *(const f32x4*)(g + 256 + 4 * lane), g2 = *(const f32x4*)(g + 512 + 4 * lane), g3 = *(const f32x4*)(g + 768 + 4 * lane);
    u32x2 hw[4], ow[4];
#pragma unroll
    for (int i = 0; i < 4; ++i) { const size_t off = (size_t)gw * D + i * 256 + 4 * lane; hw[i] = *(const u32x2*)(HUN + off); ow[i] = *(const u32x2*)(MO + off); }
    for (int t = gw; t < T; t += NGW) {
        const int tn = (t + NGW < T) ? t + NGW : t; u32x2 nh[4], no[4];
#pragma unroll
        for (int i = 0; i < 4; ++i) { const size_t off = (size_t)tn * D + i * 256 + 4 * lane; nh[i] = *(const u32x2*)(HUN + off); no[i] = *(const u32x2*)(MO + off); }
        float ssv[4]; f32x4 v[4];
#pragma unroll
        for (int i = 0; i < 4; ++i) { v[i] = (f32x4){bflo(hw[i].x), bfhi(hw[i].x), bflo(hw[i].y), bfhi(hw[i].y)}; ssv[i] = (v[i].x * v[i].x + v[i].y * v[i].y) + (v[i].z * v[i].z + v[i].w * v[i].w); }
#pragma unroll
        for (int i = 0; i < 4; ++i) ssv[i] = row16_sum(ssv[i]);
#pragma unroll
        for (int i = 0; i < 4; ++i) ssv[i] += __shfl_xor(ssv[i], 16);
#pragma unroll
        for (int i = 0; i < 4; ++i) ssv[i] += __shfl_xor(ssv[i], 32);
#pragma unroll
        for (int i = 0; i < 4; ++i) { const size_t off = (size_t)t * D + i * 256 + 4 * lane; const float rs = rsqrtf(ssv[i] * (1.f / 256.f) + EPS);
            const f32x4 gg = i == 0 ? g0 : (i == 1 ? g1 : (i == 2 ? g2 : g3));
            f32x4 r = v[i] * rs * gg; r.x *= sigmoidf_(bflo(ow[i].x)); r.y *= sigmoidf_(bfhi(ow[i].x)); r.z *= sigmoidf_(bflo(ow[i].y)); r.w *= sigmoidf_(bfhi(ow[i].y));
            u32x2 o; o.x = pk2(r.x, r.y); o.y = pk2(r.z, r.w); *(u32x2*)(Y + off) = o; }
#pragma unroll
        for (int i = 0; i < 4; ++i) { hw[i] = nh[i]; ow[i] = no[i]; }
    }
}

#define XB_TMO      128
#define XB_XCNT(j)  (256  + 64 * (j))
#define XB_XSUB(j)  (1280 + 64 * (j))
#define XB_XGEN(j)  (2304 + 64 * (j))
#define XB_TOP      3328
#define XB_TOPGEN   3392
#define XCD_BAR_WORDS 3456
#define XB_SPIN_CAP (1u << 18)

__device__ __forceinline__ unsigned xb_ld(unsigned* p)              { return __hip_atomic_load(p, __ATOMIC_RELAXED, __HIP_MEMORY_SCOPE_AGENT); }
__device__ __forceinline__ unsigned xb_add(unsigned* p, unsigned v) { return __hip_atomic_fetch_add(p, v, __ATOMIC_RELAXED, __HIP_MEMORY_SCOPE_AGENT); }
__device__ __forceinline__ unsigned xb_xcc_id() { return (unsigned)__builtin_amdgcn_s_getreg((3 << 11) | 20) & 0xFu; }
#define XB_SPIN(cond, bar) do { unsigned _sp = 0; while (cond) { __builtin_amdgcn_s_sleep(1); \
    if ((++_sp & 255u) == 0u) { if (xb_ld(&(bar)[XB_TMO])) break; if (_sp > XB_SPIN_CAP) { atomicAdd(&(bar)[XB_TMO], 1u); break; } } } } while (0)

struct XcdBarrier {
    unsigned* bar; unsigned x;
    volatile LAS unsigned* st;
};

__device__ __forceinline__ XcdBarrier xcd_barrier_post(unsigned* bar, volatile LAS unsigned* st) {
    XcdBarrier b; b.bar = bar; b.x = xb_xcc_id(); b.st = st;
    if (threadIdx.x == 0) (void)xb_add(&bar[XB_XCNT(b.x)], 1u);
    return b;
}
__device__ __forceinline__ void xcd_barrier_complete(unsigned* bar, unsigned x, unsigned& nloc, unsigned& nx) {
    const unsigned G = gridDim.x * gridDim.y * gridDim.z;
    unsigned sum, cnt, mine, sp = 0u;
    for (;;) {
        sum = 0u; cnt = 0u; mine = 0u;
#pragma unroll
        for (unsigned j = 0; j < 16; ++j) { const unsigned c = xb_ld(&bar[XB_XCNT(j)]); sum += c; cnt += (c > 0u) ? 1u : 0u; mine = (j == x) ? c : mine; }
        if (sum == G) break;
        __builtin_amdgcn_s_sleep(1);
        if ((++sp & 255u) == 0u) { if (xb_ld(&bar[XB_TMO])) break; if (sp > XB_SPIN_CAP) { atomicAdd(&bar[XB_TMO], 1u); break; } }
    }
    nloc = mine > 0u ? mine : 1u; nx = cnt > 0u ? cnt : 1u;
}

__device__ __forceinline__ void xcd_barrier(const XcdBarrier& b) {
    asm volatile("s_waitcnt vmcnt(0)" ::: "memory");
    __syncthreads();
    if (threadIdx.x == 0) {
        unsigned* bar = b.bar;
        __builtin_amdgcn_s_waitcnt(0);
        unsigned nloc = b.st[0], nx = b.st[1];
        if (nloc == 0u) { xcd_barrier_complete(bar, b.x, nloc, nx); b.st[0] = nloc; b.st[1] = nx; }
        const unsigned old = xb_add(&bar[XB_XSUB(b.x)], 1u);
        const unsigned gen = old / nloc;
        if (old + 1u == (gen + 1u) * nloc) {
            __builtin_amdgcn_fence(__ATOMIC_RELEASE, "agent");
            asm volatile("s_waitcnt vmcnt(0)" ::: "memory");
            const unsigned og = xb_add(&bar[XB_TOP], 1u);
            const unsigned tg = og / nx;
            if (og + 1u == (tg + 1u) * nx) xb_add(&bar[XB_TOPGEN], 1u);
            else XB_SPIN(xb_ld(&bar[XB_TOPGEN]) == tg, bar);
            __builtin_amdgcn_fence(__ATOMIC_ACQUIRE, "agent");
            xb_add(&bar[XB_XGEN(b.x)], 1u);
            asm volatile("s_waitcnt vmcnt(0)" ::: "memory");
        } else {
            XB_SPIN(xb_ld(&bar[XB_XGEN(b.x)]) == gen, bar);
            __builtin_amdgcn_fence(__ATOMIC_ACQUIRE, "agent");
            asm volatile("s_waitcnt vmcnt(0)" ::: "memory");
        }
    }
    __syncthreads();
}

__global__ void __launch_bounds__(NTHREADS) fwd_megakernel(Params p) {
    extern __shared__ __attribute__((aligned(16))) unsigned char lds[];
    cg::grid_group grid = cg::this_grid();
#define LANE() ({ int l_ = threadIdx.x & 63; asm volatile("" : "+v"(l_)); l_; })
    int tid0_ = threadIdx.x; asm volatile("" : "+v"(tid0_));
    const int tid = tid0_, wave = __builtin_amdgcn_readfirstlane(threadIdx.x >> 6);
    const int gw = blockIdx.x * NWAVES + wave, NGW = gridDim.x * NWAVES;
    unsigned char* ws = p.ws; unsigned char* dob = (unsigned char*)p.out;
    const float* x = p.in[0]; const float* mem = p.in[1]; const float* g_mix = p.in[2]; const float* w_in = p.in[3]; const float* b_if = p.in[4]; const float* b_gate = p.in[5];
    const float* conv_w = p.in[6]; const float* conv_b = p.in[7]; const float* ml_norm_g = p.in[8]; const float* g_mem = p.in[9]; const float* w_mem_kv = p.in[10];
    const float* q_norm_g = p.in[11]; const float* k_norm_g = p.in[12]; const float* w_sb = p.in[13]; const float* w_ml = p.in[14]; const float* w_x = p.in[15]; const float* w_out = p.in[16];
    const float* g_mlp = p.in[17]; const float* w_ff1 = p.in[18]; const float* w_ff2 = p.in[19];
    bf16_t* Wt_in = (bf16_t*)(ws + WS_WIN); bf16_t* Wt_mkv = (bf16_t*)(ws + WS_WMKV); bf16_t* Wt_sb = (bf16_t*)(ws + WS_WSB); bf16_t* Wt_ml = (bf16_t*)(ws + WS_WML);
    bf16_t* Wt_x = (bf16_t*)(ws + WS_WX); bf16_t* Wt_out = (bf16_t*)(ws + WS_WOUT); bf16_t* Wt_ff1 = (bf16_t*)(ws + WS_WFF1); bf16_t* Wt_ff2 = (bf16_t*)(ws + WS_WFF2);
    float* ifp = (float*)(ws + WS_IF);
#define SLOT(i) ((bf16_t*)(ws + WS_SLOT0 + (size_t)(i) * SLOT_BYTES))
    bf16_t* memn = (bf16_t*)(dob + DO_MEMN); bf16_t* memk = (bf16_t*)(dob + DO_MEMK); bf16_t* memvt = (bf16_t*)(dob + DO_MEMVT); bf16_t* hun = (bf16_t*)(dob + DO_HUN);

    unsigned long long probe_t0 = 0, probe_dur = 0;
    if (threadIdx.x < 4) ((LAS unsigned*)((LAS unsigned char*)lds + 147440))[threadIdx.x] = 0u;
    __syncthreads();
    const XcdBarrier xbar = xcd_barrier_post((unsigned*)(p.ws + WS_BAR), (volatile LAS unsigned*)((LAS unsigned char*)lds + 147440));
    PROBE_BEGIN(3);
    float* wscr = (float*)(lds + wave * 8448);
    float* wif = (float*)(lds + 69632);
    float* ssq = (float*)(ws + WS_SSQ);
    for (int i = tid; i < 8192; i += NTHREADS) { const int e = i >> 10, k = i & 1023; wif[i] = w_in[(size_t)k * NIN + IF_COL + e]; }
    for (int i = blockIdx.x * NTHREADS + tid; i < T; i += gridDim.x * NTHREADS) ssq[i] = 0.f;
    __syncthreads();
    transpose_matrix(w_in, NIN, D, 2048, Wt_in, wscr, gw, NGW, LANE(), nullptr, true);
    transpose_matrix(w_in + 3072, NIN, D, 2048, Wt_in + (size_t)2048 * D, wscr, gw, NGW, LANE());
    transpose_matrix(w_in + 2048, NIN, D, 1024, Wt_in + (size_t)4096 * D, wscr, gw, NGW, LANE());
    transpose_matrix(w_in + 5120, NIN, D, 2048, Wt_in + (size_t)5120 * D, wscr, gw, NGW, LANE());
    transpose_matrix(w_in + 7176, NIN, D, 4096, Wt_in + (size_t)7168 * D, wscr, gw, NGW, LANE());
    transpose_matrix(w_mem_kv, 2048, D, 2048, Wt_mkv, wscr, gw, NGW, LANE());
    transpose_matrix(w_sb, D, D, D, Wt_sb, wscr, gw, NGW, LANE());
    transpose_matrix(w_ml, D, D, D, Wt_ml, wscr, gw, NGW, LANE());
    transpose_matrix(w_x, D, D, D, Wt_x, wscr, gw, NGW, LANE());
    transpose_matrix(w_out, D, D, D, Wt_out, wscr, gw, NGW, LANE());
    transpose_matrix(w_ff1, FF, D, FF, Wt_ff1, wscr, gw, NGW, LANE(), g_mlp);
    transpose_matrix(w_ff2, D, FF, D, Wt_ff2, wscr, gw, NGW, LANE());
    { const int lane = LANE(); f32x4 cur[4];
      f32x4 gv[4]; float bif[8];
#pragma unroll
      for (int j = 0; j < 4; ++j) gv[j] = ((const f32x4*)g_mix + lane)[64 * j];
#pragma unroll
      for (int e = 0; e < 8; ++e) bif[e] = b_if[e];
#pragma unroll
      for (int j = 0; j < 4; ++j) cur[j] = ((const f32x4*)(x + (size_t)gw * D) + lane)[64 * j];
      for (int m = gw; m < T; m += NGW) { f32x4 nxt[4]; const int mn = (m + NGW < T) ? m + NGW : m;
#pragma unroll
          for (int j = 0; j < 4; ++j) nxt[j] = ((const f32x4*)(x + (size_t)mn * D) + lane)[64 * j];
          rms_row_regs(cur, gv, SLOT(0) + (size_t)m * D, wif, bif, ifp + (size_t)m * 8, lane);
#pragma unroll
          for (int j = 0; j < 4; ++j) cur[j] = nxt[j]; } }
    for (int m = gw; m < TMEM; m += NGW) rms_row<false>(mem + (size_t)m * D, g_mem, memn + (size_t)m * D, nullptr, nullptr, nullptr, LANE());
    PROBE_END(3);
    grid.sync();

    PROBE_BEGIN(7);
    { const bf16_t* hN = SLOT(0);
      gemm_fast8(lds, hN, Wt_in, T, 4096, D, EpiSeg4{SLOT(0), (bf16_t*)(ws + WS_HALOQ)});
      gemm_fast8(lds, Wt_in + (size_t)4096 * D, hN, 2048, T, D, EpiVT2{SLOT(0)});
      gemm_simple(memn, Wt_mkv, TMEM, 1024, D, 0, EpiBf16{memk, D});
      gemm_simple(Wt_mkv + (size_t)1024 * D, memn, 1024, TMEM, D, 128, EpiBf16{memvt, TMEM}); }
    PROBE_END(7);
    xcd_barrier(xbar);

    PROBE_BEGIN(4);
    memk_norm(memk, k_norm_g, q_norm_g, gw, NGW, LANE());
    conv_pass(SLOT(4), SLOT(5), (const bf16_t*)(ws + WS_HALOQ), (const bf16_t*)(ws + WS_HALOK), conv_w, conv_b, gw, NGW, LANE());
    PROBE_END(4);
    PROBE_BEGIN(1);
    gate_pass(ifp, (float*)(ws + WS_GATE), (float*)(ws + WS_GATE) + 32 * SEQ, (float*)(ws + WS_GATE) + 64 * SEQ, gw, NGW, LANE());
    sb_fast(SLOT(1), SLOT(2), SLOT(3), (LAS unsigned char*)lds);
    PROBE_END(1);
    xcd_barrier(xbar);

    PROBE_BEGIN(2);
    mlstm_fast(SLOT(4), SLOT(5), SLOT(6), (const float*)(ws + WS_GATE), (const float*)(ws + WS_GATE) + 32 * SEQ, (const float*)(ws + WS_GATE) + 64 * SEQ, hun, (LAS unsigned char*)lds);
    PROBE_END(2);
    __syncthreads();
    PROBE_BEGIN(8);
    gemm_fast8(lds, SLOT(0), Wt_in + (size_t)6144 * D, T, 2048, D, EpiSeg2{SLOT(0)});
    PROBE_END(8);
    xcd_barrier(xbar);

    PROBE_BEGIN(5);
    cross_lds(SLOT(2), memk, memvt, (LAS unsigned char*)lds);
    PROBE_END(5);
    PROBE_BEGIN(6);
    ml_finalize(hun, SLOT(3), ml_norm_g, SLOT(4), gw, NGW, LANE());
    PROBE_END(6);
    xcd_barrier(xbar);

    PROBE_BEGIN(9);
    { pg8::Gemm g{SLOT(0), Wt_in + (size_t)8192 * D, T, D, D}; GateMixOrder S; S.so.init(T, D, (int)gridDim.x, (int)blockIdx.x); EpiGateMix E{SLOT(0), b_gate};
      pg8::gemm_phase<EpiGateMix, GateMixOrder, true, true>((PG8_LAS unsigned char*)lds, g, S, E); }
    PROBE_END(9);
    xcd_barrier(xbar);

    PROBE_BEGIN(11);
    { pg8::Gemm g{SLOT(3), Wt_out, T, D, D}; pg8::StaticOrder S; S.init(T, D, (int)gridDim.x, (int)blockIdx.x); EpiResidSS E{x, p.out, SLOT(1), ssq};
      pg8::gemm_phase<EpiResidSS, pg8::StaticOrder, true, true>((PG8_LAS unsigned char*)lds, g, S, E); }
    PROBE_END(11);
    xcd_barrier(xbar);

    PROBE_BEGIN(12);
    gemm_fast8(lds, SLOT(1), Wt_ff1, T, FF, D, EpiRelu2RS{SLOT(2), FF, ssq});
    PROBE_END(12);
    xcd_barrier(xbar);

    PROBE_BEGIN(13);
    { pg8::Gemm g{SLOT(2), Wt_ff2, T, D, FF}; pg8::StaticOrder S; S.init(T, D, (int)gridDim.x, (int)blockIdx.x); EpiResidIn E{SLOT(1), p.out};
      pg8::gemm_phase<EpiResidIn, pg8::StaticOrder, true, true>((PG8_LAS unsigned char*)lds, g, S, E); }
    PROBE_END(13);
    if (PROBE_PHASE != 0) { const unsigned long long te = __builtin_amdgcn_s_memrealtime(); while (__builtin_amdgcn_s_memrealtime() - te < probe_dur) __builtin_amdgcn_s_sleep(8); }
}

extern "C" void kernel_launch(void* const* d_in, const int* in_sizes, int n_in, void* d_out, int out_size, void* d_ws, size_t ws_size, hipStream_t stream) {
    static int grid_blocks = 0;
    if (grid_blocks == 0) {
        if (n_in != 20 || out_size != T * D || ws_size < WS_NEED) { fprintf(stderr, "kernel_launch: unexpected shapes (n_in %d out %d ws %zu)\n", n_in, out_size, ws_size); grid_blocks = -1; return; }
        int dev = 0, cus = 0, per_cu = 0;
        hipGetDevice(&dev);
        hipDeviceGetAttribute(&cus, hipDeviceAttributeMultiprocessorCount, dev);
        hipFuncSetAttribute((const void*)fwd_megakernel, hipFuncAttributeMaxDynamicSharedMemorySize, LDS_BYTES);
        hipOccupancyMaxActiveBlocksPerMultiprocessor(&per_cu, (const void*)fwd_megakernel, NTHREADS, LDS_BYTES);
        if (per_cu < 1) per_cu = 1;
        grid_blocks = cus * per_cu;
    }
    if (grid_blocks < 0) return;
    if (hipMemsetAsync((char*)d_ws + WS_BAR, 0, WS_BAR_BYTES, stream) != hipSuccess) { fprintf(stderr, "kernel_launch: memset of the barrier words failed\n"); return; }
    Params p{};
    for (int i = 0; i < 20; ++i) p.in[i] = (const float*)d_in[i];
    p.out = (float*)d_out; p.ws = (unsigned char*)d_ws;
    void* args[] = {&p};
    hipError_t e = hipLaunchCooperativeKernel((const void*)fwd_megakernel, dim3(grid_blocks), dim3(NTHREADS), args, LDS_BYTES, stream);
    if (e != hipSuccess) fprintf(stderr, "cooperative launch failed: %s (grid %d)\n", hipGetErrorString(e), grid_blocks);
}
```

```cpp
#include <hip/hip_runtime.h>
#include <hip/hip_cooperative_groups.h>
#include <cstdint>
#include <cstdio>
namespace cg = cooperative_groups;

typedef unsigned short bf16_t;
typedef short bf16x8 __attribute__((ext_vector_type(8)));
typedef float f32x4 __attribute__((ext_vector_type(4)));
typedef unsigned u32x2 __attribute__((ext_vector_type(2)));
typedef unsigned u32x4 __attribute__((ext_vector_type(4)));

constexpr int D = 1024, BATCH = 8, SEQ = 4096, T = BATCH * SEQ, NMEM = 256, TMEM = BATCH * NMEM, FF = 4096;
constexpr int NIN = 11272;
constexpr int IF_COL = 7168;
constexpr float EPS = 1e-6f;
constexpr int NTHREADS = 512, NWAVES = 8;
constexpr int LDS_BYTES = 144 * 1024;
#ifndef PROBE_PHASE
#define PROBE_PHASE 0
#endif
#define PROBE_BEGIN(k) do { if (PROBE_PHASE & (1 << (k))) probe_t0 = __builtin_amdgcn_s_memrealtime(); } while (0)
#define PROBE_END(k) do { if (PROBE_PHASE & (1 << (k))) probe_dur += __builtin_amdgcn_s_memrealtime() - probe_t0; } while (0)

constexpr size_t MiB = (size_t)1 << 20;
constexpr size_t WS_WIN = 0;
constexpr size_t WS_WMKV = 22 * MiB;
constexpr size_t WS_WSB = 26 * MiB, WS_WML = 28 * MiB, WS_WX = 30 * MiB, WS_WOUT = 32 * MiB;
constexpr size_t WS_WFF1 = 34 * MiB;
constexpr size_t WS_WFF2 = 42 * MiB;
constexpr size_t WS_IF = 50 * MiB;
constexpr size_t WS_GATE = 58 * MiB;
constexpr size_t WS_BAR = 60 * MiB, WS_BAR_BYTES = 16384;
constexpr size_t WS_SSQ = 57 * MiB;
constexpr size_t WS_HALOQ = 51 * MiB, WS_HALOK = 54 * MiB;
constexpr size_t WS_SLOT0 = 64 * MiB, SLOT_BYTES = 64 * MiB;
constexpr size_t WS_NEED = WS_SLOT0 + 7 * SLOT_BYTES;
constexpr size_t DO_MEMN = 0;
constexpr size_t DO_MEMK = 4 * MiB;
constexpr size_t DO_MEMVT = 8 * MiB;
constexpr size_t DO_HUN = 64 * MiB;

struct Params { const float* in[20]; float* out; unsigned char* ws; };

__device__ __forceinline__ unsigned f2bf(float f) { unsigned u = __builtin_bit_cast(unsigned, f); return (u + 0x7fffu + ((u >> 16) & 1u)) >> 16; }
typedef float f32x2_t __attribute__((ext_vector_type(2))); typedef __bf16 bf16x2_t __attribute__((ext_vector_type(2)));
__device__ __forceinline__ unsigned pk2(float lo, float hi) { f32x2_t v = {lo, hi}; bf16x2_t b = __builtin_convertvector(v, bf16x2_t); return __builtin_bit_cast(unsigned, b); }
__device__ __forceinline__ float bf2f(bf16_t v) { return __builtin_bit_cast(float, (unsigned)v << 16); }
__device__ __forceinline__ float bflo(unsigned w) { return __builtin_bit_cast(float, w << 16); }
__device__ __forceinline__ float bfhi(unsigned w) { return __builtin_bit_cast(float, w & 0xffff0000u); }
__device__ __forceinline__ float row16_sum(float v) {
    v += __builtin_bit_cast(float, __builtin_amdgcn_update_dpp(0, __builtin_bit_cast(int, v), 0xB1, 0xF, 0xF, true));
    v += __builtin_bit_cast(float, __builtin_amdgcn_update_dpp(0, __builtin_bit_cast(int, v), 0x4E, 0xF, 0xF, true));
    v += __builtin_bit_cast(float, __builtin_amdgcn_update_dpp(0, __builtin_bit_cast(int, v), 0x141, 0xF, 0xF, true));
    v += __builtin_bit_cast(float, __builtin_amdgcn_update_dpp(0, __builtin_bit_cast(int, v), 0x140, 0xF, 0xF, true));
    return v;
}
__device__ __forceinline__ float wave_sum(float v) { v = row16_sum(v); v += __shfl_xor(v, 16); v += __shfl_xor(v, 32); return v; }
__device__ __forceinline__ float wave_max(float v) {
#pragma unroll
    for (int o = 1; o < 64; o <<= 1) v = fmaxf(v, __shfl_xor(v, o));
    return v;
}
__device__ __forceinline__ float sigmoidf_(float x) { return __builtin_amdgcn_rcpf(1.f + __builtin_amdgcn_exp2f(x * -1.4426950408889634f)); }
#define LDS_WAIT() asm volatile("s_waitcnt lgkmcnt(0)" ::: "memory")
#define LDS_BARRIER() do { asm volatile("s_waitcnt lgkmcnt(0)" ::: "memory"); __builtin_amdgcn_s_barrier(); asm volatile("" ::: "memory"); } while (0)

__device__ __forceinline__ void transpose_item(const float* W, int ldw, int K, bf16_t* WT, int k0, int n0, float* scr, int lane, const float* kscale, float cs = 1.f) {
#pragma unroll 8
    for (int i = 0; i < 32; ++i) { const int kk = 2 * i + (lane >> 5); float v = W[(size_t)(k0 + kk) * ldw + n0 + (lane & 31)] * cs; if (kscale) v *= kscale[k0 + kk]; scr[kk * 33 + (lane & 31)] = v; }
    LDS_WAIT();
    const int c = lane & 7;
#pragma unroll
    for (int j = 0; j < 4; ++j) { const int n = (lane >> 3) + 8 * j; const float* s = scr + (8 * c) * 33 + n;
        u32x4 o; o.x = pk2(s[0 * 33], s[1 * 33]); o.y = pk2(s[2 * 33], s[3 * 33]); o.z = pk2(s[4 * 33], s[5 * 33]); o.w = pk2(s[6 * 33], s[7 * 33]);
        *(u32x4*)(WT + (size_t)(n0 + n) * K + k0 + 8 * c) = o; }
    LDS_WAIT();
}
constexpr float SB_QSCALE = -0.08838834764831845f * 1.4426950408889634f;
__device__ __forceinline__ void transpose_matrix(const float* W, int ldw, int K, int N, bf16_t* WT, float* scr, int gw, int NGW, int lane, const float* kscale = nullptr, bool sbq = false) {
    const int nblk = N / 32, items = (K / 64) * nblk;
    for (int it = gw; it < items; it += NGW) { const int kb = it / nblk, nb = it % nblk; transpose_item(W, ldw, K, WT, 64 * kb, 32 * nb, scr, lane, kscale, (sbq && nb < 32) ? SB_QSCALE : 1.f); }
}

template <bool WITH_IF>
__device__ __forceinline__ void rms_row(const float* xrow, const float* g, bf16_t* orow, const float* wif  , const float* b_if, float* ifout, int lane) {
    const f32x4* xr = (const f32x4*)xrow + lane; const f32x4* gr = (const f32x4*)g + lane;
    f32x4 v[4]; float s = 0.f;
#pragma unroll
    for (int j = 0; j < 4; ++j) { v[j] = xr[64 * j]; s += (v[j].x * v[j].x + v[j].y * v[j].y) + (v[j].z * v[j].z + v[j].w * v[j].w); }
    const float r = rsqrtf(wave_sum(s) * (1.f / D) + EPS);
#pragma unroll
    for (int j = 0; j < 4; ++j) v[j] = v[j] * r * gr[64 * j];
    u32x2* o8 = (u32x2*)orow + lane;
#pragma unroll
    for (int j = 0; j < 4; ++j) { u32x2 w; w.x = pk2(v[j].x, v[j].y); w.y = pk2(v[j].z, v[j].w); o8[64 * j] = w; }
    if (WITH_IF) {
        float a[8];
#pragma unroll
        for (int e = 0; e < 8; ++e) { a[e] = 0.f;
#pragma unroll
            for (int j = 0; j < 4; ++j) { const f32x4 w = *(const f32x4*)(wif + e * 1024 + 256 * j + 4 * lane); a[e] += (v[j].x * w.x + v[j].y * w.y) + (v[j].z * w.z + v[j].w * w.w); }
            a[e] = wave_sum(a[e]); }
        if (lane == 0) {
#pragma unroll
            for (int e = 0; e < 8; ++e) ifout[e] = a[e] + b_if[e]; }
    }
}

__device__ __forceinline__ void rms_row_regs(const f32x4 (&vin)[4], const f32x4 (&gv)[4], bf16_t* orow, const float* wif  , const float (&bif)[8], float* ifout, int lane) {
    f32x4 v[4]; float s = 0.f;
#pragma unroll
    for (int j = 0; j < 4; ++j) { v[j] = vin[j]; s += (v[j].x * v[j].x + v[j].y * v[j].y) + (v[j].z * v[j].z + v[j].w * v[j].w); }
    const float r = rsqrtf(wave_sum(s) * (1.f / D) + EPS);
#pragma unroll
    for (int j = 0; j < 4; ++j) v[j] = v[j] * r * gv[j];
    u32x2* o8 = (u32x2*)orow + lane;
#pragma unroll
    for (int j = 0; j < 4; ++j) { u32x2 w; w.x = pk2(v[j].x, v[j].y); w.y = pk2(v[j].z, v[j].w); o8[64 * j] = w; }
    float a[8];
#pragma unroll
    for (int e = 0; e < 8; ++e) { a[e] = 0.f;
#pragma unroll
        for (int j = 0; j < 4; ++j) { const f32x4 w = *(const f32x4*)(wif + e * 1024 + 256 * j + 4 * lane); a[e] += (v[j].x * w.x + v[j].y * w.y) + (v[j].z * w.z + v[j].w * w.w); } }
#pragma unroll
    for (int e = 0; e < 8; ++e) a[e] = row16_sum(a[e]);
#pragma unroll
    for (int e = 0; e < 8; ++e) a[e] += __shfl_xor(a[e], 16);
#pragma unroll
    for (int e = 0; e < 8; ++e) a[e] += __shfl_xor(a[e], 32);
    if (lane == 0) { f32x4 o0 = (f32x4){a[0] + bif[0], a[1] + bif[1], a[2] + bif[2], a[3] + bif[3]}, o1 = (f32x4){a[4] + bif[4], a[5] + bif[5], a[6] + bif[6], a[7] + bif[7]}; *(f32x4*)ifout = o0; *(f32x4*)(ifout + 4) = o1; }
}

namespace pg8 {
#define PG8_LAS __attribute__((address_space(3)))
typedef unsigned short bf16_t;
typedef short bf16x8 __attribute__((ext_vector_type(8)));
typedef float f32x4 __attribute__((ext_vector_type(4)));
typedef unsigned u32x4 __attribute__((ext_vector_type(4)));
constexpr int BM = 256, BK = 64, HALF = 128, HTB = HALF * BK * 2  , STAGE_BYTES = 8 * HTB, NXCD = 8, WGM = 8;

__host__ __device__ __forceinline__ int lds_byte(int r, int c) { const int st = (r >> 4) * 2 + (c >> 5), rr = r & 15, cc = c & 31, ob = rr * 64 + cc * 2; return st * 1024 + (ob ^ (((ob >> 9) & 1) << 5)); }
__host__ __device__ __forceinline__ void stage_rc(int b, int& R, int& C) { const int st = b / 1024, sb = b % 1024, swz = sb ^ (((sb >> 9) & 1) << 5); R = (st >> 1) * 16 + swz / 64; C = (st & 1) * 32 + (swz % 64) / 2; }
__host__ __device__ __forceinline__ int perm32(int rho) { const int n = rho >> 4, i = rho & 15; return 8 * (i >> 2) + 4 * n + (i & 3); }

struct Unit { int pm, pn; };
struct Gemm { const bf16_t* A; const bf16_t* Bt; int M, N, K; };

struct StaticOrder {
    int nM, nN, nwg, G, c;
    __host__ __device__ void init(int M, int N, int G_, int c_) { nM = M / BM; nN = N / BM; nwg = nM * nN; G = G_; c = c_; }
    __host__ __device__ bool next(int i, Unit& u) const {
        const long L = (long)i * G + c; if (L >= nwg) return false;
        int wgid = (int)L; { const int q = nwg / NXCD, r = nwg % NXCD, xcd = wgid % NXCD, off = wgid / NXCD; wgid = (xcd < r ? xcd * (q + 1) : r * (q + 1) + (xcd - r) * q) + off; }
        const int nig = WGM * nN, gid = wgid / nig, fm = gid * WGM, gsz = (nM - fm) < WGM ? (nM - fm) : WGM;
        u.pm = fm + ((wgid % nig) % gsz); u.pn = (wgid % nig) / gsz; return true;
    }
    __device__ __forceinline__ void a_ready(const Unit&) const {}
    __device__ __forceinline__ void done(const Unit&) const {}
};
template <class Epi, class Sched, bool ALIGN_EPI = false, bool SP2 = false>
__device__ __forceinline__ void gemm_phase(PG8_LAS unsigned char* lds, const Gemm g, const Sched& S, const Epi& E) {
    int tid_ = threadIdx.x; asm volatile("" : "+v"(tid_));
    const int tid = tid_, wid = __builtin_amdgcn_readfirstlane(tid >> 6), lane = tid & 63, wr = wid >> 2, wc = wid & 3, fr = lane & 15, fq = lane >> 4;
    const int K = g.K, nt = K / BK;
    unsigned voffA[2], voffB[2];
#pragma unroll
    for (int i = 0; i < 2; ++i) { int R, C; stage_rc(tid * 16 + i * 8192, R, C); const int Rb = Epi::PERM ? ((R & ~31) + perm32(R & 31)) : R;
        voffA[i] = (unsigned)(R * K + C) * 2u; voffB[i] = (unsigned)(Rb * K + C) * 2u; }
    const size_t kstep = (size_t)(BK * 2);
    const size_t hstep = (size_t)HALF * K * 2;
    const size_t tstep = 2 * hstep;
    const unsigned ldsw = (unsigned)wid * 1024u;
    const int aoff = lds_byte(wr * 64 + fr, fq * 8), boff = lds_byte(wc * 32 + fr, fq * 8);
#define PG8_SA(b, h) (((b) * 2 + (h)) * HTB)
#define PG8_SB(b, h) ((4 + (b) * 2 + (h)) * HTB)
#define PG8_STAGE(bufoff, gbase, voff) do { _Pragma("unroll") for (int _i = 0; _i < 2; ++_i) \
        __builtin_amdgcn_global_load_lds((const unsigned*)((const char*)(gbase) + (voff)[_i]), (PG8_LAS unsigned*)(lds + (bufoff) + ldsw + _i * 8192), 16, 0, 0); } while (0)
#define PG8_LDA(dst, b, h) do { _Pragma("unroll") for (int m = 0; m < 4; ++m) _Pragma("unroll") for (int k = 0; k < 2; ++k) dst[m][k] = *(const PG8_LAS bf16x8*)(lds + PG8_SA(b, h) + aoff + m * 2048 + k * 1024); } while (0)
#define PG8_LDB(dst, b, h) do { _Pragma("unroll") for (int n = 0; n < 2; ++n) _Pragma("unroll") for (int k = 0; k < 2; ++k) dst[n][k] = *(const PG8_LAS bf16x8*)(lds + PG8_SB(b, h) + boff + n * 2048 + k * 1024); } while (0)
#define PG8_MMA(ai, bj, At, Bt) do { __builtin_amdgcn_s_setprio(1); _Pragma("unroll") for (int m = 0; m < 4; ++m) _Pragma("unroll") for (int n = 0; n < 2; ++n) _Pragma("unroll") for (int k = 0; k < 2; ++k) \
        acc[ai][bj][m][n] = __builtin_amdgcn_mfma_f32_16x16x32_bf16(Bt[n][k], At[m][k], acc[ai][bj][m][n], 0, 0, 0); __builtin_amdgcn_s_setprio(0); } while (0)
#define PG8_WAIT_V(n) asm volatile("s_waitcnt vmcnt(" #n ")" ::: "memory")
#define PG8_WAIT_L(n) asm volatile("s_waitcnt lgkmcnt(" #n ")" ::: "memory")
#define PG8_BAR __builtin_amdgcn_s_barrier()
#define PG8_SCHED __builtin_amdgcn_sched_barrier(0)
    Unit cur, nxt; int ui = 0;
    if (!S.next(0, cur)) return;
    f32x4 acc[2][2][4][2];
#pragma unroll
    for (int a = 0; a < 2; ++a)
#pragma unroll
        for (int b = 0; b < 2; ++b)
#pragma unroll
            for (int m = 0; m < 4; ++m)
#pragma unroll
                for (int n = 0; n < 2; ++n) acc[a][b][m][n] = (f32x4){0.f, 0.f, 0.f, 0.f};
    bf16x8 At[4][2], B0[2][2], B1[2][2];
    const char* cA = (const char*)g.A + (size_t)cur.pm * tstep; const char* cB = (const char*)g.Bt + (size_t)cur.pn * tstep;
    S.a_ready(cur);
    if constexpr (SP2) {
        PG8_STAGE(PG8_SB(0, 0), cB, voffB); PG8_STAGE(PG8_SB(0, 1), cB + hstep, voffB); PG8_STAGE(PG8_SA(0, 0), cA, voffA); PG8_STAGE(PG8_SA(0, 1), cA + hstep, voffA);
        if (wr == 1) PG8_BAR;
        PG8_WAIT_V(2); PG8_BAR;
        PG8_STAGE(PG8_SB(1, 0), cB + kstep, voffB); PG8_STAGE(PG8_SA(1, 0), cA + kstep, voffA); PG8_STAGE(PG8_SB(1, 1), cB + hstep + kstep, voffB);
        PG8_WAIT_V(6); PG8_BAR;
    } else {
        PG8_STAGE(PG8_SB(0, 0), cB, voffB); PG8_STAGE(PG8_SA(0, 0), cA, voffA); PG8_STAGE(PG8_SB(0, 1), cB + hstep, voffB); PG8_STAGE(PG8_SA(0, 1), cA + hstep, voffA);
        if (wr == 1) PG8_BAR;
        PG8_WAIT_V(4); PG8_BAR;
        PG8_STAGE(PG8_SB(1, 0), cB + kstep, voffB); PG8_STAGE(PG8_SA(1, 0), cA + kstep, voffA); PG8_STAGE(PG8_SB(1, 1), cB + hstep + kstep, voffB);
        PG8_WAIT_V(6); PG8_BAR;
    }
    for (;;) {
        const bool has_next = S.next(ui + 1, nxt);
        const char* nA = has_next ? (const char*)g.A + (size_t)nxt.pm * tstep : cA; const char* nB = has_next ? (const char*)g.Bt + (size_t)nxt.pn * tstep : cB;
        for (int t = 0; t < nt; t += 2) {
            const bool last = (t == nt - 2);
            const char* a1 = cA + (size_t)(t + 1) * kstep;
            const char* a2 = last ? nA : cA + (size_t)(t + 2) * kstep; const char* b2 = last ? nB : cB + (size_t)(t + 2) * kstep;
            const char* a3 = a2 + kstep; const char* b3 = b2 + kstep;
            if (last && has_next) S.a_ready(nxt);
            if constexpr (SP2) {
            PG8_LDB(B0, 0, 0); PG8_LDB(B1, 0, 1); PG8_SCHED; PG8_LDA(At, 0, 0); PG8_STAGE(PG8_SA(1, 1), a1 + hstep, voffA);
            PG8_WAIT_V(8); PG8_WAIT_L(0); PG8_BAR; PG8_MMA(0, 0, At, B0); PG8_MMA(0, 1, At, B1); PG8_BAR; PG8_SCHED;
            PG8_LDA(At, 0, 1); PG8_STAGE(PG8_SB(0, 0), b2, voffB); PG8_STAGE(PG8_SB(0, 1), b2 + hstep, voffB); PG8_STAGE(PG8_SA(0, 0), a2, voffA);
            PG8_WAIT_V(8); PG8_WAIT_L(0); PG8_BAR; PG8_MMA(1, 0, At, B0); PG8_MMA(1, 1, At, B1); PG8_BAR; PG8_SCHED;
            PG8_LDB(B0, 1, 0); PG8_LDB(B1, 1, 1); PG8_SCHED; PG8_LDA(At, 1, 0); PG8_STAGE(PG8_SA(0, 1), a2 + hstep, voffA);
            PG8_WAIT_V(8); PG8_WAIT_L(0); PG8_BAR; PG8_MMA(0, 0, At, B0); PG8_MMA(0, 1, At, B1); PG8_BAR; PG8_SCHED;
            PG8_LDA(At, 1, 1); PG8_STAGE(PG8_SB(1, 0), b3, voffB); PG8_STAGE(PG8_SB(1, 1), b3 + hstep, voffB); PG8_STAGE(PG8_SA(1, 0), a3, voffA);
            PG8_WAIT_V(8); PG8_WAIT_L(0); PG8_BAR; PG8_MMA(1, 0, At, B0); PG8_MMA(1, 1, At, B1); PG8_BAR; PG8_SCHED;
            } else {
            PG8_LDB(B0, 0, 0); PG8_SCHED; PG8_LDA(At, 0, 0); PG8_STAGE(PG8_SA(1, 1), a1 + hstep, voffA);
            PG8_WAIT_L(8); PG8_BAR; PG8_WAIT_L(0); PG8_MMA(0, 0, At, B0); PG8_BAR; PG8_SCHED;
            PG8_LDB(B1, 0, 1); PG8_STAGE(PG8_SB(0, 0), b2, voffB);
            PG8_BAR; PG8_WAIT_L(0); PG8_MMA(0, 1, At, B1); PG8_BAR;
            PG8_LDA(At, 0, 1); PG8_STAGE(PG8_SA(0, 0), a2, voffA);
            PG8_BAR; PG8_WAIT_L(0); PG8_MMA(1, 0, At, B0); PG8_BAR; PG8_SCHED;
            PG8_STAGE(PG8_SB(0, 1), b2 + hstep, voffB);
            PG8_WAIT_V(6); PG8_BAR; PG8_MMA(1, 1, At, B1); PG8_BAR;
            PG8_LDB(B0, 1, 0); PG8_SCHED; PG8_LDA(At, 1, 0); PG8_STAGE(PG8_SA(0, 1), a2 + hstep, voffA);
            PG8_WAIT_L(8); PG8_BAR; PG8_WAIT_L(0); PG8_MMA(0, 0, At, B0); PG8_BAR; PG8_SCHED;
            PG8_LDB(B1, 1, 1); PG8_STAGE(PG8_SB(1, 0), b3, voffB);
            PG8_BAR; PG8_WAIT_L(0); PG8_MMA(0, 1, At, B1); PG8_BAR;
            PG8_LDA(At, 1, 1); PG8_STAGE(PG8_SA(1, 0), a3, voffA);
            PG8_BAR; PG8_WAIT_L(0); PG8_MMA(1, 0, At, B0); PG8_BAR; PG8_SCHED;
            PG8_STAGE(PG8_SB(1, 1), b3 + hstep, voffB);
            PG8_WAIT_V(6); PG8_BAR; PG8_MMA(1, 1, At, B1); PG8_BAR;
            }
        }
        if constexpr (ALIGN_EPI) { if (wr == 0) PG8_BAR; }
        if constexpr (!Epi::AFTER_DRAIN) { E(acc, cur, wr, wc, fr, fq); S.done(cur); }
        if (!has_next) break;
#pragma unroll
        for (int a = 0; a < 2; ++a)
#pragma unroll
            for (int b = 0; b < 2; ++b)
#pragma unroll
                for (int m = 0; m < 4; ++m)
#pragma unroll
                    for (int n = 0; n < 2; ++n) acc[a][b][m][n] = (f32x4){0.f, 0.f, 0.f, 0.f};
        cur = nxt; cA = nA; cB = nB; ++ui;
        if constexpr (ALIGN_EPI) { if (wr == 1) PG8_BAR; }
    }
    PG8_WAIT_V(0);
    if constexpr (!ALIGN_EPI) { if (wr == 0) PG8_BAR; }
    PG8_BAR;
    if constexpr (Epi::AFTER_DRAIN) { E.fused(acc, cur, wr, wc, fr, fq, lds, wid, lane); S.done(cur); }
#undef PG8_SA
#undef PG8_SB
#undef PG8_STAGE
#undef PG8_LDA
#undef PG8_LDB
#undef PG8_MMA
#undef PG8_WAIT_V
#undef PG8_WAIT_L
#undef PG8_BAR
#undef PG8_SCHED
}
}

template <class EW> struct EpiAdapt { static constexpr bool PERM = false, AFTER_DRAIN = false; EW e;
    __device__ __forceinline__ void operator()(const f32x4 (&acc)[2][2][4][2], const pg8::Unit& u, int wr, int wc, int fr, int fq) const {
#pragma unroll
        for (int ai = 0; ai < 2; ++ai)
#pragma unroll
            for (int m = 0; m < 4; ++m) { const int row = u.pm * 256 + ai * 128 + wr * 64 + m * 16 + fr;
#pragma unroll
                for (int bj = 0; bj < 2; ++bj)
#pragma unroll
                    for (int n = 0; n < 2; ++n) e(row, u.pn * 256 + bj * 128 + wc * 32 + n * 16 + 4 * fq, acc[ai][bj][m][n]); } } };
template <class EW> struct EpiAdapt8 { static constexpr bool PERM = true, AFTER_DRAIN = false; EW e;
    __device__ __forceinline__ void operator()(const f32x4 (&acc)[2][2][4][2], const pg8::Unit& u, int wr, int wc, int fr, int fq) const {
#pragma unroll
        for (int ai = 0; ai < 2; ++ai)
#pragma unroll
            for (int m = 0; m < 4; ++m) { const int row = u.pm * 256 + ai * 128 + wr * 64 + m * 16 + fr;
#pragma unroll
                for (int bj = 0; bj < 2; ++bj) e(row, u.pn * 256 + bj * 128 + wc * 32 + 8 * fq, acc[ai][bj][m][0], acc[ai][bj][m][1]); } } };
template <class EW>
__device__ __forceinline__ void gemm_fast8(unsigned char* lds, const bf16_t* A, const bf16_t* Bt, int M, int N, int K, const EW& e) {
    pg8::Gemm g{A, Bt, M, N, K}; pg8::StaticOrder S; S.init(M, N, (int)gridDim.x, (int)blockIdx.x);
    EpiAdapt8<EW> E{e};
    pg8::gemm_phase<EpiAdapt8<EW>, pg8::StaticOrder, true, true>((PG8_LAS unsigned char*)lds, g, S, E);
}
template <class EW>
__device__ __forceinline__ void gemm_fast(unsigned char* lds, const bf16_t* A, const bf16_t* Bt, int M, int N, int K, const EW& e) {
    pg8::Gemm g{A, Bt, M, N, K}; pg8::StaticOrder S; S.init(M, N, (int)gridDim.x, (int)blockIdx.x);
    EpiAdapt<EW> E{e};
    pg8::gemm_phase<EpiAdapt<EW>, pg8::StaticOrder, true, true>((PG8_LAS unsigned char*)lds, g, S, E);
}

struct EpiBf16 { bf16_t* O; int ldc;
    __device__ __forceinline__ void operator()(int r, int c, f32x4 v) const { u32x2 w; w.x = pk2(v.x, v.y); w.y = pk2(v.z, v.w); *(u32x2*)(O + (size_t)r * ldc + c) = w; } };
struct EpiBf16Halo { bf16_t* O; bf16_t* H;
    __device__ __forceinline__ void operator()(int r, int c, f32x4 v) const { u32x2 w; w.x = pk2(v.x, v.y); w.y = pk2(v.z, v.w); *(u32x2*)(O + (size_t)r * D + c) = w;
        const int rr = r & 63; if (rr >= 61) *(u32x2*)(H + ((size_t)(r >> 6) * 3 + (rr - 61)) * D + c) = w; } };
struct EpiGate { bf16_t* S0; const float* bias;
    __device__ __forceinline__ void operator()(int r, int c, f32x4 v) const { const f32x4 b = *(const f32x4*)(bias + c); const int s = c >> 10, cc = c & 1023; bf16_t* O = S0 + (size_t)(3 + s + (s > 0 ? 1 : 0)) * (SLOT_BYTES / 2);
        u32x2 w; w.x = pk2(sigmoidf_(v.x + b.x), sigmoidf_(v.y + b.y)); w.y = pk2(sigmoidf_(v.z + b.z), sigmoidf_(v.w + b.w)); *(u32x2*)(O + (size_t)r * D + cc) = w; } };
template <int MODE>
struct EpiMix { const bf16_t* G; float* Mx; bf16_t* O;
    __device__ __forceinline__ void operator()(int r, int c, f32x4 v) const { const size_t off = (size_t)r * D + c; const u32x2 gw = *(const u32x2*)(G + off);
        f32x4 m = (f32x4){bflo(gw.x) * v.x, bfhi(gw.x) * v.y, bflo(gw.y) * v.z, bfhi(gw.y) * v.w};
        if (MODE >= 1) m = m + *(const f32x4*)(Mx + off);
        if (MODE <= 1) *(f32x4*)(Mx + off) = m; else { u32x2 w; w.x = pk2(m.x, m.y); w.y = pk2(m.z, m.w); *(u32x2*)(O + off) = w; } } };
struct EpiResid { const float* base; float* out;
    __device__ __forceinline__ void operator()(int r, int c, f32x4 v) const { const size_t off = (size_t)r * D + c; *(f32x4*)(out + off) = *(const f32x4*)(base + off) + v; } };
struct EpiRelu2 { bf16_t* O; int ldc;
    __device__ __forceinline__ void operator()(int r, int c, f32x4 v) const { f32x4 t = (f32x4){fmaxf(v.x, 0.f), fmaxf(v.y, 0.f), fmaxf(v.z, 0.f), fmaxf(v.w, 0.f)}; t = t * t;
        u32x2 w; w.x = pk2(t.x, t.y); w.y = pk2(t.z, t.w); *(u32x2*)(O + (size_t)r * ldc + c) = w; } };

__device__ __forceinline__ void sb_naive(bf16_t* Q, const bf16_t* Kk, const bf16_t* VT, float* qs, int gw, int NGW, int lane) {
    const float scale = 0.08838834764831845f;
    for (int w = gw; w < 2048; w += NGW) {
        for (int i = 0; i < 128; ++i) {
            const int bh = i >> 1, t = (i & 1) ? (SEQ - 1 - w) : w, b = bh >> 3, h = bh & 7;
            const size_t row = (size_t)b * SEQ + t;
            bf16_t* qrow = Q + row * D + h * 128;
            { const unsigned qw = *(const unsigned*)(qrow + 2 * lane); qs[2 * lane] = bflo(qw) * scale; qs[2 * lane + 1] = bfhi(qw) * scale; }
            LDS_WAIT();
            float acc[128];
#pragma unroll
            for (int d = 0; d < 128; ++d) acc[d] = 0.f;
            float R = 0.f;
            const int nb = (t + 63) >> 6;
            for (int blk = nb - 1; blk >= 0; --blk) {
                const int s = blk * 64 + lane; const bool valid = s < t;
                const bf16_t* krow = Kk + ((size_t)b * SEQ + s) * D + h * 128;
                float z = 0.f;
#pragma unroll
                for (int c = 0; c < 16; ++c) { const u32x4 kw = *(const u32x4*)(krow + 8 * c); const f32x4 q0 = *(const f32x4*)(qs + 8 * c), q1 = *(const f32x4*)(qs + 8 * c + 4);
                    z += bflo(kw.x) * q0.x + bfhi(kw.x) * q0.y + bflo(kw.y) * q0.z + bfhi(kw.y) * q0.w + bflo(kw.z) * q1.x + bfhi(kw.z) * q1.y + bflo(kw.w) * q1.z + bfhi(kw.w) * q1.w; }
                const float e = __expf(-fabsf(z)); const float sp = fmaxf(z, 0.f) + __logf(1.f + e);
                const float lm = valid ? -sp : 0.f, ls = z - sp;
                float incl = lm;
#pragma unroll
                for (int off = 1; off < 64; off <<= 1) { const float tmp = __shfl_down(incl, off); if (lane + off < 64) incl += tmp; }
                const float later = R + incl - lm;
                const float p = valid ? __expf(ls + later) : 0.f;
                R += __shfl(incl, 0);
                const bf16_t* vcol = VT + (size_t)(h * 128) * T + (size_t)b * SEQ + s;
#pragma unroll
                for (int d0 = 0; d0 < 128; d0 += 16) {
#pragma unroll
                    for (int d = d0; d < d0 + 16; ++d) acc[d] += p * bf2f(vcol[(size_t)d * T]);
                    asm volatile("" ::: "memory"); }
            }
            float o0 = 0.f, o1 = 0.f;
#pragma unroll
            for (int d = 0; d < 128; ++d) { const float tot = wave_sum(acc[d]); if ((d & 63) == lane) { if (d < 64) o0 = tot; else o1 = tot; } }
            qrow[lane] = (bf16_t)f2bf(o0); qrow[64 + lane] = (bf16_t)f2bf(o1);
            LDS_WAIT();
        }
    }
}

template <class Epi>
__device__ __forceinline__ void gemm_simple(const bf16_t* A, const bf16_t* Bt, int M, int N, int K, int u0, const Epi& E) {
    const int tid = threadIdx.x, wid = tid >> 6, lane = tid & 63, wr = wid >> 2, wc = wid & 3, fr = lane & 15, fq = lane >> 4;
    const int nN = N / 128, nU = (M / 128) * nN;
    for (int uu = blockIdx.x; uu < u0 + nU; uu += gridDim.x) { if (uu < u0) continue; const int u = uu - u0;
        const int pm = u / nN, pn = u % nN, row0 = pm * 128 + wr * 64, col0 = pn * 128 + wc * 32;
        f32x4 acc[4][2];
#pragma unroll
        for (int m = 0; m < 4; ++m)
#pragma unroll
            for (int n = 0; n < 2; ++n) acc[m][n] = (f32x4){0.f, 0.f, 0.f, 0.f};
        const bf16_t* ap = A + (size_t)(row0 + fr) * K + fq * 8; const bf16_t* bp = Bt + (size_t)(col0 + fr) * K + fq * 8;
#pragma unroll 2
        for (int k0 = 0; k0 < K; k0 += 32) { bf16x8 a[4], b[2];
#pragma unroll
            for (int m = 0; m < 4; ++m) a[m] = *(const bf16x8*)(ap + (size_t)m * 16 * K + k0);
#pragma unroll
            for (int n = 0; n < 2; ++n) b[n] = *(const bf16x8*)(bp + (size_t)n * 16 * K + k0);
#pragma unroll
            for (int m = 0; m < 4; ++m)
#pragma unroll
                for (int n = 0; n < 2; ++n) acc[m][n] = __builtin_amdgcn_mfma_f32_16x16x32_bf16(b[n], a[m], acc[m][n], 0, 0, 0); }
#pragma unroll
        for (int m = 0; m < 4; ++m)
#pragma unroll
            for (int n = 0; n < 2; ++n) E(row0 + m * 16 + fr, col0 + n * 16 + 4 * fq, acc[m][n]); }
}

constexpr size_t SLOT_ELEMS = SLOT_BYTES / 2;
struct EpiSeg4 { bf16_t* S0; bf16_t* HQ;
    __device__ __forceinline__ void operator()(int r, int c, f32x4 v) const { const int seg = c >> 10, cc = c & 1023; bf16_t* O = S0 + (size_t)(seg + 1 + (seg >= 2 ? 1 : 0)) * SLOT_ELEMS;
        u32x2 w; w.x = pk2(v.x, v.y); w.y = pk2(v.z, v.w); *(u32x2*)(O + (size_t)r * D + cc) = w;
        const int rr = r & 63; if (seg >= 2 && rr >= 61) *(u32x2*)(HQ + (size_t)(seg - 2) * (3 * MiB / 2) + ((size_t)(r >> 6) * 3 + (rr - 61)) * D + cc) = w; }
    __device__ __forceinline__ void operator()(int r, int c, f32x4 v0, f32x4 v1) const { const int seg = c >> 10, cc = c & 1023; bf16_t* O = S0 + (size_t)(seg + 1 + (seg >= 2 ? 1 : 0)) * SLOT_ELEMS; u32x4 w; w.x = pk2(v0.x, v0.y); w.y = pk2(v0.z, v0.w); w.z = pk2(v1.x, v1.y); w.w = pk2(v1.z, v1.w); *(u32x4*)(O + (size_t)r * D + cc) = w;
        const int rr = r & 63; if (seg >= 2 && rr >= 61) *(u32x4*)(HQ + (size_t)(seg - 2) * (3 * MiB / 2) + ((size_t)(r >> 6) * 3 + (rr - 61)) * D + cc) = w; } };
struct EpiVT2 { bf16_t* S0;
    __device__ __forceinline__ void operator()(int r, int c, f32x4 v) const { bf16_t* O = S0 + (size_t)(3 + 3 * (r >> 10)) * SLOT_ELEMS;
        u32x2 w; w.x = pk2(v.x, v.y); w.y = pk2(v.z, v.w); *(u32x2*)(O + (size_t)(r & 1023) * T + c) = w; }
    __device__ __forceinline__ void operator()(int r, int c, f32x4 v0, f32x4 v1) const { bf16_t* O = S0 + (size_t)(3 + 3 * (r >> 10)) * SLOT_ELEMS; u32x4 w; w.x = pk2(v0.x, v0.y); w.y = pk2(v0.z, v0.w); w.z = pk2(v1.x, v1.y); w.w = pk2(v1.z, v1.w); *(u32x4*)(O + (size_t)(r & 1023) * T + c) = w; } };
struct EpiSeg2 { bf16_t* S0;
    __device__ __forceinline__ void operator()(int r, int c, f32x4 v) const { bf16_t* O = S0 + (size_t)(3 - (c >> 10)) * SLOT_ELEMS;
        u32x2 w; w.x = pk2(v.x, v.y); w.y = pk2(v.z, v.w); *(u32x2*)(O + (size_t)r * D + (c & 1023)) = w; }
    __device__ __forceinline__ void operator()(int r, int c, f32x4 v0, f32x4 v1) const { bf16_t* O = S0 + (size_t)(3 - (c >> 10)) * SLOT_ELEMS; u32x4 w; w.x = pk2(v0.x, v0.y); w.y = pk2(v0.z, v0.w); w.z = pk2(v1.x, v1.y); w.w = pk2(v1.z, v1.w); *(u32x4*)(O + (size_t)r * D + (c & 1023)) = w; } };
struct EpiRelu2RS { bf16_t* O; int ldc; const float* ssq;
    __device__ __forceinline__ void operator()(int r, int c, f32x4 v) const { const float rs = rsqrtf(ssq[r] * (1.f / D) + EPS);
        f32x4 t = (f32x4){fmaxf(v.x * rs, 0.f), fmaxf(v.y * rs, 0.f), fmaxf(v.z * rs, 0.f), fmaxf(v.w * rs, 0.f)}; t = t * t;
        u32x2 w; w.x = pk2(t.x, t.y); w.y = pk2(t.z, t.w); *(u32x2*)(O + (size_t)r * ldc + c) = w; }
    __device__ __forceinline__ void operator()(int r, int c, f32x4 v0, f32x4 v1) const { const float rs = rsqrtf(ssq[r] * (1.f / D) + EPS);
        v0 = (f32x4){fmaxf(v0.x * rs, 0.f), fmaxf(v0.y * rs, 0.f), fmaxf(v0.z * rs, 0.f), fmaxf(v0.w * rs, 0.f)}; v0 = v0 * v0; v1 = (f32x4){fmaxf(v1.x * rs, 0.f), fmaxf(v1.y * rs, 0.f), fmaxf(v1.z * rs, 0.f), fmaxf(v1.w * rs, 0.f)}; v1 = v1 * v1; u32x4 w; w.x = pk2(v0.x, v0.y); w.y = pk2(v0.z, v0.w); w.z = pk2(v1.x, v1.y); w.w = pk2(v1.z, v1.w); *(u32x4*)(O + (size_t)r * ldc + c) = w; } };
struct GateMixOrder { pg8::StaticOrder so;
    __device__ __forceinline__ bool next(int i, pg8::Unit& u) const { const int ti = i / 6, r = i - 6 * ti, br = r >> 1; pg8::Unit t; if (!so.next(ti, t)) return false;
        if ((r & 1) == 0) { u.pm = t.pm; u.pn = br * 4 + t.pn; } else { const int slot = 1 + (br == 1 ? 3 : 0) + (br == 2 ? 1 : 0); u.pm = slot * 128 + t.pm; u.pn = 20 + br * 4 + t.pn; }
        return true; }
    __device__ __forceinline__ void a_ready(const pg8::Unit&) const {}
    __device__ __forceinline__ void done(const pg8::Unit&) const {} };
struct EpiGateMix { static constexpr bool PERM = true, AFTER_DRAIN = false; bf16_t* S0; const float* bias;
    __device__ __forceinline__ void operator()(const f32x4 (&acc)[2][2][4][2], const pg8::Unit& u, int wr, int wc, int fr, int fq) const {
        const bool mix = u.pn >= 20; const int q = mix ? u.pn - 20 : u.pn, br = q >> 2, pn = q & 3, pm = u.pm & 127;
        unsigned char* G8 = (unsigned char*)(S0 + (size_t)(br == 2 ? 6 : 5) * SLOT_ELEMS) + (br == 1 ? (size_t)T * D : 0);
        bf16_t* R = S0 + (size_t)3 * SLOT_ELEMS;
        if (!mix) {
#pragma unroll
            for (int bj = 0; bj < 2; ++bj) { const int col = pn * 256 + bj * 128 + wc * 32 + 8 * fq; const f32x4 b0 = *(const f32x4*)(bias + br * 1024 + col), b1 = *(const f32x4*)(bias + br * 1024 + col + 4);
#pragma unroll
                for (int ai = 0; ai < 2; ++ai)
#pragma unroll
                    for (int m = 0; m < 4; ++m) { const int row = pm * 256 + ai * 128 + wr * 64 + m * 16 + fr; const f32x4 v0 = acc[ai][bj][m][0] + b0, v1 = acc[ai][bj][m][1] + b1;
                        u32x2 g8;
                        g8.x = (unsigned)(sigmoidf_(v0.x) * 255.f + 0.5f) | ((unsigned)(sigmoidf_(v0.y) * 255.f + 0.5f) << 8) | ((unsigned)(sigmoidf_(v0.z) * 255.f + 0.5f) << 16) | ((unsigned)(sigmoidf_(v0.w) * 255.f + 0.5f) << 24);
                        g8.y = (unsigned)(sigmoidf_(v1.x) * 255.f + 0.5f) | ((unsigned)(sigmoidf_(v1.y) * 255.f + 0.5f) << 8) | ((unsigned)(sigmoidf_(v1.z) * 255.f + 0.5f) << 16) | ((unsigned)(sigmoidf_(v1.w) * 255.f + 0.5f) << 24);
                        *(u32x2*)(G8 + ((((size_t)(pm * 4 + pn) * 8 + (wr * 4 + wc)) * 8 + ai * 4 + m) * 2 + bj) * 512 + (fq * 16 + fr) * 8) = g8; } }
        } else {
            const float k255 = 1.f / 255.f;
#pragma unroll
            for (int ai = 0; ai < 2; ++ai) { u32x2 gw[4][2]; u32x4 pw[4][2];
#pragma unroll
                for (int m = 0; m < 4; ++m)
#pragma unroll
                    for (int bj = 0; bj < 2; ++bj) { const size_t off = (size_t)(pm * 256 + ai * 128 + wr * 64 + m * 16 + fr) * D + pn * 256 + bj * 128 + wc * 32 + 8 * fq; gw[m][bj] = *(const u32x2*)(G8 + ((((size_t)(pm * 4 + pn) * 8 + (wr * 4 + wc)) * 8 + ai * 4 + m) * 2 + bj) * 512 + (fq * 16 + fr) * 8); if (br >= 1) pw[m][bj] = *(const u32x4*)(R + off); }
#pragma unroll
                for (int m = 0; m < 4; ++m)
#pragma unroll
                    for (int bj = 0; bj < 2; ++bj) { const size_t off = (size_t)(pm * 256 + ai * 128 + wr * 64 + m * 16 + fr) * D + pn * 256 + bj * 128 + wc * 32 + 8 * fq; const f32x4 v0 = acc[ai][bj][m][0], v1 = acc[ai][bj][m][1];
                        const unsigned ga = gw[m][bj].x, gb = gw[m][bj].y;
                        f32x4 m0 = (f32x4){(float)(ga & 255u) * k255 * v0.x, (float)((ga >> 8) & 255u) * k255 * v0.y, (float)((ga >> 16) & 255u) * k255 * v0.z, (float)(ga >> 24) * k255 * v0.w};
                        f32x4 m1 = (f32x4){(float)(gb & 255u) * k255 * v1.x, (float)((gb >> 8) & 255u) * k255 * v1.y, (float)((gb >> 16) & 255u) * k255 * v1.z, (float)(gb >> 24) * k255 * v1.w};
                        if (br >= 1) { const u32x4 p = pw[m][bj]; m0.x += bflo(p.x); m0.y += bfhi(p.x); m0.z += bflo(p.y); m0.w += bfhi(p.y); m1.x += bflo(p.z); m1.y += bfhi(p.z); m1.z += bflo(p.w); m1.w += bfhi(p.w); }
                        u32x4 w; w.x = pk2(m0.x, m0.y); w.y = pk2(m0.z, m0.w); w.z = pk2(m1.x, m1.y); w.w = pk2(m1.z, m1.w); *(u32x4*)(R + off) = w; } }
        } } };
struct EpiResidSS { static constexpr bool PERM = true, AFTER_DRAIN = false; const float* base; float* out; bf16_t* xb; float* ssq;
    __device__ __forceinline__ void operator()(const f32x4 (&acc)[2][2][4][2], const pg8::Unit& u, int wr, int wc, int fr, int fq) const {
#pragma unroll
        for (int ai = 0; ai < 2; ++ai) { f32x4 pre[4][2][2];
#pragma unroll
            for (int m = 0; m < 4; ++m)
#pragma unroll
                for (int bj = 0; bj < 2; ++bj) { const float* bp = base + (size_t)(u.pm * 256 + ai * 128 + wr * 64 + m * 16 + fr) * D + u.pn * 256 + bj * 128 + wc * 32 + 8 * fq; pre[m][bj][0] = *(const f32x4*)bp; pre[m][bj][1] = *(const f32x4*)(bp + 4); }
#pragma unroll
            for (int m = 0; m < 4; ++m) { const int row = u.pm * 256 + ai * 128 + wr * 64 + m * 16 + fr; float ss = 0.f;
#pragma unroll
                for (int bj = 0; bj < 2; ++bj) { const size_t off = (size_t)row * D + u.pn * 256 + bj * 128 + wc * 32 + 8 * fq;
                    const f32x4 o0 = pre[m][bj][0] + acc[ai][bj][m][0], o1 = pre[m][bj][1] + acc[ai][bj][m][1];
                    u32x4 w; w.x = pk2(o0.x, o0.y); w.y = pk2(o0.z, o0.w); w.z = pk2(o1.x, o1.y); w.w = pk2(o1.z, o1.w); *(u32x4*)(xb + off) = w;
                    ss += ((o0.x * o0.x + o0.y * o0.y) + (o0.z * o0.z + o0.w * o0.w)) + ((o1.x * o1.x + o1.y * o1.y) + (o1.z * o1.z + o1.w * o1.w)); }
                ss += __shfl_xor(ss, 16); ss += __shfl_xor(ss, 32);
                if (fq == 0) atomicAdd(ssq + row, ss); } } } };
struct EpiResidIn { static constexpr bool PERM = true, AFTER_DRAIN = false; const bf16_t* xb; float* out;
    __device__ __forceinline__ void operator()(const f32x4 (&acc)[2][2][4][2], const pg8::Unit& u, int wr, int wc, int fr, int fq) const {
#pragma unroll
        for (int ai = 0; ai < 2; ++ai) { u32x4 pre[4][2];
#pragma unroll
            for (int m = 0; m < 4; ++m)
#pragma unroll
                for (int bj = 0; bj < 2; ++bj) pre[m][bj] = *(const u32x4*)(xb + (size_t)(u.pm * 256 + ai * 128 + wr * 64 + m * 16 + fr) * D + u.pn * 256 + bj * 128 + wc * 32 + 8 * fq);
#pragma unroll
            for (int m = 0; m < 4; ++m)
#pragma unroll
                for (int bj = 0; bj < 2; ++bj) { const f32x4 a0 = acc[ai][bj][m][0], a1 = acc[ai][bj][m][1]; const u32x4 p = pre[m][bj];
                    float* op = out + (size_t)(u.pm * 256 + ai * 128 + wr * 64 + m * 16 + fr) * D + u.pn * 256 + bj * 128 + wc * 32 + 8 * fq;
                    *(f32x4*)op = (f32x4){bflo(p.x) + a0.x, bfhi(p.x) + a0.y, bflo(p.y) + a0.z, bfhi(p.y) + a0.w}; *(f32x4*)(op + 4) = (f32x4){bflo(p.z) + a1.x, bfhi(p.z) + a1.y, bflo(p.w) + a1.z, bfhi(p.w) + a1.w}; } } } };

#define LAS __attribute__((address_space(3)))
typedef float f32x16 __attribute__((ext_vector_type(16)));
constexpr int SB_KST = 272, SB_VST = 136, SB_KBYTES = 64 * SB_KST, SB_VBYTES = 128 * SB_VST, SB_BUF = SB_KBYTES + SB_VBYTES;
template <bool DIAG>
__device__ __forceinline__ void sb_subtile(LAS unsigned char* buf, int st, const bf16x8 (&qf)[8], f32x16 (&Y)[4], float& R, int k0, int qi, int r32, int hh) {
    f32x16 X;
#pragma unroll
    for (int r = 0; r < 16; ++r) X[r] = 0.f;
    LAS unsigned char* kp = buf + (32 * st + r32) * SB_KST + hh * 16;
#pragma unroll
    for (int s = 0; s < 8; ++s) { const bf16x8 kf = *(LAS bf16x8*)(kp + s * 32); X = __builtin_amdgcn_mfma_f32_32x32x16_bf16(kf, qf[s], X, 0, 0, 0); }
    float om[16];
#pragma unroll
    for (int r = 0; r < 16; ++r) { const float zz = __builtin_amdgcn_fmed3f(X[r], -80.f, 80.f);
        const float u = __builtin_amdgcn_exp2f(zz); const float be = __builtin_amdgcn_rcpf(1.f + u);
        const int key = k0 + (r & 3) + 8 * (r >> 2) + 4 * hh; const bool valid = !DIAG || key < qi;
        om[r] = valid ? u * be : 1.f; X[r] = valid ? be : 0.f; }
    float g[4], og[4], pr[4];
#pragma unroll
    for (int c = 0; c < 4; ++c) { g[c] = (om[4 * c] * om[4 * c + 1]) * (om[4 * c + 2] * om[4 * c + 3]); og[c] = __shfl_xor(g[c], 32); pr[c] = g[c] * og[c]; }
    float Tc[4]; Tc[3] = 1.f; Tc[2] = pr[3]; Tc[1] = pr[3] * pr[2]; Tc[0] = Tc[1] * pr[1];
    const float total = Tc[0] * pr[0];
#pragma unroll
    for (int c = 0; c < 4; ++c) { float later = R * Tc[c] * (hh == 0 ? og[c] : 1.f);
#pragma unroll
        for (int i = 3; i >= 0; --i) { const int r = 4 * c + i; const float pv = X[r] * later; later *= om[r]; X[r] = pv; } }
    R *= total;
    bf16x8 pf[2];
#pragma unroll
    for (int s2 = 0; s2 < 2; ++s2) { u32x4 w; w.x = pk2(X[8 * s2], X[8 * s2 + 1]); w.y = pk2(X[8 * s2 + 2], X[8 * s2 + 3]); w.z = pk2(X[8 * s2 + 4], X[8 * s2 + 5]); w.w = pk2(X[8 * s2 + 6], X[8 * s2 + 7]); pf[s2] = __builtin_bit_cast(bf16x8, w); }
#pragma unroll
    for (int dt = 0; dt < 4; ++dt) { LAS unsigned char* vp = buf + SB_KBYTES + (32 * dt + r32) * SB_VST + (32 * st + 4 * hh) * 2;
#pragma unroll
        for (int s2 = 0; s2 < 2; ++s2) { const u32x2 lo = *(LAS u32x2*)(vp + s2 * 32), hi = *(LAS u32x2*)(vp + s2 * 32 + 16);
            u32x4 w; w.x = lo.x; w.y = lo.y; w.z = hi.x; w.w = hi.y;
            Y[dt] = __builtin_amdgcn_mfma_f32_32x32x16_bf16(__builtin_bit_cast(bf16x8, w), pf[s2], Y[dt], 0, 0, 0); } }
}
__device__ __forceinline__ void sb_tile_full(LAS unsigned char* buf, const bf16x8 (&qf)[8], f32x16 (&Y)[4], float& R, int r32, int hh) {
    f32x16 X1, X0;
#pragma unroll
    for (int r = 0; r < 16; ++r) { X1[r] = 0.f; X0[r] = 0.f; }
    LAS unsigned char* kp = buf + r32 * SB_KST + hh * 16;
#pragma unroll
    for (int s = 0; s < 8; ++s) { const bf16x8 k1 = *(LAS bf16x8*)(kp + 32 * SB_KST + s * 32), k0_ = *(LAS bf16x8*)(kp + s * 32);
        X1 = __builtin_amdgcn_mfma_f32_32x32x16_bf16(k1, qf[s], X1, 0, 0, 0); X0 = __builtin_amdgcn_mfma_f32_32x32x16_bf16(k0_, qf[s], X0, 0, 0, 0); }
    float om1[16], om0[16];
#pragma unroll
    for (int r = 0; r < 16; ++r) { const float z1 = X1[r], z0 = X0[r];
        const float u1 = __builtin_amdgcn_exp2f(z1), u0 = __builtin_amdgcn_exp2f(z0); const float b1 = __builtin_amdgcn_rcpf(1.f + u1), b0 = __builtin_amdgcn_rcpf(1.f + u0);
        om1[r] = u1 * b1; om0[r] = u0 * b0; X1[r] = b1; X0[r] = b0; }
    float g1[4], g0[4], o1[4], o0[4];
#pragma unroll
    for (int c = 0; c < 4; ++c) { g1[c] = (om1[4 * c] * om1[4 * c + 1]) * (om1[4 * c + 2] * om1[4 * c + 3]); g0[c] = (om0[4 * c] * om0[4 * c + 1]) * (om0[4 * c + 2] * om0[4 * c + 3]); }
#pragma unroll
    for (int c = 0; c < 4; ++c) { o1[c] = __shfl_xor(g1[c], 32); o0[c] = __shfl_xor(g0[c], 32); }
    float T1[4], T0[4];
    { const float p3 = g1[3] * o1[3], p2 = g1[2] * o1[2], p1 = g1[1] * o1[1], p0 = g1[0] * o1[0]; T1[3] = R; T1[2] = R * p3; T1[1] = T1[2] * p2; T1[0] = T1[1] * p1; R = T1[0] * p0; }
    { const float p3 = g0[3] * o0[3], p2 = g0[2] * o0[2], p1 = g0[1] * o0[1], p0 = g0[0] * o0[0]; T0[3] = R; T0[2] = R * p3; T0[1] = T0[2] * p2; T0[0] = T0[1] * p1; R = T0[0] * p0; }
#pragma unroll
    for (int c = 0; c < 4; ++c) { float l1 = T1[c] * (hh == 0 ? o1[c] : 1.f), l0 = T0[c] * (hh == 0 ? o0[c] : 1.f);
#pragma unroll
        for (int i = 3; i >= 0; --i) { const int r = 4 * c + i; const float p1 = X1[r] * l1, p0 = X0[r] * l0; l1 *= om1[r]; l0 *= om0[r]; X1[r] = p1; X0[r] = p0; } }
    bf16x8 pf1[2], pf0[2];
#pragma unroll
    for (int s2 = 0; s2 < 2; ++s2) { u32x4 w; w.x = pk2(X1[8 * s2], X1[8 * s2 + 1]); w.y = pk2(X1[8 * s2 + 2], X1[8 * s2 + 3]); w.z = pk2(X1[8 * s2 + 4], X1[8 * s2 + 5]); w.w = pk2(X1[8 * s2 + 6], X1[8 * s2 + 7]); pf1[s2] = __builtin_bit_cast(bf16x8, w);
        w.x = pk2(X0[8 * s2], X0[8 * s2 + 1]); w.y = pk2(X0[8 * s2 + 2], X0[8 * s2 + 3]); w.z = pk2(X0[8 * s2 + 4], X0[8 * s2 + 5]); w.w = pk2(X0[8 * s2 + 6], X0[8 * s2 + 7]); pf0[s2] = __builtin_bit_cast(bf16x8, w); }
    LAS unsigned char* vp0 = buf + SB_KBYTES + r32 * SB_VST + (4 * hh) * 2;
    u32x4 va[8], vb[8];
#pragma unroll
    for (int i = 0; i < 8; ++i) { LAS unsigned char* vp = vp0 + (32 * (i >> 2)) * SB_VST + (i & 3) * 32; const u32x2 lo = *(LAS u32x2*)vp, hi = *(LAS u32x2*)(vp + 16); va[i].x = lo.x; va[i].y = lo.y; va[i].z = hi.x; va[i].w = hi.y; }
#pragma unroll
    for (int i = 0; i < 8; ++i) asm volatile("" : "+v"(va[i]));
#pragma unroll
    for (int i = 0; i < 8; ++i) { LAS unsigned char* vp = vp0 + (32 * (2 + (i >> 2))) * SB_VST + (i & 3) * 32; const u32x2 lo = *(LAS u32x2*)vp, hi = *(LAS u32x2*)(vp + 16); vb[i].x = lo.x; vb[i].y = lo.y; vb[i].z = hi.x; vb[i].w = hi.y; }
    __builtin_amdgcn_sched_barrier(0);
#pragma unroll
    for (int i = 0; i < 8; ++i) { const int q4 = i & 3; Y[i >> 2] = __builtin_amdgcn_mfma_f32_32x32x16_bf16(__builtin_bit_cast(bf16x8, va[i]), (q4 < 2) ? pf0[q4] : pf1[q4 - 2], Y[i >> 2], 0, 0, 0); }
#pragma unroll
    for (int i = 0; i < 8; ++i) asm volatile("" : "+v"(vb[i]));
#pragma unroll
    for (int i = 0; i < 8; ++i) { const int q4 = i & 3; Y[2 + (i >> 2)] = __builtin_amdgcn_mfma_f32_32x32x16_bf16(__builtin_bit_cast(bf16x8, vb[i]), (q4 < 2) ? pf0[q4] : pf1[q4 - 2], Y[2 + (i >> 2)], 0, 0, 0); }
}
__device__ __forceinline__ void sb_fast(bf16_t* Q, const bf16_t* Kk, const bf16_t* VT, LAS unsigned char* lds) {
    int tid_ = threadIdx.x; asm volatile("" : "+v"(tid_));
    const int tid = tid_, lane = tid & 63, wid = tid >> 6, r32 = lane & 31, hh = lane >> 5;
    const int vcu_ = (gridDim.x % 8 == 0) ? (int)((blockIdx.x % 8) * (gridDim.x / 8) + blockIdx.x / 8) : (int)blockIdx.x;
    for (int vw = vcu_; vw < 256; vw += gridDim.x) {
        const int bh = vw >> 2, jj = vw & 3, b = bh >> 3, h = bh & 7;
        const bf16_t* kg = Kk + ((size_t)b * SEQ) * D + h * 128;
        const bf16_t* vg = VT + (size_t)(h * 128) * T + (size_t)b * SEQ;
        for (int ui = 0; ui < 4; ++ui) {
            const int qb = ui == 0 ? 2 * jj : (ui == 1 ? 15 - 2 * jj : (ui == 2 ? 2 * jj + 1 : 14 - 2 * jj));
            const int q0w = qb * 256 + 32 * wid, qi = q0w + r32;
            bf16_t* qrow = Q + ((size_t)b * SEQ + qi) * D + h * 128;
            bf16x8 qf[8];
#pragma unroll
            for (int s = 0; s < 8; ++s) qf[s] = *(const bf16x8*)(qrow + 16 * s + 8 * hh);
            f32x16 Y[4];
#pragma unroll
            for (int dt = 0; dt < 4; ++dt)
#pragma unroll
                for (int r = 0; r < 16; ++r) Y[dt][r] = 0.f;
            float R = 1.f;
            const int ktmax = 4 * qb + 3;
            u32x4 kr[2], vr[2];
#define SB_LOADG(kt) do { _Pragma("unroll") for (int i_ = 0; i_ < 2; ++i_) { const int c_ = tid + 512 * i_; \
                kr[i_] = *(const u32x4*)(kg + (size_t)(64 * (kt) + (c_ >> 4)) * D + (c_ & 15) * 8); \
                vr[i_] = *(const u32x4*)(vg + (size_t)(c_ >> 3) * T + 64 * (kt) + (c_ & 7) * 8); } } while (0)
#define SB_STORES(bufp) do { _Pragma("unroll") for (int i_ = 0; i_ < 2; ++i_) { const int c_ = tid + 512 * i_; \
                *(LAS u32x4*)((bufp) + (c_ >> 4) * SB_KST + (c_ & 15) * 16) = kr[i_]; \
                LAS u32x2* vp_ = (LAS u32x2*)((bufp) + SB_KBYTES + (c_ >> 3) * SB_VST + (c_ & 7) * 16); \
                u32x2 a_; a_.x = vr[i_].x; a_.y = vr[i_].y; u32x2 b_; b_.x = vr[i_].z; b_.y = vr[i_].w; vp_[0] = a_; vp_[1] = b_; } } while (0)
            SB_LOADG(ktmax); SB_STORES(lds);
#pragma unroll
            for (int s_ = 0; s_ < 8; ++s_) asm volatile("" : "+v"(qf[s_]));
            __syncthreads();
            for (int kt = ktmax, it = 0; kt >= 0; --kt, ++it) {
                LAS unsigned char* cur = lds + (it & 1) * SB_BUF; LAS unsigned char* nxt = lds + ((it & 1) ^ 1) * SB_BUF;
                if (kt > 0) SB_LOADG(kt - 1);
                if (64 * kt + 63 < q0w) sb_tile_full(cur, qf, Y, R, r32, hh);
                else {
#pragma unroll
                for (int st = 1; st >= 0; --st) { const int k0 = 64 * kt + 32 * st;
                    if (k0 < q0w + 31) { if (k0 + 31 >= q0w) sb_subtile<true>(cur, st, qf, Y, R, k0, qi, r32, hh); else sb_subtile<false>(cur, st, qf, Y, R, k0, qi, r32, hh); } } }
                if (kt > 0) SB_STORES(nxt);
                __syncthreads();
            }
#undef SB_LOADG
#undef SB_STORES
            { LAS unsigned char* stg = lds + wid * 8704;
#pragma unroll
              for (int dt = 0; dt < 4; ++dt)
#pragma unroll
                  for (int c = 0; c < 4; ++c) { u32x2 w; w.x = pk2(Y[dt][4 * c], Y[dt][4 * c + 1]); w.y = pk2(Y[dt][4 * c + 2], Y[dt][4 * c + 3]); *(LAS u32x2*)(stg + r32 * 272 + (32 * dt + 8 * c + 4 * hh) * 2) = w; }
              LDS_WAIT();
              bf16_t* orow = Q + ((size_t)b * SEQ + q0w) * D + h * 128;
#pragma unroll 1
              for (int i = 0; i < 8; ++i) { const int row = 4 * i + (lane >> 4), ch = lane & 15; const u32x4 v = *(LAS u32x4*)(stg + row * 272 + ch * 16); *(u32x4*)(orow + (size_t)row * D + ch * 8) = v; }
              __syncthreads(); }
        }
    }
}

__device__ __forceinline__ void conv_pass(bf16_t* MQ, bf16_t* MK, const bf16_t* haloQ, const bf16_t* haloK, const float* conv_w, const float* conv_b, int gw, int NGW, int lane) {
    for (int it = gw; it < 2048; it += NGW) {
        const int blk = it >> 2, isk = (it >> 1) & 1, half = it & 1;
        const int ch0 = (half * 64 + lane) * 8;
        bf16_t* base = (isk ? MK : MQ) + (size_t)blk * 64 * D + ch0;
        const float* cw = conv_w + isk * 1024 + ch0;
        float w0[8], w1[8], w2[8], w3[8], cb[8], r0[8], r1[8], r2[8];
#pragma unroll
        for (int e = 0; e < 8; ++e) { w0[e] = cw[e]; w1[e] = cw[2048 + e]; w2[e] = cw[4096 + e]; w3[e] = cw[6144 + e]; cb[e] = conv_b[isk * 1024 + ch0 + e]; r0[e] = 0.f; r1[e] = 0.f; r2[e] = 0.f; }
        if ((blk & 63) != 0) { const bf16_t* hal = (isk ? haloK : haloQ) + (size_t)(blk - 1) * 3 * D + ch0;
            const u32x4 h0 = *(const u32x4*)hal, h1 = *(const u32x4*)(hal + D), h2 = *(const u32x4*)(hal + 2 * D);
#pragma unroll
            for (int e2 = 0; e2 < 4; ++e2) { r0[2 * e2] = bflo(h0[e2]); r0[2 * e2 + 1] = bfhi(h0[e2]); r1[2 * e2] = bflo(h1[e2]); r1[2 * e2 + 1] = bfhi(h1[e2]); r2[2 * e2] = bflo(h2[e2]); r2[2 * e2 + 1] = bfhi(h2[e2]); } }
        const float osc = isk ? 0.0625f : 1.f;
        u32x4 in[4];
#pragma unroll
        for (int i = 0; i < 4; ++i) in[i] = *(const u32x4*)(base + (size_t)i * D);
#pragma unroll 1
        for (int r4 = 0; r4 < 64; r4 += 4) {
            u32x4 nx[4]; const int rn = (r4 + 4 < 64) ? r4 + 4 : r4;
#pragma unroll
            for (int i = 0; i < 4; ++i) nx[i] = *(const u32x4*)(base + (size_t)(rn + i) * D);
#pragma unroll
            for (int i = 0; i < 4; ++i) { float y[8];
#pragma unroll
                for (int e = 0; e < 8; ++e) { const float xv = (e & 1) ? bfhi(in[i][e >> 1]) : bflo(in[i][e >> 1]);
                    const float u = w0[e] * r0[e] + w1[e] * r1[e] + w2[e] * r2[e] + w3[e] * xv + cb[e]; r0[e] = r1[e]; r1[e] = r2[e]; r2[e] = xv; y[e] = u * sigmoidf_(u) * osc; }
                u32x4 o; o.x = pk2(y[0], y[1]); o.y = pk2(y[2], y[3]); o.z = pk2(y[4], y[5]); o.w = pk2(y[6], y[7]); *(u32x4*)(base + (size_t)(r4 + i) * D) = o; }
#pragma unroll
            for (int i = 0; i < 4; ++i) in[i] = nx[i];
        }
    }
}

__device__ __forceinline__ void gate_pass(const float* ifp, float* GA, float* GP, float* GB, int gw, int NGW, int lane) {
    for (int it = gw; it < 2048; it += NGW) { const int bh = it >> 6, c = it & 63, b = bh >> 2, h = bh & 3;
        const size_t trow = (size_t)b * SEQ + 64 * c + lane; const float gi = ifp[trow * 8 + h], gf = ifp[trow * 8 + 4 + h];
        const float lf = -(fmaxf(-gf, 0.f) + __logf(1.f + __expf(-fabsf(gf))));
        float bc = lf;
#pragma unroll
        for (int o = 1; o < 64; o <<= 1) { const float t_ = __shfl_up(bc, o); if (lane >= o) bc += t_; }
        const float a = gi - bc; float pm = a;
#pragma unroll
        for (int o = 1; o < 64; o <<= 1) { const float t_ = __shfl_up(pm, o); if (lane >= o) pm = fmaxf(pm, t_); }
        const size_t o_ = (size_t)bh * SEQ + 64 * c + lane; GA[o_] = a; GP[o_] = pm; GB[o_] = bc; }
}

constexpr int ML_QS = 0, ML_KS = 33792, ML_KST = 67584, ML_VTS = 104448, ML_VWT = 109200, ML_SCB = 113952, ML_CB = 123168, ML_VEC = 140592, ML_RS = 528, ML_TS = 144;
__device__ __forceinline__ void mlstm_fast(const bf16_t* MQ, const bf16_t* MK, const bf16_t* MVT, const float* GA, const float* GP, const float* GB, bf16_t* HUN, LAS unsigned char* lds) {
    int tid_ = threadIdx.x; asm volatile("" : "+v"(tid_));
    const int tid = tid_, lane = tid & 63, w = tid >> 6, fr = lane & 15, fq = lane >> 4;
    LAS float* vA = (LAS float*)(lds + ML_VEC); LAS float* vM = vA + 64; LAS float* vSI = vA + 128; LAS float* vEM = vA + 192; LAS float* vWK = vA + 256; LAS float* vDEC = vA + 320;
    const int tt = w & 3, sp = w >> 2;
    const int vcu_ = (gridDim.x % 8 == 0) ? (int)((blockIdx.x % 8) * (gridDim.x / 8) + blockIdx.x / 8) : (int)blockIdx.x;
    for (int item = vcu_; item < 256; item += gridDim.x) {
        const int bh = item >> 3, vs = item & 7, b = bh >> 2, h = bh & 3;
        const bf16_t* qg = MQ + ((size_t)b * SEQ + (tid >> 5)) * D + h * 256 + (tid & 31) * 8;
        const bf16_t* kg = MK + ((size_t)b * SEQ + (tid >> 5)) * D + h * 256 + (tid & 31) * 8;
        const bf16_t* vg = MVT + (size_t)(h * 256 + vs * 32 + ((tid >> 3) & 31)) * T + (size_t)b * SEQ + (tid & 7) * 8;
        const size_t go = (size_t)bh * SEQ + lane;
        bf16_t* hg = HUN + ((size_t)b * SEQ + 16 * tt + fr) * D + h * 256 + vs * 32 + 16 * sp + 4 * fq;
        for (int i = tid; i < 17424 / 16; i += NTHREADS) *(LAS u32x4*)(lds + ML_CB + i * 16) = (u32x4){0u, 0u, 0u, 0u};
        if (tid < 32) *(LAS unsigned*)(lds + ML_VTS + 32 * ML_TS + 4 * tid) = 0x3F803F80u;
        u32x4 pq[4], pk[4], pv; float ga = 0.f, gp_ = 0.f, gb = 0.f, nga = 0.f, ngp = 0.f, ngb = 0.f;
#define ML_LOAD(c) do { _Pragma("unroll") for (int i_ = 0; i_ < 4; ++i_) { pq[i_] = *(const u32x4*)(qg + (size_t)(64 * (c) + 16 * i_) * D); pk[i_] = *(const u32x4*)(kg + (size_t)(64 * (c) + 16 * i_) * D); } \
            if (tid < 256) pv = *(const u32x4*)(vg + 64 * (c)); if (w == 0) { nga = GA[go + 64 * (c)]; ngp = GP[go + 64 * (c)]; ngb = GB[go + 64 * (c)]; } } while (0)
#define ML_STORE() do { _Pragma("unroll") for (int i_ = 0; i_ < 4; ++i_) { *(LAS u32x4*)(lds + ML_QS + ((tid >> 5) + 16 * i_) * ML_RS + (tid & 31) * 16) = pq[i_]; *(LAS u32x4*)(lds + ML_KS + ((tid >> 5) + 16 * i_) * ML_RS + (tid & 31) * 16) = pk[i_]; } \
            if (tid < 256) *(LAS u32x4*)(lds + ML_VTS + (tid >> 3) * ML_TS + (tid & 7) * 16) = pv; } while (0)
        ML_LOAD(0); ML_STORE(); ga = nga; gp_ = ngp; gb = ngb;
        __syncthreads();
        float m_prev = 0.f;
        f32x4 Cacc[2][3];
#pragma unroll
        for (int u = 0; u < 2; ++u)
#pragma unroll
            for (int v3 = 0; v3 < 3; ++v3) Cacc[u][v3] = (f32x4){0.f, 0.f, 0.f, 0.f};
#pragma unroll 1
        for (int c = 0; c < 64; ++c) {
            if (c < 63) ML_LOAD(c + 1);
#pragma unroll
            for (int i_ = 0; i_ < 4; ++i_) { const u32x4 kv = *(LAS u32x4*)(lds + ML_KS + lane * ML_RS + (4 * w + i_) * 16);
#pragma unroll
                for (int e_ = 0; e_ < 8; ++e_) { const unsigned wd_ = kv[e_ >> 1]; *(LAS bf16_t*)(lds + ML_KST + (32 * w + 8 * i_ + e_) * ML_TS + 2 * lane) = (bf16_t)((e_ & 1) ? (wd_ >> 16) : (wd_ & 0xffffu)); } }
            if (w == 0) {
                const float Mt = fmaxf(m_prev, gp_);
                const float Mend = __shfl(Mt, 63), bend = __shfl(gb, 63);
                vA[lane] = ga; vM[lane] = Mt; vSI[lane] = __expf(m_prev - Mt); vEM[lane] = __expf(-(gb + Mt)); vWK[lane] = __expf(ga - Mend);
                if (lane == 0) vDEC[0] = __expf(m_prev - Mend);
                m_prev = bend + Mend;
            }
            f32x4 S[2]; S[0] = (f32x4){0.f, 0.f, 0.f, 0.f}; S[1] = S[0];
#pragma unroll
            for (int ks = 0; ks < 8; ++ks) { const bf16x8 bq = *(LAS bf16x8*)(lds + ML_QS + (16 * tt + fr) * ML_RS + (32 * ks + 8 * fq) * 2);
                const bf16x8 a0 = *(LAS bf16x8*)(lds + ML_KS + (32 * sp + fr) * ML_RS + (32 * ks + 8 * fq) * 2); const bf16x8 a1 = *(LAS bf16x8*)(lds + ML_KS + (32 * sp + 16 + fr) * ML_RS + (32 * ks + 8 * fq) * 2);
                S[0] = __builtin_amdgcn_mfma_f32_16x16x32_bf16(a0, bq, S[0], 0, 0, 0); S[1] = __builtin_amdgcn_mfma_f32_16x16x32_bf16(a1, bq, S[1], 0, 0, 0); }
            LDS_BARRIER();
            { const float Mt = vM[16 * tt + fr]; const int t = 16 * tt + fr;
#pragma unroll
              for (int u = 0; u < 2; ++u) { const int st = 2 * sp + u; const f32x4 av = *(LAS f32x4*)(vA + 16 * st + 4 * fq); float sc[4];
#pragma unroll
                  for (int j = 0; j < 4; ++j) { const int s_ = 16 * st + 4 * fq + j; sc[j] = (s_ <= t) ? S[u][j] * __expf(av[j] - Mt) : 0.f; }
                  u32x2 o; o.x = pk2(sc[0], sc[1]); o.y = pk2(sc[2], sc[3]); *(LAS u32x2*)(lds + ML_SCB + t * ML_TS + (16 * st + 4 * fq) * 2) = o; }
              const int v_ = tid >> 4, s4 = (tid & 15) * 4; const f32x4 wk = *(LAS f32x4*)(vWK + s4);
              const u32x2 vv = *(LAS u32x2*)(lds + ML_VTS + v_ * ML_TS + s4 * 2);
              u32x2 o; o.x = pk2(bflo(vv.x) * wk.x, bfhi(vv.x) * wk.y); o.y = pk2(bflo(vv.y) * wk.z, bfhi(vv.y) * wk.w); *(LAS u32x2*)(lds + ML_VWT + v_ * ML_TS + s4 * 2) = o;
              if (tid < 16) { u32x2 o2; o2.x = pk2(wk.x, wk.y); o2.y = pk2(wk.z, wk.w); *(LAS u32x2*)(lds + ML_VWT + 32 * ML_TS + s4 * 2) = o2; } }
            LDS_BARRIER();
            { f32x4 a1 = (f32x4){0.f, 0.f, 0.f, 0.f}, a1n = a1, a2 = a1, a2n = a1;
#pragma unroll
              for (int ks = 0; ks < 8; ++ks) { const bf16x8 bq = *(LAS bf16x8*)(lds + ML_QS + (16 * tt + fr) * ML_RS + (32 * ks + 8 * fq) * 2);
                  const bf16x8 ac = *(LAS bf16x8*)(lds + ML_CB + (16 * sp + fr) * ML_RS + (32 * ks + 8 * fq) * 2); const bf16x8 an = *(LAS bf16x8*)(lds + ML_CB + 32 * ML_RS + (32 * ks + 8 * fq) * 2);
                  a1 = __builtin_amdgcn_mfma_f32_16x16x32_bf16(ac, bq, a1, 0, 0, 0); a1n = __builtin_amdgcn_mfma_f32_16x16x32_bf16(an, bq, a1n, 0, 0, 0); }
#pragma unroll
              for (int ks = 0; ks < 2; ++ks) { const bf16x8 bs = *(LAS bf16x8*)(lds + ML_SCB + (16 * tt + fr) * ML_TS + (32 * ks + 8 * fq) * 2);
                  const bf16x8 av = *(LAS bf16x8*)(lds + ML_VTS + (16 * sp + fr) * ML_TS + (32 * ks + 8 * fq) * 2); const bf16x8 an = *(LAS bf16x8*)(lds + ML_VTS + 32 * ML_TS + (32 * ks + 8 * fq) * 2);
                  a2 = __builtin_amdgcn_mfma_f32_16x16x32_bf16(av, bs, a2, 0, 0, 0); a2n = __builtin_amdgcn_mfma_f32_16x16x32_bf16(an, bs, a2n, 0, 0, 0); }
              const float si = vSI[16 * tt + fr], em = vEM[16 * tt + fr];
              const float den = a2n[0] + si * a1n[0]; const float rd = 1.f / fmaxf(fabsf(den), em);
              u32x2 o; o.x = pk2((a2[0] + si * a1[0]) * rd, (a2[1] + si * a1[1]) * rd); o.y = pk2((a2[2] + si * a1[2]) * rd, (a2[3] + si * a1[3]) * rd);
              *(u32x2*)(hg + (size_t)(64 * c) * D) = o; }
            { const float dec = vDEC[0];
#pragma unroll
              for (int u = 0; u < 2; ++u)
#pragma unroll
                  for (int v3 = 0; v3 < 3; ++v3) Cacc[u][v3] = Cacc[u][v3] * dec;
#pragma unroll
              for (int ks = 0; ks < 2; ++ks) { bf16x8 bv[3];
#pragma unroll
                  for (int v3 = 0; v3 < 3; ++v3) { const int vr = (v3 < 2) ? 16 * v3 + fr : 32; bv[v3] = *(LAS bf16x8*)(lds + ML_VWT + vr * ML_TS + (32 * ks + 8 * fq) * 2); }
#pragma unroll
                  for (int u = 0; u < 2; ++u) { const bf16x8 ak = *(LAS bf16x8*)(lds + ML_KST + (16 * (2 * w + u) + fr) * ML_TS + (32 * ks + 8 * fq) * 2);
#pragma unroll
                      for (int v3 = 0; v3 < 3; ++v3) Cacc[u][v3] = __builtin_amdgcn_mfma_f32_16x16x32_bf16(ak, bv[v3], Cacc[u][v3], 0, 0, 0); } } }
            LDS_BARRIER();
#pragma unroll
            for (int u = 0; u < 2; ++u)
#pragma unroll
                for (int v3 = 0; v3 < 3; ++v3) { if (v3 < 2 || fr == 0) { const int vr = (v3 < 2) ? 16 * v3 + fr : 32; const f32x4 cv = Cacc[u][v3];
                    u32x2 o; o.x = pk2(cv.x, cv.y); o.y = pk2(cv.z, cv.w); *(LAS u32x2*)(lds + ML_CB + vr * ML_RS + (16 * (2 * w + u) + 4 * fq) * 2) = o; } }
            if (c < 63) { ML_STORE(); ga = nga; gp_ = ngp; gb = ngb; }
            LDS_BARRIER();
        }
#undef ML_LOAD
#undef ML_STORE
    }
}

__device__ __forceinline__ void memk_norm(bf16_t* MK, const float* gk, const float* gq, int gw, int NGW, int lane) {
    for (int r = gw; r < TMEM * 4; r += NGW) { const int bm = r >> 2, h = r & 3; bf16_t* p = MK + (size_t)bm * D + h * 256 + 4 * lane;
        const u32x2 w = *(const u32x2*)p; f32x4 v = (f32x4){bflo(w.x), bfhi(w.x), bflo(w.y), bfhi(w.y)};
        const float rs = rsqrtf(wave_sum(v.x * v.x + v.y * v.y + v.z * v.z + v.w * v.w) * (1.f / 256.f) + EPS);
        const f32x4 g = *(const f32x4*)(gk + 4 * lane); const f32x4 g2 = *(const f32x4*)(gq + 4 * lane); v = v * rs * g * g2 * 0.0625f;
        u32x2 o; o.x = pk2(v.x, v.y); o.y = pk2(v.z, v.w); *(u32x2*)p = o; }
}
constexpr int CX_RS = 528;
__device__ __forceinline__ void cross_lds(bf16_t* XQ, const bf16_t* MK, const bf16_t* MVT, LAS unsigned char* lds) {
    int tid_ = threadIdx.x; asm volatile("" : "+v"(tid_));
    const int tid = tid_, lane = tid & 63, w = tid >> 6, fr = lane & 15, fq = lane >> 4;
    for (int un = blockIdx.x; un < (T / 128) * 4; un += gridDim.x) {
        const int h = un & 3, t0 = (un >> 2) * 128, b = t0 >> 12;
        { const bf16_t* src = MK + (size_t)(b * NMEM) * D + h * 256 + (size_t)(tid >> 5) * D + (tid & 31) * 8; LAS unsigned char* dst = lds + (tid >> 5) * CX_RS + (tid & 31) * 16;
#pragma unroll 1
          for (int i0 = 0; i0 < 16; i0 += 8) { u32x4 tmp[8];
#pragma unroll
              for (int i = 0; i < 8; ++i) tmp[i] = *(const u32x4*)(src + (size_t)(16 * (i0 + i)) * D);
#pragma unroll
              for (int i = 0; i < 8; ++i) *(LAS u32x4*)(dst + 16 * (i0 + i) * CX_RS) = tmp[i]; } }
        asm volatile("" ::: "memory");
        bf16_t* qrow = XQ + (size_t)(t0 + 16 * w + fr) * D + h * 256;
        bf16x8 qf[8]; float ss = 0.f;
#pragma unroll
        for (int s_ = 0; s_ < 8; ++s_) { const u32x4 wq = *(const u32x4*)(qrow + 32 * s_ + 8 * fq); qf[s_] = __builtin_bit_cast(bf16x8, wq);
            ss += bflo(wq.x) * bflo(wq.x) + bfhi(wq.x) * bfhi(wq.x) + bflo(wq.y) * bflo(wq.y) + bfhi(wq.y) * bfhi(wq.y) + bflo(wq.z) * bflo(wq.z) + bfhi(wq.z) * bfhi(wq.z) + bflo(wq.w) * bflo(wq.w) + bfhi(wq.w) * bfhi(wq.w); }
        ss += __shfl_xor(ss, 16); ss += __shfl_xor(ss, 32);
        const float rs = rsqrtf(ss * (1.f / 256.f) + EPS);
        __syncthreads();
        f32x4 X[16];
#pragma unroll
        for (int kt = 0; kt < 16; ++kt) { X[kt] = (f32x4){0.f, 0.f, 0.f, 0.f};
#pragma unroll
            for (int s_ = 0; s_ < 8; ++s_) { const bf16x8 kf = *(LAS bf16x8*)(lds + (16 * kt + fr) * CX_RS + (32 * s_ + 8 * fq) * 2); X[kt] = __builtin_amdgcn_mfma_f32_16x16x32_bf16(kf, qf[s_], X[kt], 0, 0, 0); }
            asm volatile("" : "+v"(X[kt]) : : "memory"); }
        __syncthreads();
        asm volatile("" ::: "memory");
        { const bf16_t* src = MVT + (size_t)(h * 256) * TMEM + b * NMEM + (size_t)(tid >> 5) * TMEM + (tid & 31) * 8; LAS unsigned char* dst = lds + (tid >> 5) * CX_RS + (tid & 31) * 16;
#pragma unroll 1
          for (int i0 = 0; i0 < 16; i0 += 8) { u32x4 tmp[8];
#pragma unroll
              for (int i = 0; i < 8; ++i) tmp[i] = *(const u32x4*)(src + (size_t)(16 * (i0 + i)) * TMEM);
#pragma unroll
              for (int i = 0; i < 8; ++i) *(LAS u32x4*)(dst + 16 * (i0 + i) * CX_RS) = tmp[i]; } }
        asm volatile("" ::: "memory");
        float mx = -3.0e38f;
#pragma unroll
        for (int kt = 0; kt < 16; ++kt) { X[kt] = X[kt] * rs; mx = fmaxf(mx, fmaxf(fmaxf(X[kt].x, X[kt].y), fmaxf(X[kt].z, X[kt].w))); }
        mx = fmaxf(mx, __shfl_xor(mx, 16)); mx = fmaxf(mx, __shfl_xor(mx, 32));
        float sum = 0.f;
#pragma unroll
        for (int kt = 0; kt < 16; ++kt) { X[kt].x = __expf(X[kt].x - mx); X[kt].y = __expf(X[kt].y - mx); X[kt].z = __expf(X[kt].z - mx); X[kt].w = __expf(X[kt].w - mx); sum += (X[kt].x + X[kt].y) + (X[kt].z + X[kt].w); }
        sum += __shfl_xor(sum, 16); sum += __shfl_xor(sum, 32);
        const float inv = 1.f / sum;
        bf16x8 pf[8];
#pragma unroll
        for (int kp = 0; kp < 8; ++kp) { u32x4 wp; wp.x = pk2(X[2 * kp].x, X[2 * kp].y); wp.y = pk2(X[2 * kp].z, X[2 * kp].w); wp.z = pk2(X[2 * kp + 1].x, X[2 * kp + 1].y); wp.w = pk2(X[2 * kp + 1].z, X[2 * kp + 1].w); pf[kp] = __builtin_bit_cast(bf16x8, wp); }
        __syncthreads();
#pragma unroll 2
        for (int dt = 0; dt < 16; ++dt) { f32x4 Y = (f32x4){0.f, 0.f, 0.f, 0.f};
#pragma unroll
            for (int kp = 0; kp < 8; ++kp) { LAS unsigned char* vp = lds + (16 * dt + fr) * CX_RS + (32 * kp + 4 * fq) * 2; const u32x2 lo = *(LAS u32x2*)vp, hi = *(LAS u32x2*)(vp + 32);
                u32x4 wv; wv.x = lo.x; wv.y = lo.y; wv.z = hi.x; wv.w = hi.y; Y = __builtin_amdgcn_mfma_f32_16x16x32_bf16(__builtin_bit_cast(bf16x8, wv), pf[kp], Y, 0, 0, 0); }
            Y = Y * inv; u32x2 o; o.x = pk2(Y.x, Y.y); o.y = pk2(Y.z, Y.w); *(u32x2*)(qrow + 16 * dt + 4 * fq) = o; }
        __syncthreads();
    }
}
__device__ __forceinline__ void ml_finalize(const bf16_t* HUN, const bf16_t* MO, const float* g, bf16_t* Y, int gw, int NGW, int lane) {
    const f32x4 g0 = *(const f32x4*)(g + 4 * lane), g1 = *(const f32x4*)(g + 256 + 4 * lane), g2 = *(const f32x4*)(g + 512 + 4 * lane), g3 = *(const f32x4*)(g + 768 + 4 * lane);
    u32x2 hw[4], ow[4];
#pragma unroll
    for (int i = 0; i < 4; ++i) { const size_t off = (size_t)gw * D + i * 256 + 4 * lane; hw[i] = *(const u32x2*)(HUN + off); ow[i] = *(const u32x2*)(MO + off); }
    for (int t = gw; t < T; t += NGW) {
        const int tn = (t + NGW < T) ? t + NGW : t; u32x2 nh[4], no[4];
#pragma unroll
        for (int i = 0; i < 4; ++i) { const size_t off = (size_t)tn * D + i * 256 + 4 * lane; nh[i] = *(const u32x2*)(HUN + off); no[i] = *(const u32x2*)(MO + off); }
        float ssv[4]; f32x4 v[4];
#pragma unroll
        for (int i = 0; i < 4; ++i) { v[i] = (f32x4){bflo(hw[i].x), bfhi(hw[i].x), bflo(hw[i].y), bfhi(hw[i].y)}; ssv[i] = (v[i].x * v[i].x + v[i].y * v[i].y) + (v[i].z * v[i].z + v[i].w * v[i].w); }
#pragma unroll
        for (int i = 0; i < 4; ++i) ssv[i] = row16_sum(ssv[i]);
#pragma unroll
        for (int i = 0; i < 4; ++i) ssv[i] += __shfl_xor(ssv[i], 16);
#pragma unroll
        for (int i = 0; i < 4; ++i) ssv[i] += __shfl_xor(ssv[i], 32);
#pragma unroll
        for (int i = 0; i < 4; ++i) { const size_t off = (size_t)t * D + i * 256 + 4 * lane; const float rs = rsqrtf(ssv[i] * (1.f / 256.f) + EPS);
            const f32x4 gg = i == 0 ? g0 : (i == 1 ? g1 : (i == 2 ? g2 : g3));
            f32x4 r = v[i] * rs * gg; r.x *= sigmoidf_(bflo(ow[i].x)); r.y *= sigmoidf_(bfhi(ow[i].x)); r.z *= sigmoidf_(bflo(ow[i].y)); r.w *= sigmoidf_(bfhi(ow[i].y));
            u32x2 o; o.x = pk2(r.x, r.y); o.y = pk2(r.z, r.w); *(u32x2*)(Y + off) = o; }
#pragma unroll
        for (int i = 0; i < 4; ++i) { hw[i] = nh[i]; ow[i] = no[i]; }
    }
}

#define XB_TMO      128
#define XB_XCNT(j)  (256  + 64 * (j))
#define XB_XSUB(j)  (1280 + 64 * (j))
#define XB_XGEN(j)  (2304 + 64 * (j))
#define XB_TOP      3328
#define XB_TOPGEN   3392
#define XCD_BAR_WORDS 3456
#define XB_SPIN_CAP (1u << 18)

__device__ __forceinline__ unsigned xb_ld(unsigned* p)              { return __hip_atomic_load(p, __ATOMIC_RELAXED, __HIP_MEMORY_SCOPE_AGENT); }
__device__ __forceinline__ unsigned xb_add(unsigned* p, unsigned v) { return __hip_atomic_fetch_add(p, v, __ATOMIC_RELAXED, __HIP_MEMORY_SCOPE_AGENT); }
__device__ __forceinline__ unsigned xb_xcc_id() { return (unsigned)__builtin_amdgcn_s_getreg((3 << 11) | 20) & 0xFu; }
#define XB_SPIN(cond, bar) do { unsigned _sp = 0; while (cond) { __builtin_amdgcn_s_sleep(1); \
    if ((++_sp & 255u) == 0u) { if (xb_ld(&(bar)[XB_TMO])) break; if (_sp > XB_SPIN_CAP) { atomicAdd(&(bar)[XB_TMO], 1u); break; } } } } while (0)

struct XcdBarrier {
    unsigned* bar; unsigned x;
    volatile LAS unsigned* st;
};

__device__ __forceinline__ XcdBarrier xcd_barrier_post(unsigned* bar, volatile LAS unsigned* st) {
    XcdBarrier b; b.bar = bar; b.x = xb_xcc_id(); b.st = st;
    if (threadIdx.x == 0) (void)xb_add(&bar[XB_XCNT(b.x)], 1u);
    return b;
}
__device__ __forceinline__ void xcd_barrier_complete(unsigned* bar, unsigned x, unsigned& nloc, unsigned& nx) {
    const unsigned G = gridDim.x * gridDim.y * gridDim.z;
    unsigned sum, cnt, mine, sp = 0u;
    for (;;) {
        sum = 0u; cnt = 0u; mine = 0u;
#pragma unroll
        for (unsigned j = 0; j < 16; ++j) { const unsigned c = xb_ld(&bar[XB_XCNT(j)]); sum += c; cnt += (c > 0u) ? 1u : 0u; mine = (j == x) ? c : mine; }
        if (sum == G) break;
        __builtin_amdgcn_s_sleep(1);
        if ((++sp & 255u) == 0u) { if (xb_ld(&bar[XB_TMO])) break; if (sp > XB_SPIN_CAP) { atomicAdd(&bar[XB_TMO], 1u); break; } }
    }
    nloc = mine > 0u ? mine : 1u; nx = cnt > 0u ? cnt : 1u;
}

__device__ __forceinline__ void xcd_barrier(const XcdBarrier& b) {
    asm volatile("s_waitcnt vmcnt(0)" ::: "memory");
    __syncthreads();
    if (threadIdx.x == 0) {
        unsigned* bar = b.bar;
        __builtin_amdgcn_s_waitcnt(0);
        unsigned nloc = b.st[0], nx = b.st[1];
        if (nloc == 0u) { xcd_barrier_complete(bar, b.x, nloc, nx); b.st[0] = nloc; b.st[1] = nx; }
        const unsigned old = xb_add(&bar[XB_XSUB(b.x)], 1u);
        const unsigned gen = old / nloc;
        if (old + 1u == (gen + 1u) * nloc) {
            __builtin_amdgcn_fence(__ATOMIC_RELEASE, "agent");
            asm volatile("s_waitcnt vmcnt(0)" ::: "memory");
            const unsigned og = xb_add(&bar[XB_TOP], 1u);
            const unsigned tg = og / nx;
            if (og + 1u == (tg + 1u) * nx) xb_add(&bar[XB_TOPGEN], 1u);
            else XB_SPIN(xb_ld(&bar[XB_TOPGEN]) == tg, bar);
            __builtin_amdgcn_fence(__ATOMIC_ACQUIRE, "agent");
            xb_add(&bar[XB_XGEN(b.x)], 1u);
            asm volatile("s_waitcnt vmcnt(0)" ::: "memory");
        } else {
            XB_SPIN(xb_ld(&bar[XB_XGEN(b.x)]) == gen, bar);
            __builtin_amdgcn_fence(__ATOMIC_ACQUIRE, "agent");
            asm volatile("s_waitcnt vmcnt(0)" ::: "memory");
        }
    }
    __syncthreads();
}

__global__ void __launch_bounds__(NTHREADS) fwd_megakernel(Params p) {
    extern __shared__ __attribute__((aligned(16))) unsigned char lds[];
    cg::grid_group grid = cg::this_grid();
#define LANE() ({ int l_ = threadIdx.x & 63; asm volatile("" : "+v"(l_)); l_; })
    int tid0_ = threadIdx.x; asm volatile("" : "+v"(tid0_));
    const int tid = tid0_, wave = __builtin_amdgcn_readfirstlane(threadIdx.x >> 6);
    const int gw = blockIdx.x * NWAVES + wave, NGW = gridDim.x * NWAVES;
    unsigned char* ws = p.ws; unsigned char* dob = (unsigned char*)p.out;
    const float* x = p.in[0]; const float* mem = p.in[1]; const float* g_mix = p.in[2]; const float* w_in = p.in[3]; const float* b_if = p.in[4]; const float* b_gate = p.in[5];
    const float* conv_w = p.in[6]; const float* conv_b = p.in[7]; const float* ml_norm_g = p.in[8]; const float* g_mem = p.in[9]; const float* w_mem_kv = p.in[10];
    const float* q_norm_g = p.in[11]; const float* k_norm_g = p.in[12]; const float* w_sb = p.in[13]; const float* w_ml = p.in[14]; const float* w_x = p.in[15]; const float* w_out = p.in[16];
    const float* g_mlp = p.in[17]; const float* w_ff1 = p.in[18]; const float* w_ff2 = p.in[19];
    bf16_t* Wt_in = (bf16_t*)(ws + WS_WIN); bf16_t* Wt_mkv = (bf16_t*)(ws + WS_WMKV); bf16_t* Wt_sb = (bf16_t*)(ws + WS_WSB); bf16_t* Wt_ml = (bf16_t*)(ws + WS_WML);
    bf16_t* Wt_x = (bf16_t*)(ws + WS_WX); bf16_t* Wt_out = (bf16_t*)(ws + WS_WOUT); bf16_t* Wt_ff1 = (bf16_t*)(ws + WS_WFF1); bf16_t* Wt_ff2 = (bf16_t*)(ws + WS_WFF2);
    float* ifp = (float*)(ws + WS_IF);
#define SLOT(i) ((bf16_t*)(ws + WS_SLOT0 + (size_t)(i) * SLOT_BYTES))
    bf16_t* memn = (bf16_t*)(dob + DO_MEMN); bf16_t* memk = (bf16_t*)(dob + DO_MEMK); bf16_t* memvt = (bf16_t*)(dob + DO_MEMVT); bf16_t* hun = (bf16_t*)(dob + DO_HUN);

    unsigned long long probe_t0 = 0, probe_dur = 0;
    if (threadIdx.x < 4) ((LAS unsigned*)((LAS unsigned char*)lds + 147440))[threadIdx.x] = 0u;
    __syncthreads();
    const XcdBarrier xbar = xcd_barrier_post((unsigned*)(p.ws + WS_BAR), (volatile LAS unsigned*)((LAS unsigned char*)lds + 147440));
    PROBE_BEGIN(3);
    float* wscr = (float*)(lds + wave * 8448);
    float* wif = (float*)(lds + 69632);
    float* ssq = (float*)(ws + WS_SSQ);
    for (int i = tid; i < 8192; i += NTHREADS) { const int e = i >> 10, k = i & 1023; wif[i] = w_in[(size_t)k * NIN + IF_COL + e]; }
    for (int i = blockIdx.x * NTHREADS + tid; i < T; i += gridDim.x * NTHREADS) ssq[i] = 0.f;
    __syncthreads();
    transpose_matrix(w_in, NIN, D, 2048, Wt_in, wscr, gw, NGW, LANE(), nullptr, true);
    transpose_matrix(w_in + 3072, NIN, D, 2048, Wt_in + (size_t)2048 * D, wscr, gw, NGW, LANE());
    transpose_matrix(w_in + 2048, NIN, D, 1024, Wt_in + (size_t)4096 * D, wscr, gw, NGW, LANE());
    transpose_matrix(w_in + 5120, NIN, D, 2048, Wt_in + (size_t)5120 * D, wscr, gw, NGW, LANE());
    transpose_matrix(w_in + 7176, NIN, D, 4096, Wt_in + (size_t)7168 * D, wscr, gw, NGW, LANE());
    transpose_matrix(w_mem_kv, 2048, D, 2048, Wt_mkv, wscr, gw, NGW, LANE());
    transpose_matrix(w_sb, D, D, D, Wt_sb, wscr, gw, NGW, LANE());
    transpose_matrix(w_ml, D, D, D, Wt_ml, wscr, gw, NGW, LANE());
    transpose_matrix(w_x, D, D, D, Wt_x, wscr, gw, NGW, LANE());
    transpose_matrix(w_out, D, D, D, Wt_out, wscr, gw, NGW, LANE());
    transpose_matrix(w_ff1, FF, D, FF, Wt_ff1, wscr, gw, NGW, LANE(), g_mlp);
    transpose_matrix(w_ff2, D, FF, D, Wt_ff2, wscr, gw, NGW, LANE());
    { const int lane = LANE(); f32x4 cur[4];
      f32x4 gv[4]; float bif[8];
#pragma unroll
      for (int j = 0; j < 4; ++j) gv[j] = ((const f32x4*)g_mix + lane)[64 * j];
#pragma unroll
      for (int e = 0; e < 8; ++e) bif[e] = b_if[e];
#pragma unroll
      for (int j = 0; j < 4; ++j) cur[j] = ((const f32x4*)(x + (size_t)gw * D) + lane)[64 * j];
      for (int m = gw; m < T; m += NGW) { f32x4 nxt[4]; const int mn = (m + NGW < T) ? m + NGW : m;
#pragma unroll
          for (int j = 0; j < 4; ++j) nxt[j] = ((const f32x4*)(x + (size_t)mn * D) + lane)[64 * j];
          rms_row_regs(cur, gv, SLOT(0) + (size_t)m * D, wif, bif, ifp + (size_t)m * 8, lane);
#pragma unroll
          for (int j = 0; j < 4; ++j) cur[j] = nxt[j]; } }
    for (int m = gw; m < TMEM; m += NGW) rms_row<false>(mem + (size_t)m * D, g_mem, memn + (size_t)m * D, nullptr, nullptr, nullptr, LANE());
    PROBE_END(3);
    if (p.ws == nullptr) grid.sync();
    xcd_barrier(xbar);

    PROBE_BEGIN(7);
    { const bf16_t* hN = SLOT(0);
      gemm_fast8(lds, hN, Wt_in, T, 4096, D, EpiSeg4{SLOT(0), (bf16_t*)(ws + WS_HALOQ)});
      gemm_fast8(lds, Wt_in + (size_t)4096 * D, hN, 2048, T, D, EpiVT2{SLOT(0)});
      gemm_simple(memn, Wt_mkv, TMEM, 1024, D, 0, EpiBf16{memk, D});
      gemm_simple(Wt_mkv + (size_t)1024 * D, memn, 1024, TMEM, D, 128, EpiBf16{memvt, TMEM}); }
    PROBE_END(7);
    xcd_barrier(xbar);

    PROBE_BEGIN(4);
    memk_norm(memk, k_norm_g, q_norm_g, gw, NGW, LANE());
    conv_pass(SLOT(4), SLOT(5), (const bf16_t*)(ws + WS_HALOQ), (const bf16_t*)(ws + WS_HALOK), conv_w, conv_b, gw, NGW, LANE());
    PROBE_END(4);
    PROBE_BEGIN(1);
    gate_pass(ifp, (float*)(ws + WS_GATE), (float*)(ws + WS_GATE) + 32 * SEQ, (float*)(ws + WS_GATE) + 64 * SEQ, gw, NGW, LANE());
    sb_fast(SLOT(1), SLOT(2), SLOT(3), (LAS unsigned char*)lds);
    PROBE_END(1);
    xcd_barrier(xbar);

    PROBE_BEGIN(2);
    mlstm_fast(SLOT(4), SLOT(5), SLOT(6), (const float*)(ws + WS_GATE), (const float*)(ws + WS_GATE) + 32 * SEQ, (const float*)(ws + WS_GATE) + 64 * SEQ, hun, (LAS unsigned char*)lds);
    PROBE_END(2);
    __syncthreads();
    PROBE_BEGIN(8);
    gemm_fast8(lds, SLOT(0), Wt_in + (size_t)6144 * D, T, 2048, D, EpiSeg2{SLOT(0)});
    PROBE_END(8);
    xcd_barrier(xbar);

    PROBE_BEGIN(5);
    cross_lds(SLOT(2), memk, memvt, (LAS unsigned char*)lds);
    PROBE_END(5);
    PROBE_BEGIN(6);
    ml_finalize(hun, SLOT(3), ml_norm_g, SLOT(4), gw, NGW, LANE());
    PROBE_END(6);
    xcd_barrier(xbar);

    PROBE_BEGIN(9);
    { pg8::Gemm g{SLOT(0), Wt_in + (size_t)8192 * D, T, D, D}; GateMixOrder S; S.so.init(T, D, (int)gridDim.x, (int)blockIdx.x); EpiGateMix E{SLOT(0), b_gate};
      pg8::gemm_phase<EpiGateMix, GateMixOrder, true, true>((PG8_LAS unsigned char*)lds, g, S, E); }
    PROBE_END(9);
    xcd_barrier(xbar);

    PROBE_BEGIN(11);
    { pg8::Gemm g{SLOT(3), Wt_out, T, D, D}; pg8::StaticOrder S; S.init(T, D, (int)gridDim.x, (int)blockIdx.x); EpiResidSS E{x, p.out, SLOT(1), ssq};
      pg8::gemm_phase<EpiResidSS, pg8::StaticOrder, true, true>((PG8_LAS unsigned char*)lds, g, S, E); }
    PROBE_END(11);
    xcd_barrier(xbar);

    PROBE_BEGIN(12);
    gemm_fast8(lds, SLOT(1), Wt_ff1, T, FF, D, EpiRelu2RS{SLOT(2), FF, ssq});
    PROBE_END(12);
    xcd_barrier(xbar);

    PROBE_BEGIN(13);
    { pg8::Gemm g{SLOT(2), Wt_ff2, T, D, FF}; pg8::StaticOrder S; S.init(T, D, (int)gridDim.x, (int)blockIdx.x); EpiResidIn E{SLOT(1), p.out};
      pg8::gemm_phase<EpiResidIn, pg8::StaticOrder, true, true>((PG8_LAS unsigned char*)lds, g, S, E); }
    PROBE_END(13);
    if (PROBE_PHASE != 0) { const unsigned long long te = __builtin_amdgcn_s_memrealtime(); while (__builtin_amdgcn_s_memrealtime() - te < probe_dur) __builtin_amdgcn_s_sleep(8); }
}

extern "C" void kernel_launch(void* const* d_in, const int* in_sizes, int n_in, void* d_out, int out_size, void* d_ws, size_t ws_size, hipStream_t stream) {
    static int grid_blocks = 0;
    if (grid_blocks == 0) {
        if (n_in != 20 || out_size != T * D || ws_size < WS_NEED) { fprintf(stderr, "kernel_launch: unexpected shapes (n_in %d out %d ws %zu)\n", n_in, out_size, ws_size); grid_blocks = -1; return; }
        int dev = 0, cus = 0, per_cu = 0;
        hipGetDevice(&dev);
        hipDeviceGetAttribute(&cus, hipDeviceAttributeMultiprocessorCount, dev);
        hipFuncSetAttribute((const void*)fwd_megakernel, hipFuncAttributeMaxDynamicSharedMemorySize, LDS_BYTES);
        hipOccupancyMaxActiveBlocksPerMultiprocessor(&per_cu, (const void*)fwd_megakernel, NTHREADS, LDS_BYTES);
        if (per_cu < 1) per_cu = 1;
        grid_blocks = cus * per_cu;
    }
    if (grid_blocks < 0) return;
    if (hipMemsetAsync((char*)d_ws + WS_BAR, 0, WS_BAR_BYTES, stream) != hipSuccess) { fprintf(stderr, "kernel_launch: memset of the barrier words failed\n"); return; }
    Params p{};
    for (int i = 0; i < 20; ++i) p.in[i] = (const float*)d_in[i];
    p.out = (float*)d_out; p.ws = (unsigned char*)d_ws;
    void* args[] = {&p};
    hipError_t e = hipLaunchCooperativeKernel((const void*)fwd_megakernel, dim3(grid_blocks), dim3(NTHREADS), args, LDS_BYTES, stream);
    if (e != hipSuccess) fprintf(stderr, "cooperative launch failed: %s (grid %d)\n", hipGetErrorString(e), grid_blocks);
}
```
